# Optimizing an MI355X kernel written in HIP

```python
import math
import jax
import jax.numpy as jnp
from jax import lax
import numpy as np


D_MODEL = 1024
BATCH = 8
SEQ = 2048
DEPTH = 1

F32 = jnp.float32
EPS = 1e-6
PLE_DIM = 256

A_HEADS = 8
A_HEAD_DIM = 64
A_WIDTH = A_HEADS * A_HEAD_DIM
MOBA_BLOCK = 256
MOBA_TOPK = 3
MOBA_QCHUNK = 16

SSD_D_INNER = D_MODEL
SSD_HEAD_DIM = 64
SSD_HEADS = SSD_D_INNER // SSD_HEAD_DIM
SSD_GROUPS = 2
SSD_D_STATE = 128
SSD_CONV = 4
SSD_CHUNK = 256
SSD_CONV_DIM = SSD_D_INNER + 2 * SSD_GROUPS * SSD_D_STATE

MOE_GROUPS = 4
MOE_EXPERTS_PER_GROUP = 4
MOE_EXPERTS = MOE_GROUPS * MOE_EXPERTS_PER_GROUP
MOE_TOPK = 2
MOE_D_FF = 512

OFF_Q = 0
OFF_K = OFF_Q + A_WIDTH
OFF_V = OFF_K + A_WIDTH
OFF_Z = OFF_V + A_WIDTH
OFF_XBC = OFF_Z + SSD_D_INNER
OFF_DT = OFF_XBC + SSD_CONV_DIM
OFF_GA = OFF_DT + SSD_HEADS
OFF_GB = OFF_GA + D_MODEL
IN_DIM = OFF_GB + D_MODEL

kernel_name = 'hybrid_moba_ssd_hmoe_block'


def rms_norm(x, g):
    xf = x.astype(F32)
    y = xf * lax.rsqrt(jnp.mean(xf * xf, axis=-1, keepdims=True) + EPS)
    return (y * g.astype(F32)).astype(x.dtype)


def alibi_slopes(n):
    return 2.0 ** (-8.0 * jnp.arange(1, n + 1, dtype=F32) / n)


def moba_attention(q, k, v):
    bsz, s, nh, hd = q.shape
    nb = -(-s // MOBA_BLOCK)
    s_pad = nb * MOBA_BLOCK
    pad = ((0, 0), (0, s_pad - s), (0, 0), (0, 0))
    q, k, v = [jnp.pad(t, pad).transpose(0, 2, 1, 3) for t in (q, k, v)]
    scale = hd ** -0.5
    kb = k.reshape(bsz, nh, nb, MOBA_BLOCK, hd)
    vb = v.reshape(bsz, nh, nb, MOBA_BLOCK, hd)
    k_mean = jnp.mean(kb.astype(F32), axis=3)
    gate = jnp.einsum('bhtd,bhnd->bhtn', q.astype(F32), k_mean)
    q_blk = jnp.arange(s_pad) // MOBA_BLOCK
    past = jnp.arange(nb)[None, :] < q_blk[:, None]
    gate = jnp.where(past[None, None], gate, -jnp.inf)
    topk = min(MOBA_TOPK, nb)
    _, top_idx = lax.top_k(gate, topk)
    sel_valid = jnp.arange(topk)[None, :] < q_blk[:, None]
    slopes = alibi_slopes(nh)[None, :, None, None]
    bi = jnp.arange(bsz)[:, None, None, None]
    hi = jnp.arange(nh)[None, :, None, None]
    offs = jnp.arange(MOBA_BLOCK)
    n_chunks = s_pad // MOBA_QCHUNK

    def chunk(c):
        t0 = c * MOBA_QCHUNK
        qc = lax.dynamic_slice_in_dim(q, t0, MOBA_QCHUNK, axis=2)
        idx = lax.dynamic_slice_in_dim(top_idx, t0, MOBA_QCHUNK, axis=2)
        valid = lax.dynamic_slice_in_dim(sel_valid, t0, MOBA_QCHUNK, axis=0)
        t = t0 + jnp.arange(MOBA_QCHUNK)
        kg = kb[bi, hi, idx]
        vg = vb[bi, hi, idx]
        s_sel = jnp.einsum('bhqd,bhqkld->bhqkl', qc, kg, preferred_element_type=F32) * scale
        kpos = idx[..., None] * MOBA_BLOCK + offs
        s_sel = s_sel - slopes[..., None] * (t[:, None, None] - kpos).astype(F32)
        s_sel = jnp.where(valid[:, :, None], s_sel, -jnp.inf)
        blk0 = (t0 // MOBA_BLOCK) * MOBA_BLOCK
        ko = lax.dynamic_slice_in_dim(k, blk0, MOBA_BLOCK, axis=2)
        vo = lax.dynamic_slice_in_dim(v, blk0, MOBA_BLOCK, axis=2)
        s_own = jnp.einsum('bhqd,bhld->bhql', qc, ko, preferred_element_type=F32) * scale
        dist = t[:, None] - (blk0 + offs)[None, :]
        s_own = jnp.where(dist >= 0, s_own - slopes * dist.astype(F32), -jnp.inf)
        sc = jnp.concatenate([s_sel.reshape(bsz, nh, MOBA_QCHUNK, topk * MOBA_BLOCK), s_own], axis=-1)
        pr = jax.nn.softmax(sc, axis=-1).astype(v.dtype)
        p_sel = pr[..., :topk * MOBA_BLOCK].reshape(bsz, nh, MOBA_QCHUNK, topk, MOBA_BLOCK)
        p_own = pr[..., topk * MOBA_BLOCK:]
        return (jnp.einsum('bhqkl,bhqkld->bhqd', p_sel, vg)
                + jnp.einsum('bhql,bhld->bhqd', p_own, vo))

    out = lax.map(chunk, jnp.arange(n_chunks))
    out = out.transpose(1, 2, 0, 3, 4).reshape(bsz, nh, s_pad, hd)[:, :, :s]
    return out.transpose(0, 2, 1, 3)


def causal_depthwise_conv(u, w, b):
    c = u.shape[-1]
    out = lax.conv_general_dilated(u, w[:, None, :].astype(u.dtype), window_strides=(1,),
                                   padding=[(SSD_CONV - 1, 0)],
                                   dimension_numbers=('NWC', 'WIO', 'NWC'),
                                   feature_group_count=c)
    return out + b


def segsum(a):
    tlen = a.shape[-1]
    cs = jnp.cumsum(a, axis=-1)
    diff = cs[..., :, None] - cs[..., None, :]
    mask = jnp.tril(jnp.ones((tlen, tlen), dtype=bool))
    return jnp.where(mask, diff, -jnp.inf)


def ssd_chunked_scan(x, dt, a, b_in, c_in):
    bsz, s, nh, hp = x.shape
    ng, ns = b_in.shape[2], b_in.shape[3]
    hpg = nh // ng
    nc = -(-s // SSD_CHUNK)
    sp = nc * SSD_CHUNK

    def padt(t):
        return jnp.pad(t.astype(F32), [(0, 0), (0, sp - s)] + [(0, 0)] * (t.ndim - 2))

    x, dt, b_in, c_in = padt(x), padt(dt), padt(b_in), padt(c_in)
    xdt = (x * dt[..., None]).reshape(bsz, nc, SSD_CHUNK, ng, hpg, hp)
    da = (dt * a.astype(F32)).reshape(bsz, nc, SSD_CHUNK, ng, hpg).transpose(0, 3, 4, 1, 2)
    bc = b_in.reshape(bsz, nc, SSD_CHUNK, ng, ns)
    cc = c_in.reshape(bsz, nc, SSD_CHUNK, ng, ns)
    da_cs = jnp.cumsum(da, axis=-1)
    decay_in = jnp.exp(segsum(da))
    cb = jnp.einsum('bclgn,bcsgn->bgcls', cc, bc)
    y_diag = jnp.einsum('bgcls,bgjcls,bcsgjp->bclgjp', cb, decay_in, xdt)
    decay_to_end = jnp.exp(da_cs[..., -1:] - da_cs)
    chunk_states = jnp.einsum('bclgn,bgjcl,bclgjp->cbgjpn', bc, decay_to_end, xdt)
    chunk_decay = jnp.exp(da_cs[..., -1]).transpose(3, 0, 1, 2)

    def carry_state(h, inp):
        st, dec = inp
        return h * dec[..., None, None] + st, h

    h0 = jnp.zeros(chunk_states.shape[1:], F32)
    _, h_in = lax.scan(carry_state, h0, (chunk_states, chunk_decay))
    y_off = jnp.einsum('bclgn,cbgjpn,bgjcl->bclgjp', cc, h_in, jnp.exp(da_cs))
    return (y_diag + y_off).reshape(bsz, sp, nh, hp)[:, :s]


def ssd_mixer(z, xbc, dt_raw, conv_w, conv_b, dt_bias, a_log, d_skip, norm_g):
    bsz, s, _ = z.shape
    xbc = jax.nn.silu(causal_depthwise_conv(xbc, conv_w, conv_b))
    xs = xbc[..., :SSD_D_INNER].reshape(bsz, s, SSD_HEADS, SSD_HEAD_DIM)
    gs = SSD_GROUPS * SSD_D_STATE
    b_in = xbc[..., SSD_D_INNER:SSD_D_INNER + gs].reshape(bsz, s, SSD_GROUPS, SSD_D_STATE)
    c_in = xbc[..., SSD_D_INNER + gs:].reshape(bsz, s, SSD_GROUPS, SSD_D_STATE)
    dt = jax.nn.softplus(dt_raw.astype(F32) + dt_bias.astype(F32))
    a = -jnp.exp(a_log.astype(F32))
    y = ssd_chunked_scan(xs, dt, a, b_in, c_in)
    y = y + d_skip.astype(F32)[:, None] * xs.astype(F32)
    u = (y.reshape(bsz, s, SSD_D_INNER) * jax.nn.silu(z.astype(F32)))
    u = u.reshape(bsz, s, SSD_GROUPS, SSD_D_INNER // SSD_GROUPS)
    u = u * lax.rsqrt(jnp.mean(u * u, axis=-1, keepdims=True) + EPS)
    return (u.reshape(bsz, s, SSD_D_INNER) * norm_g.astype(F32)).astype(z.dtype)


def hier_moe(h, w_rg, b_rg, w_re, b_re, w_gate, w_up, w_down):
    bsz, s, _ = h.shape
    hf = h.astype(F32)
    g_logits = hf @ w_rg.astype(F32) + b_rg.astype(F32)
    g_prob = jax.nn.softmax(g_logits, axis=-1)
    g_pw, g_sel = lax.top_k(g_prob, 1)
    e_logits = (hf @ w_re.astype(F32) + b_re.astype(F32)).reshape(bsz, s, MOE_GROUPS, MOE_EXPERTS_PER_GROUP)
    e_in_group = jnp.take_along_axis(e_logits, g_sel[..., None], axis=2)[:, :, 0]
    e_val, e_idx = lax.top_k(e_in_group, MOE_TOPK)
    e_w = jax.nn.softmax(e_val, axis=-1) * g_pw
    expert_id = g_sel * MOE_EXPERTS_PER_GROUP + e_idx
    combine = jnp.sum(jax.nn.one_hot(expert_id, MOE_EXPERTS, dtype=F32) * e_w[..., None], axis=-2)
    out = jnp.zeros_like(h)
    for e in range(MOE_EXPERTS):
        he = jax.nn.silu(h @ w_gate[e]) * (h @ w_up[e])
        out = out + combine[..., e:e + 1].astype(h.dtype) * (he @ w_down[e])
    return out


def setup_inputs(seed: int = 0) -> dict:
    key = jax.random.key(seed)
    ks = jax.random.split(key, 24)
    nrm = jax.random.normal

    def gain(k, n):
        return 1.0 + 0.02 * nrm(k, (DEPTH, n), F32)

    dt0 = jnp.exp(jax.random.uniform(ks[6], (DEPTH, SSD_HEADS), F32)
                  * (math.log(0.1) - math.log(1e-3)) + math.log(1e-3))
    return {
        'x': nrm(ks[0], (BATCH, SEQ, D_MODEL), F32),
        'p': nrm(ks[1], (DEPTH, BATCH, SEQ, PLE_DIM), F32),
        'mix_norm_g': gain(ks[2], D_MODEL),
        'w_in': nrm(ks[3], (DEPTH, D_MODEL, IN_DIM), F32) * D_MODEL ** -0.5,
        'conv_w': nrm(ks[4], (DEPTH, SSD_CONV, SSD_CONV_DIM), F32) * SSD_CONV ** -0.5,
        'conv_b': 0.02 * nrm(ks[5], (DEPTH, SSD_CONV_DIM), F32),
        'dt_bias': dt0 + jnp.log(-jnp.expm1(-dt0)),
        'a_log': jnp.log(jax.random.uniform(ks[7], (DEPTH, SSD_HEADS), F32, minval=1.0, maxval=16.0)),
        'd_skip': gain(ks[8], SSD_HEADS),
        'ssd_norm_g': gain(ks[9], SSD_D_INNER),
        'w_out_a': nrm(ks[10], (DEPTH, A_WIDTH, D_MODEL), F32) * A_WIDTH ** -0.5,
        'w_out_b': nrm(ks[11], (DEPTH, SSD_D_INNER, D_MODEL), F32) * SSD_D_INNER ** -0.5,
        'w_out': nrm(ks[12], (DEPTH, D_MODEL, D_MODEL), F32) * D_MODEL ** -0.5,
        'ffn_norm_g': gain(ks[13], D_MODEL),
        'w_rg': nrm(ks[14], (DEPTH, D_MODEL, MOE_GROUPS), F32) * D_MODEL ** -0.5,
        'b_rg': 0.01 * nrm(ks[15], (DEPTH, MOE_GROUPS), F32),
        'w_re': nrm(ks[16], (DEPTH, D_MODEL, MOE_EXPERTS), F32) * D_MODEL ** -0.5,
        'b_re': 0.01 * nrm(ks[17], (DEPTH, MOE_EXPERTS), F32),
        'w_gate': nrm(ks[18], (DEPTH, MOE_EXPERTS, D_MODEL, MOE_D_FF), F32) * D_MODEL ** -0.5,
        'w_up': nrm(ks[19], (DEPTH, MOE_EXPERTS, D_MODEL, MOE_D_FF), F32) * D_MODEL ** -0.5,
        'w_down': nrm(ks[20], (DEPTH, MOE_EXPERTS, MOE_D_FF, D_MODEL), F32) * MOE_D_FF ** -0.5,
        'w_ple_proj': nrm(ks[21], (DEPTH, PLE_DIM, D_MODEL), F32) * PLE_DIM ** -0.5,
        'w_ple_gate': nrm(ks[22], (DEPTH, D_MODEL, D_MODEL), F32) * D_MODEL ** -0.5,
        'final_norm_g': 1.0 + 0.02 * nrm(ks[23], (D_MODEL,), F32),
    }


def reference(x, p, mix_norm_g, w_in, conv_w, conv_b, dt_bias, a_log, d_skip, ssd_norm_g,
              w_out_a, w_out_b, w_out, ffn_norm_g, w_rg, b_rg, w_re, b_re, w_gate, w_up,
              w_down, w_ple_proj, w_ple_gate, final_norm_g):
    bsz, s, _ = x.shape
    for i in range(DEPTH):
        h = rms_norm(x, mix_norm_g[i])
        proj = h @ w_in[i]
        q = proj[..., OFF_Q:OFF_K].reshape(bsz, s, A_HEADS, A_HEAD_DIM)
        k = proj[..., OFF_K:OFF_V].reshape(bsz, s, A_HEADS, A_HEAD_DIM)
        v = proj[..., OFF_V:OFF_Z].reshape(bsz, s, A_HEADS, A_HEAD_DIM)
        z = proj[..., OFF_Z:OFF_XBC]
        xbc = proj[..., OFF_XBC:OFF_DT]
        dt_raw = proj[..., OFF_DT:OFF_GA]
        gate_a = jax.nn.sigmoid(proj[..., OFF_GA:OFF_GB])
        gate_b = jax.nn.sigmoid(proj[..., OFF_GB:IN_DIM])
        y_a = moba_attention(q, k, v).reshape(bsz, s, A_WIDTH) @ w_out_a[i]
        y_b = ssd_mixer(z, xbc, dt_raw, conv_w[i], conv_b[i], dt_bias[i], a_log[i],
                        d_skip[i], ssd_norm_g[i]) @ w_out_b[i]
        x = x + (gate_a * y_a + gate_b * y_b) @ w_out[i]
        h2 = rms_norm(x, ffn_norm_g[i])
        x = x + hier_moe(h2, w_rg[i], b_rg[i], w_re[i], b_re[i], w_gate[i], w_up[i], w_down[i])
        x = x + jax.nn.sigmoid(x @ w_ple_gate[i]) * (p[i] @ w_ple_proj[i])
    return rms_norm(x, final_norm_g)
```

```cpp
#include <hip/hip_runtime.h>
#include <cstdio>
#include <cstdint>

#define LAS __attribute__((address_space(3)))
#define GAS __attribute__((address_space(1)))
typedef unsigned short bf16;
typedef short bf16x8 __attribute__((ext_vector_type(8)));
typedef float f32x4 __attribute__((ext_vector_type(4)));
typedef float f32x2 __attribute__((ext_vector_type(2)));
typedef unsigned u32x4 __attribute__((ext_vector_type(4)));
typedef unsigned u32x2 __attribute__((ext_vector_type(2)));

constexpr int M = 16384, DM = 1024, SEQ = 2048, NBATCH = 8;
constexpr int AH = 8, AD = 64, AW = 512, MBLK = 256, NBLK = 8;
constexpr int SH = 16, SPD = 64, SN = 128, CONVD = 1536, NCH = 8;
constexpr int NE = 16, FF = 512, NCLS = 24;
constexpr int PLE = 256;
constexpr int IN_DIM = 6160, OFF_DT = 4096, OFF_GA = 4112;
constexpr float EPS = 1e-6f;
constexpr float LOG2E = 1.4426950408889634f;
constexpr float C2 = 0.125f * LOG2E;
constexpr int MAXRT = 88;

constexpr size_t MiB = 1u << 20;
constexpr size_t WS_CTL = 0, CTL_ZERO_BYTES = 64 * 1024;
constexpr size_t WS_BCAT = 1 * MiB;
constexpr size_t WS_WOUT = 4 * MiB;
constexpr size_t WS_WPG = 6 * MiB;
constexpr size_t WS_DTRAW = 8 * MiB;
constexpr size_t WS_DT = 9 * MiB;
constexpr size_t WS_CS = 10 * MiB;
constexpr size_t WS_SUMSQ = 11 * MiB;
constexpr size_t WS_KMEAN = 12 * MiB;
constexpr size_t WS_CLS = 12 * MiB + 512 * 1024;
constexpr size_t WS_WTS = 12 * MiB + 768 * 1024;
constexpr size_t WS_HIST = 13 * MiB;
constexpr size_t WS_TILES = 13 * MiB + 256 * 1024;
constexpr size_t WS_PERM = 13 * MiB + 512 * 1024;
constexpr size_t WS_WPOS = 14 * MiB;
constexpr size_t WS_Q = 16 * MiB, WS_K = 32 * MiB, WS_V = 48 * MiB;
constexpr size_t WS_WGU = 16 * MiB;
constexpr size_t WS_WD = 48 * MiB;
constexpr size_t WS_Z = 64 * MiB;
constexpr size_t WS_MERGED = 64 * MiB;
constexpr size_t WS_H2B = 64 * MiB;
constexpr size_t WS_X2B = 64 * MiB;
constexpr size_t WS_XBC = 96 * MiB;
constexpr size_t WS_ACAT = 96 * MiB;
constexpr size_t WS_XS = 96 * MiB;
constexpr size_t WS_ACAT2 = 144 * MiB;
constexpr size_t WS_XBCACT = 144 * MiB;
constexpr size_t WS_HID = 144 * MiB;
constexpr size_t WS_PP = 192 * MiB;
constexpr size_t WS_WCAT2 = 224 * MiB;
constexpr size_t WS_STATES = 224 * MiB;
constexpr size_t WS_END = 256 * MiB;

constexpr int CW_BAR = 1024;

#define RLX_AGENT __ATOMIC_RELAXED, __HIP_MEMORY_SCOPE_AGENT
#define LDS_WAIT() asm volatile("s_waitcnt lgkmcnt(0)" ::: "memory")
#define VM_WAIT() asm volatile("s_waitcnt vmcnt(0)" ::: "memory")
__device__ __forceinline__ unsigned f2bf(float f) { unsigned u = __builtin_bit_cast(unsigned, f); return (u + 0x7fffu + ((u >> 16) & 1u)) >> 16; }
__device__ __forceinline__ unsigned pk2(float lo, float hi) { return f2bf(lo) | (f2bf(hi) << 16); }
__device__ __forceinline__ float bf2f(unsigned b) { return __builtin_bit_cast(float, b << 16); }
__device__ __forceinline__ float bflo(unsigned w) { return __builtin_bit_cast(float, w << 16); }
__device__ __forceinline__ float bfhi(unsigned w) { return __builtin_bit_cast(float, w & 0xffff0000u); }
__device__ __forceinline__ float sigmoidf_(float x) { return __builtin_amdgcn_rcpf(1.f + __builtin_amdgcn_exp2f(-x * LOG2E)); }
__device__ __forceinline__ float wave_sum(float v) {
#pragma unroll
    for (int o = 1; o < 64; o <<= 1) v += __shfl_xor(v, o);
    return v;
}

#define XB_TMO      128
#define XB_XCNT(j)  (256  + 64 * (j))
#define XB_XSUB(j)  (1280 + 64 * (j))
#define XB_XGEN(j)  (2304 + 64 * (j))
#define XB_TOP      3328
#define XB_TOPGEN   3392
#define XCD_BAR_WORDS 3456
#define XB_SPIN_CAP (1u << 20)
__device__ __forceinline__ unsigned xb_ld(unsigned* p)              { return __hip_atomic_load(p, __ATOMIC_RELAXED, __HIP_MEMORY_SCOPE_AGENT); }
__device__ __forceinline__ unsigned xb_add(unsigned* p, unsigned v) { return __hip_atomic_fetch_add(p, v, __ATOMIC_RELAXED, __HIP_MEMORY_SCOPE_AGENT); }
__device__ __forceinline__ unsigned xb_xcc_id() { return (unsigned)__builtin_amdgcn_s_getreg((3 << 11) | 20) & 0xFu; }
#define XB_SPIN(cond, bar) do { unsigned _sp = 0; while (cond) { __builtin_amdgcn_s_sleep(1); \
    if ((++_sp & 255u) == 0u) { if (xb_ld(&(bar)[XB_TMO])) break; if (_sp > XB_SPIN_CAP) { atomicAdd(&(bar)[XB_TMO], 1u); break; } } } } while (0)
struct XcdBarrier { unsigned* bar; unsigned x; volatile LAS unsigned* st; };
__device__ __forceinline__ XcdBarrier xcd_barrier_post(unsigned* bar, volatile LAS unsigned* st) {
    XcdBarrier b; b.bar = bar; b.x = xb_xcc_id(); b.st = st;
    if (threadIdx.x == 0) (void)xb_add(&bar[XB_XCNT(b.x)], 1u);
    return b;
}
__device__ __forceinline__ void xcd_barrier_complete(unsigned* bar, unsigned x, unsigned& nloc, unsigned& nx) {
    const unsigned G = gridDim.x * gridDim.y * gridDim.z;
    unsigned sum, cnt, mine, sp = 0u;
    for (;;) {
        sum = 0u; cnt = 0u; mine = 0u;
#pragma unroll
        for (unsigned j = 0; j < 16; ++j) { const unsigned c = xb_ld(&bar[XB_XCNT(j)]); sum += c; cnt += (c > 0u) ? 1u : 0u; mine = (j == x) ? c : mine; }
        if (sum == G) break;
        __builtin_amdgcn_s_sleep(1);
        if ((++sp & 255u) == 0u) { if (xb_ld(&bar[XB_TMO])) break; if (sp > XB_SPIN_CAP) { atomicAdd(&bar[XB_TMO], 1u); break; } }
    }
    nloc = mine > 0u ? mine : 1u; nx = cnt > 0u ? cnt : 1u;
}
__device__ __forceinline__ void xcd_barrier(const XcdBarrier& b) {
    asm volatile("s_waitcnt vmcnt(0)" ::: "memory");
    __syncthreads();
    if (threadIdx.x == 0) {
        unsigned* bar = b.bar;
        __builtin_amdgcn_s_waitcnt(0);
        unsigned nloc = b.st[0], nx = b.st[1];
        if (nloc == 0u) { xcd_barrier_complete(bar, b.x, nloc, nx); b.st[0] = nloc; b.st[1] = nx; }
        const unsigned old = xb_add(&bar[XB_XSUB(b.x)], 1u);
        const unsigned gen = old / nloc;
        if (old + 1u == (gen + 1u) * nloc) {
            __builtin_amdgcn_fence(__ATOMIC_RELEASE, "agent");
            asm volatile("s_waitcnt vmcnt(0)" ::: "memory");
            const unsigned og = xb_add(&bar[XB_TOP], 1u);
            const unsigned tg = og / nx;
            if (og + 1u == (tg + 1u) * nx) xb_add(&bar[XB_TOPGEN], 1u);
            else XB_SPIN(xb_ld(&bar[XB_TOPGEN]) == tg, bar);
            __builtin_amdgcn_fence(__ATOMIC_ACQUIRE, "agent");
            xb_add(&bar[XB_XGEN(b.x)], 1u);
            asm volatile("s_waitcnt vmcnt(0)" ::: "memory");
        } else {
            XB_SPIN(xb_ld(&bar[XB_XGEN(b.x)]) == gen, bar);
            __builtin_amdgcn_fence(__ATOMIC_ACQUIRE, "agent");
            asm volatile("s_waitcnt vmcnt(0)" ::: "memory");
        }
    }
    __syncthreads();
}

namespace pg8 {
constexpr int BM = 256, BK = 64, HALF = 128, HTB = HALF * BK * 2, STAGE_BYTES = 8 * HTB, NXCD = 8, WGM = 8;
__host__ __device__ __forceinline__ int lds_byte(int r, int c) { const int st = (r >> 4) * 2 + (c >> 5), rr = r & 15, cc = c & 31, ob = rr * 64 + cc * 2; return st * 1024 + (ob ^ (((ob >> 9) & 1) << 5)); }
__host__ __device__ __forceinline__ void stage_rc(int b, int& R, int& C) { const int st = b / 1024, sb = b % 1024, swz = sb ^ (((sb >> 9) & 1) << 5); R = (st >> 1) * 16 + swz / 64; C = (st & 1) * 32 + (swz % 64) / 2; }
__host__ __device__ __forceinline__ int perm32(int rho) { const int n = rho >> 4, i = rho & 15; return 8 * (i >> 2) + 4 * n + (i & 3); }

struct Unit { int pm, pn, aux, nt; size_t offA, offB; };
struct Gemm { const bf16* A; const bf16* Bt; int lda, ldb; };

__device__ __forceinline__ void tile_of(int L, int nM, int nN, int& pm, int& pn) {
    const int nwg = nM * nN; int wgid = L;
    { const int q = nwg / NXCD, r = nwg % NXCD, xcd = wgid % NXCD, off = wgid / NXCD; wgid = (xcd < r ? xcd * (q + 1) : r * (q + 1) + (xcd - r) * q) + off; }
    const int nig = WGM * nN, gid = wgid / nig, fm = gid * WGM, gsz = (nM - fm) < WGM ? (nM - fm) : WGM;
    pm = fm + ((wgid % nig) % gsz); pn = (wgid % nig) / gsz;
}
__device__ __forceinline__ unsigned cvt_pk_bf16(float lo, float hi) { unsigned r; asm volatile("v_cvt_pk_bf16_f32 %0, %1, %2" : "=v"(r) : "v"(lo), "v"(hi)); return r; }

typedef f32x4 Acc[2][2][4][2];

template <class Epi, class Sched>
__device__ __forceinline__ void gemm_simple(const Gemm g, const Sched& S, const Epi& E) {
    const int tid = threadIdx.x, wid = __builtin_amdgcn_readfirstlane(tid >> 6), lane = tid & 63, wr = wid >> 2, wc = wid & 3, fr = lane & 15, fq = lane >> 4;
    Unit cur; Acc acc;
#pragma unroll
    for (int a = 0; a < 2; ++a)
#pragma unroll
        for (int b = 0; b < 2; ++b)
#pragma unroll
            for (int m = 0; m < 4; ++m)
#pragma unroll
                for (int n = 0; n < 2; ++n) acc[a][b][m][n] = (f32x4){0.f, 0.f, 0.f, 0.f};
    for (int ui = 0; S.next(ui, cur); ++ui) {
        const char* cA = (const char*)g.A + cur.offA; const char* cB = (const char*)g.Bt + cur.offB;
        for (int kt = 0; kt < cur.nt * 2; ++kt) {
#pragma unroll
            for (int ai = 0; ai < 2; ++ai) {
                bf16x8 af[4];
#pragma unroll
                for (int m = 0; m < 4; ++m) af[m] = *(const bf16x8*)(cA + ((size_t)(ai * HALF + wr * 64 + m * 16 + fr) * g.lda + kt * 32 + fq * 8) * 2);
#pragma unroll
                for (int bj = 0; bj < 2; ++bj)
#pragma unroll
                    for (int n = 0; n < 2; ++n) {
                        const int rr = n * 16 + fr, br = bj * HALF + wc * 32 + (Epi::PERM ? perm32(rr) : rr);
                        const bf16x8 bfr = *(const bf16x8*)(cB + ((size_t)br * g.ldb + kt * 32 + fq * 8) * 2);
#pragma unroll
                        for (int m = 0; m < 4; ++m) acc[ai][bj][m][n] = __builtin_amdgcn_mfma_f32_16x16x32_bf16(bfr, af[m], acc[ai][bj][m][n], 0, 0, 0);
                    }
            }
        }
        E(acc, cur, wr, wc, fr, fq);
        if (!E.keep(cur)) {
#pragma unroll
            for (int a = 0; a < 2; ++a)
#pragma unroll
                for (int b = 0; b < 2; ++b)
#pragma unroll
                    for (int m = 0; m < 4; ++m)
#pragma unroll
                        for (int n = 0; n < 2; ++n) acc[a][b][m][n] = (f32x4){0.f, 0.f, 0.f, 0.f};
        }
    }
}

template <class Epi, class Sched, bool ALIGN_EPI = true, bool SP2 = true>
__device__ __forceinline__ void gemm_phase(LAS unsigned char* lds, const Gemm g, const Sched& S, const Epi& E) {
    const int tid = threadIdx.x, wid = __builtin_amdgcn_readfirstlane(tid >> 6), lane = tid & 63, wr = wid >> 2, wc = wid & 3, fr = lane & 15, fq = lane >> 4;
    unsigned voffA[2], voffB[2];
#pragma unroll
    for (int i = 0; i < 2; ++i) { int R, C; stage_rc(tid * 16 + i * 8192, R, C); const int Rb = Epi::PERM ? ((R & ~31) + perm32(R & 31)) : R;
        voffA[i] = (unsigned)(R * g.lda + C) * 2u; voffB[i] = (unsigned)(Rb * g.ldb + C) * 2u; }
    const size_t kstep = (size_t)(BK * 2);
    const size_t hstepA = (size_t)HALF * g.lda * 2, hstepB = (size_t)HALF * g.ldb * 2;
    const unsigned ldsw = (unsigned)wid * 1024u;
    const int aoff = lds_byte(wr * 64 + fr, fq * 8), boff = lds_byte(wc * 32 + fr, fq * 8);
#define PG8_SA(b, h) (((b) * 2 + (h)) * HTB)
#define PG8_SB(b, h) ((4 + (b) * 2 + (h)) * HTB)
#define PG8_STAGE(bufoff, gbase, voff) do { _Pragma("unroll") for (int _i = 0; _i < 2; ++_i) \
        __builtin_amdgcn_global_load_lds((const unsigned*)((const char*)(gbase) + (voff)[_i]), (LAS unsigned*)(lds + (bufoff) + ldsw + _i * 8192), 16, 0, 0); } while (0)
#define PG8_LDA(dst, b, h) do { _Pragma("unroll") for (int m = 0; m < 4; ++m) _Pragma("unroll") for (int k = 0; k < 2; ++k) dst[m][k] = *(const LAS bf16x8*)(lds + PG8_SA(b, h) + aoff + m * 2048 + k * 1024); } while (0)
#define PG8_LDB(dst, b, h) do { _Pragma("unroll") for (int n = 0; n < 2; ++n) _Pragma("unroll") for (int k = 0; k < 2; ++k) dst[n][k] = *(const LAS bf16x8*)(lds + PG8_SB(b, h) + boff + n * 2048 + k * 1024); } while (0)
#define PG8_MMA(ai, bj, At, Bt) do { __builtin_amdgcn_s_setprio(1); _Pragma("unroll") for (int m = 0; m < 4; ++m) _Pragma("unroll") for (int n = 0; n < 2; ++n) _Pragma("unroll") for (int k = 0; k < 2; ++k) \
        acc[ai][bj][m][n] = __builtin_amdgcn_mfma_f32_16x16x32_bf16(Bt[n][k], At[m][k], acc[ai][bj][m][n], 0, 0, 0); __builtin_amdgcn_s_setprio(0); } while (0)
#define PG8_WAIT_V(n) asm volatile("s_waitcnt vmcnt(" #n ")" ::: "memory")
#define PG8_WAIT_L(n) asm volatile("s_waitcnt lgkmcnt(" #n ")" ::: "memory")
#define PG8_BAR __builtin_amdgcn_s_barrier()
#define PG8_SCHED __builtin_amdgcn_sched_barrier(0)
    Unit cur, nxt; int ui = 0;
    if (!S.next(0, cur)) return;
    Acc acc;
#pragma unroll
    for (int a = 0; a < 2; ++a)
#pragma unroll
        for (int b = 0; b < 2; ++b)
#pragma unroll
            for (int m = 0; m < 4; ++m)
#pragma unroll
                for (int n = 0; n < 2; ++n) acc[a][b][m][n] = (f32x4){0.f, 0.f, 0.f, 0.f};
    bf16x8 At[4][2], B0[2][2], B1[2][2];
    const char* cA = (const char*)g.A + cur.offA; const char* cB = (const char*)g.Bt + cur.offB;
    if constexpr (SP2) {
        PG8_STAGE(PG8_SB(0, 0), cB, voffB); PG8_STAGE(PG8_SB(0, 1), cB + hstepB, voffB); PG8_STAGE(PG8_SA(0, 0), cA, voffA); PG8_STAGE(PG8_SA(0, 1), cA + hstepA, voffA);
        if (wr == 1) PG8_BAR;
        PG8_WAIT_V(2); PG8_BAR;
        PG8_STAGE(PG8_SB(1, 0), cB + kstep, voffB); PG8_STAGE(PG8_SA(1, 0), cA + kstep, voffA); PG8_STAGE(PG8_SB(1, 1), cB + hstepB + kstep, voffB);
        PG8_WAIT_V(6); PG8_BAR;
    } else {
        PG8_STAGE(PG8_SB(0, 0), cB, voffB); PG8_STAGE(PG8_SA(0, 0), cA, voffA); PG8_STAGE(PG8_SB(0, 1), cB + hstepB, voffB); PG8_STAGE(PG8_SA(0, 1), cA + hstepA, voffA);
        if (wr == 1) PG8_BAR;
        PG8_WAIT_V(4); PG8_BAR;
        PG8_STAGE(PG8_SB(1, 0), cB + kstep, voffB); PG8_STAGE(PG8_SA(1, 0), cA + kstep, voffA); PG8_STAGE(PG8_SB(1, 1), cB + hstepB + kstep, voffB);
        PG8_WAIT_V(6); PG8_BAR;
    }
    for (;;) {
        const bool has_next = S.next(ui + 1, nxt);
        const char* nA = has_next ? (const char*)g.A + nxt.offA : cA; const char* nB = has_next ? (const char*)g.Bt + nxt.offB : cB;
        const int nt = cur.nt;
        for (int t = 0; t < nt; t += 2) {
            const bool last = (t == nt - 2);
            const char* a1 = cA + (size_t)(t + 1) * kstep;
            const char* a2 = last ? nA : cA + (size_t)(t + 2) * kstep; const char* b2 = last ? nB : cB + (size_t)(t + 2) * kstep;
            const char* a3 = a2 + kstep; const char* b3 = b2 + kstep;
            if constexpr (SP2) {
            PG8_LDB(B0, 0, 0); PG8_LDB(B1, 0, 1); PG8_SCHED; PG8_LDA(At, 0, 0); PG8_STAGE(PG8_SA(1, 1), a1 + hstepA, voffA);
            PG8_WAIT_V(8); PG8_WAIT_L(0); PG8_BAR; PG8_MMA(0, 0, At, B0); PG8_MMA(0, 1, At, B1); PG8_BAR; PG8_SCHED;
            PG8_LDA(At, 0, 1); PG8_STAGE(PG8_SB(0, 0), b2, voffB); PG8_STAGE(PG8_SB(0, 1), b2 + hstepB, voffB); PG8_STAGE(PG8_SA(0, 0), a2, voffA);
            PG8_WAIT_V(8); PG8_WAIT_L(0); PG8_BAR; PG8_MMA(1, 0, At, B0); PG8_MMA(1, 1, At, B1); PG8_BAR; PG8_SCHED;
            PG8_LDB(B0, 1, 0); PG8_LDB(B1, 1, 1); PG8_SCHED; PG8_LDA(At, 1, 0); PG8_STAGE(PG8_SA(0, 1), a2 + hstepA, voffA);
            PG8_WAIT_V(8); PG8_WAIT_L(0); PG8_BAR; PG8_MMA(0, 0, At, B0); PG8_MMA(0, 1, At, B1); PG8_BAR; PG8_SCHED;
            PG8_LDA(At, 1, 1); PG8_STAGE(PG8_SB(1, 0), b3, voffB); PG8_STAGE(PG8_SB(1, 1), b3 + hstepB, voffB); PG8_STAGE(PG8_SA(1, 0), a3, voffA);
            PG8_WAIT_V(8); PG8_WAIT_L(0); PG8_BAR; PG8_MMA(1, 0, At, B0); PG8_MMA(1, 1, At, B1); PG8_BAR; PG8_SCHED;
            } else {
            PG8_LDB(B0, 0, 0); PG8_SCHED; PG8_LDA(At, 0, 0); PG8_STAGE(PG8_SA(1, 1), a1 + hstepA, voffA);
            PG8_WAIT_L(8); PG8_BAR; PG8_WAIT_L(0); PG8_MMA(0, 0, At, B0); PG8_BAR; PG8_SCHED;
            PG8_LDB(B1, 0, 1); PG8_STAGE(PG8_SB(0, 0), b2, voffB);
            PG8_BAR; PG8_WAIT_L(0); PG8_MMA(0, 1, At, B1); PG8_BAR;
            PG8_LDA(At, 0, 1); PG8_STAGE(PG8_SA(0, 0), a2, voffA);
            PG8_BAR; PG8_WAIT_L(0); PG8_MMA(1, 0, At, B0); PG8_BAR; PG8_SCHED;
            PG8_STAGE(PG8_SB(0, 1), b2 + hstepB, voffB);
            PG8_WAIT_V(6); PG8_BAR; PG8_MMA(1, 1, At, B1); PG8_BAR;
            PG8_LDB(B0, 1, 0); PG8_SCHED; PG8_LDA(At, 1, 0); PG8_STAGE(PG8_SA(0, 1), a2 + hstepA, voffA);
            PG8_WAIT_L(8); PG8_BAR; PG8_WAIT_L(0); PG8_MMA(0, 0, At, B0); PG8_BAR; PG8_SCHED;
            PG8_LDB(B1, 1, 1); PG8_STAGE(PG8_SB(1, 0), b3, voffB);
            PG8_BAR; PG8_WAIT_L(0); PG8_MMA(0, 1, At, B1); PG8_BAR;
            PG8_LDA(At, 1, 1); PG8_STAGE(PG8_SA(1, 0), a3, voffA);
            PG8_BAR; PG8_WAIT_L(0); PG8_MMA(1, 0, At, B0); PG8_BAR; PG8_SCHED;
            PG8_STAGE(PG8_SB(1, 1), b3 + hstepB, voffB);
            PG8_WAIT_V(6); PG8_BAR; PG8_MMA(1, 1, At, B1); PG8_BAR;
            }
        }
        if constexpr (ALIGN_EPI) { if (wr == 0) PG8_BAR; }
        E(acc, cur, wr, wc, fr, fq);
        if (!has_next) break;
        if (!E.keep(cur)) {
#pragma unroll
            for (int a = 0; a < 2; ++a)
#pragma unroll
                for (int b = 0; b < 2; ++b)
#pragma unroll
                    for (int m = 0; m < 4; ++m)
#pragma unroll
                        for (int n = 0; n < 2; ++n) acc[a][b][m][n] = (f32x4){0.f, 0.f, 0.f, 0.f};
        }
        cur = nxt; cA = nA; cB = nB; ++ui;
        if constexpr (ALIGN_EPI) { if (wr == 1) PG8_BAR; }
    }
    PG8_WAIT_V(0);
    if constexpr (!ALIGN_EPI) { if (wr == 0) PG8_BAR; }
    PG8_BAR;
#undef PG8_SA
#undef PG8_SB
#undef PG8_STAGE
#undef PG8_LDA
#undef PG8_LDB
#undef PG8_MMA
#undef PG8_WAIT_V
#undef PG8_WAIT_L
#undef PG8_BAR
#undef PG8_SCHED
}
}

#ifndef USE_FAST_GEMM
#define USE_FAST_GEMM 1
#endif
template <class Epi, class Sched>
__device__ __forceinline__ void run_gemm(LAS unsigned char* lds, const pg8::Gemm g, const Sched& S, const Epi& E) {
#if USE_FAST_GEMM
    pg8::gemm_phase<Epi, Sched, true, true>(lds, g, S, E);
#else
    pg8::gemm_simple<Epi, Sched>(g, S, E);
#endif
}

constexpr int NWAVES = 8;
constexpr int RING_BYTES = 131072;
constexpr int LDS_BYTES = 147456;
constexpr int MISC_OFF = LDS_BYTES - 128;

struct Args {
    const float* in[24]; float* out; unsigned char* ws; int ph_lo, ph_hi, li, pad;
};
enum { I_X = 0, I_P, I_MIXG, I_WIN, I_CONVW, I_CONVB, I_DTB, I_ALOG, I_DSKIP, I_SSDG, I_WOA, I_WOB, I_WOUT, I_FFNG, I_WRG, I_BRG, I_WRE, I_BRE, I_WGATE, I_WUP, I_WDOWN, I_WPP, I_WPG, I_FING };

struct Frame {
    LAS unsigned char* lds;
    int tid, lane, wave, vcu, G;
    const float* const* in; float* out; unsigned char* ws;
};

__device__ __forceinline__ void transpose_item(const float* W, int ldsrc, int k0, int c0, bf16* WT, int ldt, int r0, int kd0, LAS float* scr, int lane) {
#pragma unroll 8
    for (int i = 0; i < 32; ++i) { const int kk = 2 * i + (lane >> 5); scr[kk * 33 + (lane & 31)] = W[(size_t)(k0 + kk) * ldsrc + c0 + (lane & 31)]; }
    LDS_WAIT(); asm volatile("" ::: "memory");
    const int c = lane & 7;
#pragma unroll
    for (int j = 0; j < 4; ++j) { const int n = (lane >> 3) + 8 * j; const LAS float* s = scr + (8 * c) * 33 + n;
        u32x4 o; o.x = pk2(s[0 * 33], s[1 * 33]); o.y = pk2(s[2 * 33], s[3 * 33]); o.z = pk2(s[4 * 33], s[5 * 33]); o.w = pk2(s[6 * 33], s[7 * 33]);
        *(GAS u32x4*)(WT + (size_t)(r0 + n) * ldt + kd0 + k0 + 8 * c) = o; }
    LDS_WAIT(); asm volatile("" ::: "memory");
}

__device__ __forceinline__ void phase_prologue(Frame& F) {
    const int gw = F.vcu * NWAVES + F.wave, NGW = F.G * NWAVES;
    LAS float* scr = (LAS float*)(F.lds + F.wave * 8704);
    bf16* WCAT2 = (bf16*)(F.ws + WS_WCAT2); bf16* BCAT = (bf16*)(F.ws + WS_BCAT); bf16* WOUT = (bf16*)(F.ws + WS_WOUT); bf16* WPG = (bf16*)(F.ws + WS_WPG);
    constexpr int I0 = 16 * 128, I1 = 16 * 64, I2 = 4 * 32, I3 = 8 * 32, I4 = 16 * 32, I5 = 16 * 32, I6 = 16 * 32, NIT = I0 + I1 + I2 + I3 + I4 + I5 + I6;
    for (int it = gw; it < NIT; it += NGW) {
        int r = it;
        if (r < I0) { transpose_item(F.in[I_WIN], IN_DIM, 64 * (r / 128), 32 * (r % 128), WCAT2, 1280, 32 * (r % 128), 0, scr, F.lane); continue; } r -= I0;
        if (r < I1) { transpose_item(F.in[I_WIN], IN_DIM, 64 * (r / 64), OFF_GA + 32 * (r % 64), WCAT2, 1280, 4096 + 32 * (r % 64), 0, scr, F.lane); continue; } r -= I1;
        if (r < I2) { transpose_item(F.in[I_WPP], DM, 64 * (r / 32), 32 * (r % 32), WCAT2, 1280, 6144 + 32 * (r % 32), 1024, scr, F.lane); continue; } r -= I2;
        if (r < I3) { transpose_item(F.in[I_WOA], DM, 64 * (r / 32), 32 * (r % 32), BCAT, 1536, 32 * (r % 32), 0, scr, F.lane); continue; } r -= I3;
        if (r < I4) { transpose_item(F.in[I_WOB], DM, 64 * (r / 32), 32 * (r % 32), BCAT, 1536, 32 * (r % 32), 512, scr, F.lane); continue; } r -= I4;
        if (r < I5) { transpose_item(F.in[I_WOUT], DM, 64 * (r / 32), 32 * (r % 32), WOUT, 1024, 32 * (r % 32), 0, scr, F.lane); continue; } r -= I5;
        transpose_item(F.in[I_WPG], DM, 64 * (r / 32), 32 * (r % 32), WPG, 1024, 32 * (r % 32), 0, scr, F.lane);
    }
    __syncthreads();
    LAS float* wdt = (LAS float*)(F.lds + 8 * 8704);
    for (int i = F.tid; i < 16 * 1024; i += NWAVES * 64) { const int k = i >> 4, c = i & 15; wdt[c * 1024 + k] = F.in[I_WIN][(size_t)k * IN_DIM + OFF_DT + c]; }
    __syncthreads();
    bf16* ACAT2 = (bf16*)(F.ws + WS_ACAT2); float* DTRAW = (float*)(F.ws + WS_DTRAW);
    const float* X = F.in[I_X]; const float* P = F.in[I_P]; const float* G = F.in[I_MIXG];
    for (int m = gw; m < M; m += NGW) {
        const GAS f32x4* xr = (const GAS f32x4*)(X + (size_t)m * DM) + F.lane;
        f32x4 v[4]; float s = 0.f;
#pragma unroll
        for (int j = 0; j < 4; ++j) { v[j] = xr[64 * j]; s += (v[j].x * v[j].x + v[j].y * v[j].y) + (v[j].z * v[j].z + v[j].w * v[j].w); }
        const float r = 1.0f / sqrtf(wave_sum(s) * (1.f / DM) + EPS);
        GAS unsigned long long* o8 = (GAS unsigned long long*)(ACAT2 + (size_t)m * 1280) + F.lane;
#pragma unroll
        for (int j = 0; j < 4; ++j) { const f32x4 gg = *((const GAS f32x4*)G + F.lane + 64 * j); v[j] = v[j] * r * gg;
            o8[64 * j] = (unsigned long long)pk2(v[j].x, v[j].y) | ((unsigned long long)pk2(v[j].z, v[j].w) << 32); }
        float dv = 0.f;
#pragma unroll 2
        for (int c = 0; c < 16; ++c) { float a = 0.f;
#pragma unroll
            for (int j = 0; j < 4; ++j) { const f32x4 w = *(const LAS f32x4*)(wdt + c * 1024 + 256 * j + 4 * F.lane); a += (v[j].x * w.x + v[j].y * w.y) + (v[j].z * w.z + v[j].w * w.w); }
            a = wave_sum(a); dv = (F.lane == c) ? a : dv; }
        if (F.lane < 16) DTRAW[(size_t)m * 16 + F.lane] = dv;
        const f32x4 pv = *((const GAS f32x4*)(P + (size_t)m * PLE) + F.lane);
        *((GAS unsigned long long*)(ACAT2 + (size_t)m * 1280 + 1024) + F.lane) = (unsigned long long)pk2(pv.x, pv.y) | ((unsigned long long)pk2(pv.z, pv.w) << 32);
    }
}

struct EpiProj {
    static constexpr bool PERM = true;
    bf16 *Q, *K, *V, *Z, *XBC, *GA, *GB, *PP;
    __device__ __forceinline__ bool keep(const pg8::Unit&) const { return false; }
    __device__ __forceinline__ void operator()(pg8::Acc& acc, const pg8::Unit& u, int wr, int wc, int fr, int fq) const {
        const int pn = u.pn; bf16* base; int ldc, colt, act = 0;
        if (pn < 2) { base = Q; ldc = 512; colt = pn * 256; act = 1; }
        else if (pn < 4) { base = K; ldc = 512; colt = (pn - 2) * 256; }
        else if (pn < 6) { base = V; ldc = 512; colt = (pn - 4) * 256; }
        else if (pn < 10) { base = Z; ldc = 1024; colt = (pn - 6) * 256; }
        else if (pn < 16) { base = XBC; ldc = 1536; colt = (pn - 10) * 256; }
        else if (pn < 20) { base = GA; ldc = 1024; colt = (pn - 16) * 256; act = 2; }
        else if (pn < 24) { base = GB; ldc = 1024; colt = (pn - 20) * 256; act = 2; }
        else { base = PP; ldc = 1024; colt = (pn - 24) * 256; }
        const int row0 = u.pm * 256 + wr * 64 + fr, col0 = colt + wc * 32 + 8 * fq;
#pragma unroll
        for (int ai = 0; ai < 2; ++ai)
#pragma unroll
            for (int m = 0; m < 4; ++m) { bf16* rowp = base + (size_t)(row0 + ai * 128 + m * 16) * ldc + col0;
#pragma unroll
                for (int bj = 0; bj < 2; ++bj) { f32x4 v0 = acc[ai][bj][m][0], v1 = acc[ai][bj][m][1];
                    if (act == 1) { v0 = v0 * C2; v1 = v1 * C2; }
                    if (act == 2) {
#pragma unroll
                        for (int j = 0; j < 4; ++j) { v0[j] = sigmoidf_(v0[j]); v1[j] = sigmoidf_(v1[j]); } }
                    u32x4 w; w.x = pg8::cvt_pk_bf16(v0[0], v0[1]); w.y = pg8::cvt_pk_bf16(v0[2], v0[3]); w.z = pg8::cvt_pk_bf16(v1[0], v1[1]); w.w = pg8::cvt_pk_bf16(v1[2], v1[3]);
                    *(u32x4*)(rowp + bj * 128) = w; } }
    }
};
struct SchedProj {
    int G, c;
    __device__ __forceinline__ bool next(int i, pg8::Unit& u) const {
        const int L = i * G + c; constexpr int NP = 64 * 24, NQ = 64 * 4;
        if (L >= NP + NQ) return false;
        int pm, pn;
        if (L < NP) { pg8::tile_of(L, 64, 24, pm, pn); u.pm = pm; u.pn = pn; u.aux = 0; u.nt = 16; u.offA = (size_t)pm * 256 * 1280 * 2; u.offB = (size_t)pn * 256 * 1280 * 2; }
        else { pg8::tile_of(L - NP, 64, 4, pm, pn); u.pm = pm; u.pn = 24 + pn; u.aux = 0; u.nt = 4; u.offA = (size_t)pm * 256 * 1280 * 2 + 1024 * 2; u.offB = (size_t)(6144 + pn * 256) * 1280 * 2 + 1024 * 2; }
        return true;
    }
};
__device__ __forceinline__ void phase_proj(Frame& F) {
    pg8::Gemm g{(const bf16*)(F.ws + WS_ACAT2), (const bf16*)(F.ws + WS_WCAT2), 1280, 1280};
    EpiProj E{(bf16*)(F.ws + WS_Q), (bf16*)(F.ws + WS_K), (bf16*)(F.ws + WS_V), (bf16*)(F.ws + WS_Z), (bf16*)(F.ws + WS_XBC), (bf16*)F.out, (bf16*)F.out + (size_t)M * DM, (bf16*)(F.ws + WS_PP)};
    SchedProj S{F.G, (int)blockIdx.x};
    run_gemm(F.lds, g, S, E);
}

__device__ __forceinline__ void phase_conv(Frame& F) {
    const int gt = F.vcu * (NWAVES * 64) + F.tid, NGT = F.G * NWAVES * 64;
    const bf16* XBC = (const bf16*)(F.ws + WS_XBC); bf16* XA = (bf16*)(F.ws + WS_XBCACT);
    const float* CW = F.in[I_CONVW]; const float* CB = F.in[I_CONVB];
    for (int it = gt; it < M * (CONVD / 8); it += NGT) {
        const int m = it / (CONVD / 8), c0 = (it % (CONVD / 8)) * 8, s = m % SEQ;
        float a[8];
#pragma unroll
        for (int j = 0; j < 8; ++j) a[j] = CB[c0 + j];
#pragma unroll
        for (int k = 0; k < 4; ++k) { const int ds = 3 - k; if (s - ds >= 0) {
                const u32x4 r = *(const GAS u32x4*)(XBC + (size_t)(m - ds) * CONVD + c0);
                const f32x4 w0 = *(const GAS f32x4*)(CW + k * CONVD + c0), w1 = *(const GAS f32x4*)(CW + k * CONVD + c0 + 4);
                a[0] += bflo(r.x) * w0.x; a[1] += bfhi(r.x) * w0.y; a[2] += bflo(r.y) * w0.z; a[3] += bfhi(r.y) * w0.w;
                a[4] += bflo(r.z) * w1.x; a[5] += bfhi(r.z) * w1.y; a[6] += bflo(r.w) * w1.z; a[7] += bfhi(r.w) * w1.w; } }
#pragma unroll
        for (int j = 0; j < 8; ++j) a[j] = a[j] * sigmoidf_(a[j]);
        u32x4 o; o.x = pk2(a[0], a[1]); o.y = pk2(a[2], a[3]); o.z = pk2(a[4], a[5]); o.w = pk2(a[6], a[7]);
        *(GAS u32x4*)(XA + (size_t)m * CONVD + c0) = o;
    }
    {
        const int gw = F.vcu * NWAVES + F.wave, NGW = F.G * NWAVES;
        const float* DTRAW = (const float*)(F.ws + WS_DTRAW); float* DT = (float*)(F.ws + WS_DT); float* CS = (float*)(F.ws + WS_CS);
        for (int it = gw; it < (M / 256) * SH; it += NGW) {
            const int ch = it / SH, j = it % SH; const float bias = F.in[I_DTB][j], a = -__expf(F.in[I_ALOG][j]);
            float dt[4], cs[4]; float run = 0.f;
#pragma unroll
            for (int e = 0; e < 4; ++e) { const float x = DTRAW[(size_t)(ch * 256 + 4 * F.lane + e) * 16 + j] + bias; dt[e] = x > 20.f ? x : log1pf(__expf(x)); run += dt[e] * a; cs[e] = run; }
            float inc = run;
#pragma unroll
            for (int o = 1; o < 64; o <<= 1) { const float t = __shfl_up(inc, o); if (F.lane >= o) inc += t; }
            const float excl = inc - run;
#pragma unroll
            for (int e = 0; e < 4; ++e) { const size_t idx = (size_t)(ch * 256 + 4 * F.lane + e) * 16 + j; DT[idx] = dt[e]; CS[idx] = cs[e] + excl; }
        }
        const bf16* Kb = (const bf16*)(F.ws + WS_K); float* KM = (float*)(F.ws + WS_KMEAN);
        for (int it = gw; it < NBATCH * AH * NBLK; it += NGW) {
            const int b = it / (AH * NBLK), h = (it / NBLK) % AH, kb = it % NBLK;
            float s = 0.f;
            for (int r = 0; r < 256; ++r) s += bf2f(Kb[(size_t)(b * SEQ + kb * 256 + r) * AW + h * 64 + F.lane]);
            KM[(size_t)it * 64 + F.lane] = s * (1.f / 256.f);
        }
    }
}

__device__ __forceinline__ void phase_norm(Frame& F) {
    const int gw = F.vcu * NWAVES + F.wave, NGW = F.G * NWAVES;
    bf16* ACAT = (bf16*)(F.ws + WS_ACAT); const float* SS = (const float*)(F.ws + WS_SUMSQ); const float* NG = F.in[I_SSDG];
    for (int m = gw; m < M; m += NGW) {
        float s0 = 0.f, s1 = 0.f;
#pragma unroll
        for (int j = 0; j < 8; ++j) { s0 += SS[(size_t)m * 16 + j]; s1 += SS[(size_t)m * 16 + 8 + j]; }
        const float r0 = 1.0f / sqrtf(s0 * (1.f / 512.f) + EPS), r1 = 1.0f / sqrtf(s1 * (1.f / 512.f) + EPS);
        GAS u32x4* row = (GAS u32x4*)(ACAT + (size_t)m * 1536 + 512);
#pragma unroll
        for (int j = 0; j < 2; ++j) { const int c8 = F.lane + 64 * j; const float r = j == 0 ? r0 : r1;
            u32x4 w = row[c8]; const f32x4 g0 = *(const GAS f32x4*)(NG + 8 * c8), g1 = *(const GAS f32x4*)(NG + 8 * c8 + 4);
            w.x = pk2(bflo(w.x) * r * g0.x, bfhi(w.x) * r * g0.y); w.y = pk2(bflo(w.y) * r * g0.z, bfhi(w.y) * r * g0.w);
            w.z = pk2(bflo(w.z) * r * g1.x, bfhi(w.z) * r * g1.y); w.w = pk2(bflo(w.w) * r * g1.z, bfhi(w.w) * r * g1.w);
            row[c8] = w; }
    }
    LAS float* scr = (LAS float*)(F.lds + F.wave * 8704);
    bf16* WGU = (bf16*)(F.ws + WS_WGU); bf16* WD = (bf16*)(F.ws + WS_WD);
    constexpr int IG = NE * 16 * 16, ID = NE * 8 * 32;
    for (int it = gw; it < 2 * IG + ID; it += NGW) {
        int r = it;
        if (r < 2 * IG) { const int up = r >= IG; if (up) r -= IG; const int e = r / 256, kb = (r % 256) / 16, nb = r % 16;
            const float* W = F.in[up ? I_WUP : I_WGATE] + (size_t)e * DM * FF;
            const int j0 = 32 * nb, row0 = e * 1024 + 256 * (j0 / 128) + (j0 % 128) + (up ? 128 : 0);
            transpose_item(W, FF, 64 * kb, j0, WGU, 1024, row0, 0, scr, F.lane); }
        else { r -= 2 * IG; const int e = r / 256, kb = (r % 256) / 32, nb = r % 32;
            const float* W = F.in[I_WDOWN] + (size_t)e * FF * DM;
            transpose_item(W, DM, 64 * kb, 32 * nb, WD, 512, e * 1024 + 32 * nb, 0, scr, F.lane); }
    }
}

struct EpiMerge {
    static constexpr bool PERM = true;
    const bf16 *GA, *GB; bf16* OUT;
    __device__ __forceinline__ bool keep(const pg8::Unit& u) const { return u.aux == 0; }
    __device__ __forceinline__ void operator()(pg8::Acc& acc, const pg8::Unit& u, int wr, int wc, int fr, int fq) const {
        const int row0 = u.pm * 256 + wr * 64 + fr, col0 = u.pn * 256 + wc * 32 + 8 * fq;
#pragma unroll
        for (int ai = 0; ai < 2; ++ai)
#pragma unroll
            for (int m = 0; m < 4; ++m) { const size_t off = (size_t)(row0 + ai * 128 + m * 16) * DM + col0;
#pragma unroll
                for (int bj = 0; bj < 2; ++bj) {
                    const u32x4 gb = *(const u32x4*)(GB + off + bj * 128);
                    const float b[8] = {bflo(gb.x), bfhi(gb.x), bflo(gb.y), bfhi(gb.y), bflo(gb.z), bfhi(gb.z), bflo(gb.w), bfhi(gb.w)};
                    if (u.aux == 0) {
                        const u32x4 ga = *(const u32x4*)(GA + off + bj * 128);
                        const float a[8] = {bflo(ga.x), bfhi(ga.x), bflo(ga.y), bfhi(ga.y), bflo(ga.z), bfhi(ga.z), bflo(ga.w), bfhi(ga.w)};
#pragma unroll
                        for (int j = 0; j < 4; ++j) { acc[ai][bj][m][0][j] *= a[j] * __builtin_amdgcn_rcpf(fmaxf(b[j], 1e-30f)); acc[ai][bj][m][1][j] *= a[4 + j] * __builtin_amdgcn_rcpf(fmaxf(b[4 + j], 1e-30f)); }
                    } else {
                        const f32x4 v0 = acc[ai][bj][m][0], v1 = acc[ai][bj][m][1];
                        u32x4 w; w.x = pg8::cvt_pk_bf16(v0[0] * b[0], v0[1] * b[1]); w.y = pg8::cvt_pk_bf16(v0[2] * b[2], v0[3] * b[3]);
                        w.z = pg8::cvt_pk_bf16(v1[0] * b[4], v1[1] * b[5]); w.w = pg8::cvt_pk_bf16(v1[2] * b[6], v1[3] * b[7]);
                        *(u32x4*)(OUT + off + bj * 128) = w;
                    } } }
    }
};
struct SchedMerge {
    int G, c;
    __device__ __forceinline__ bool next(int i, pg8::Unit& u) const {
        const int T = (i >> 1) * G + c; if (T >= 256) return false;
        int pm, pn; pg8::tile_of(T, 64, 4, pm, pn); const int sub = i & 1;
        u.pm = pm; u.pn = pn; u.aux = sub; u.nt = sub ? 16 : 8;
        u.offA = (size_t)pm * 256 * 1536 * 2 + (sub ? 512 * 2 : 0); u.offB = (size_t)pn * 256 * 1536 * 2 + (sub ? 512 * 2 : 0);
        return true;
    }
};
__device__ __forceinline__ void phase_merge(Frame& F) {
    pg8::Gemm g{(const bf16*)(F.ws + WS_ACAT), (const bf16*)(F.ws + WS_BCAT), 1536, 1536};
    EpiMerge E{(const bf16*)F.out, (const bf16*)F.out + (size_t)M * DM, (bf16*)(F.ws + WS_MERGED)};
    SchedMerge S{F.G, (int)blockIdx.x};
    run_gemm(F.lds, g, S, E);
}

struct SchedPlain {
    int G, c, nN, nt, lda, ldb;
    __device__ __forceinline__ bool next(int i, pg8::Unit& u) const {
        const int L = i * G + c; if (L >= 64 * nN) return false;
        int pm, pn; pg8::tile_of(L, 64, nN, pm, pn);
        u.pm = pm; u.pn = pn; u.aux = 0; u.nt = nt; u.offA = (size_t)pm * 256 * lda * 2; u.offB = (size_t)pn * 256 * ldb * 2; return true;
    }
};
struct EpiX1 {
    static constexpr bool PERM = false;
    const float* X; float* OUT;
    __device__ __forceinline__ bool keep(const pg8::Unit&) const { return false; }
    __device__ __forceinline__ void operator()(pg8::Acc& acc, const pg8::Unit& u, int wr, int wc, int fr, int fq) const {
        const int row0 = u.pm * 256 + wr * 64 + fr, col0 = u.pn * 256 + wc * 32 + 4 * fq;
#pragma unroll
        for (int ai = 0; ai < 2; ++ai)
#pragma unroll
            for (int m = 0; m < 4; ++m) { const size_t off = (size_t)(row0 + ai * 128 + m * 16) * DM + col0;
#pragma unroll
                for (int bj = 0; bj < 2; ++bj)
#pragma unroll
                    for (int n = 0; n < 2; ++n) { const f32x4 xv = *(const f32x4*)(X + off + bj * 128 + n * 16); *(f32x4*)(OUT + off + bj * 128 + n * 16) = xv + acc[ai][bj][m][n]; } }
    }
};
__device__ __forceinline__ void phase_x1(Frame& F) {
    pg8::Gemm g{(const bf16*)(F.ws + WS_MERGED), (const bf16*)(F.ws + WS_WOUT), 1024, 1024};
    EpiX1 E{F.in[I_X], F.out};
    SchedPlain S{F.G, (int)blockIdx.x, 4, 16, 1024, 1024};
    run_gemm(F.lds, g, S, E);
}

__device__ __forceinline__ void cls_experts(int cls, int& ea, int& eb) { const int g = cls / 6, p = cls % 6; const int a = p < 3 ? 0 : (p < 5 ? 1 : 2), b = p < 3 ? p + 1 : (p < 5 ? p - 1 : 3); ea = g * 4 + a; eb = g * 4 + b; }
__device__ __forceinline__ void phase_route1(Frame& F) {
    LAS float* wl = (LAS float*)F.lds; LAS int* hist = (LAS int*)(F.lds + 20 * 1024 * 4);
    for (int i = F.tid; i < 4 * 1024; i += NWAVES * 64) { const int k = i >> 2, c = i & 3; wl[c * 1024 + k] = F.in[I_WRG][(size_t)k * 4 + c]; }
    for (int i = F.tid; i < 16 * 1024; i += NWAVES * 64) { const int k = i >> 4, c = i & 15; wl[(4 + c) * 1024 + k] = F.in[I_WRE][(size_t)k * 16 + c]; }
    if (F.tid < NCLS) hist[F.tid] = 0;
    __syncthreads();
    const float* X1 = F.out; const float* G = F.in[I_FFNG]; bf16* H2B = (bf16*)(F.ws + WS_H2B);
    int* CLS = (int*)(F.ws + WS_CLS); float* WTS = (float*)(F.ws + WS_WTS);
    const int blk = blockIdx.x;
    for (int rr = F.wave; rr < 64; rr += NWAVES) {
        const int m = blk * 64 + rr;
        const GAS f32x4* xr = (const GAS f32x4*)(X1 + (size_t)m * DM) + F.lane;
        f32x4 v[4]; float s = 0.f;
#pragma unroll
        for (int j = 0; j < 4; ++j) { v[j] = xr[64 * j]; s += (v[j].x * v[j].x + v[j].y * v[j].y) + (v[j].z * v[j].z + v[j].w * v[j].w); }
        const float r = 1.0f / sqrtf(wave_sum(s) * (1.f / DM) + EPS);
        GAS unsigned long long* o8 = (GAS unsigned long long*)(H2B + (size_t)m * DM) + F.lane;
#pragma unroll
        for (int j = 0; j < 4; ++j) { const f32x4 gg = *((const GAS f32x4*)G + F.lane + 64 * j); v[j] = v[j] * r * gg;
            o8[64 * j] = (unsigned long long)pk2(v[j].x, v[j].y) | ((unsigned long long)pk2(v[j].z, v[j].w) << 32); }
        float lg[20];
#pragma unroll
        for (int c = 0; c < 20; ++c) { float a = 0.f;
#pragma unroll
            for (int j = 0; j < 4; ++j) { const f32x4 w = *(const LAS f32x4*)(wl + c * 1024 + 256 * j + 4 * F.lane); a += (v[j].x * w.x + v[j].y * w.y) + (v[j].z * w.z + v[j].w * w.w); }
            lg[c] = wave_sum(a); }
        if (F.lane == 0) {
            float gl[4]; int gs = 0;
#pragma unroll
            for (int c = 0; c < 4; ++c) gl[c] = lg[c] + F.in[I_BRG][c];
#pragma unroll
            for (int c = 1; c < 4; ++c) if (gl[c] > gl[gs]) gs = c;
            float den = 0.f;
#pragma unroll
            for (int c = 0; c < 4; ++c) den += __expf(gl[c] - gl[gs]);
            const float gpw = 1.f / den;
            float el[4];
#pragma unroll
            for (int c = 0; c < 4; ++c) { float v0 = lg[4 + c] + F.in[I_BRE][c];
#pragma unroll
                for (int gg = 1; gg < 4; ++gg) v0 = (gs == gg) ? lg[4 + gg * 4 + c] + F.in[I_BRE][gg * 4 + c] : v0;
                el[c] = v0; }
            int i0 = 0;
#pragma unroll
            for (int c = 1; c < 4; ++c) if (el[c] > el[i0]) i0 = c;
            int i1 = (i0 == 0) ? 1 : 0;
#pragma unroll
            for (int c = 0; c < 4; ++c) if (c != i0 && el[c] > el[i1]) i1 = c;
            const float e1 = __expf(el[i1] - el[i0]), w0 = gpw / (1.f + e1), w1 = gpw * e1 / (1.f + e1);
            const int a = i0 < i1 ? i0 : i1, b = i0 < i1 ? i1 : i0; const float wa = i0 < i1 ? w0 : w1, wb = i0 < i1 ? w1 : w0;
            const int pair = (a == 0) ? (b - 1) : (a == 1 ? (b + 1) : 5);
            const int cls = gs * 6 + pair;
            CLS[m] = cls; WTS[2 * m] = wa; WTS[2 * m + 1] = wb;
            atomicAdd((int*)hist + cls, 1);
        }
    }
    __syncthreads();
    if (F.tid < NCLS) ((int*)(F.ws + WS_HIST))[blk * NCLS + F.tid] = hist[F.tid];
}

__device__ __forceinline__ void phase_route2(Frame& F) {
    LAS int* tot = (LAS int*)F.lds; LAS int* pre = tot + 32; LAS int* base = pre + 32; LAS int* lcls = base + 32; LAS int* lpos = lcls + 64;
    const int* HIST = (const int*)(F.ws + WS_HIST); const int blk = blockIdx.x;
    if (F.tid < NCLS) { int t = 0, p = 0; for (int b = 0; b < 256; ++b) { const int h = HIST[b * NCLS + F.tid]; if (b < blk) p += h; t += h; } tot[F.tid] = t; pre[F.tid] = p; }
    __syncthreads();
    if (F.tid == 0) { int acc = 0; for (int c = 0; c < NCLS; ++c) { base[c] = acc; acc += ((tot[c] + 255) >> 8) << 8; } base[NCLS] = acc; }
    const int* CLS = (const int*)(F.ws + WS_CLS);
    if (F.tid < 64) lcls[F.tid] = CLS[blk * 64 + F.tid];
    __syncthreads();
    if (F.tid < 64) { const int c = lcls[F.tid]; int rank = 0; for (int j = 0; j < F.tid; ++j) rank += (lcls[j] == c) ? 1 : 0; lpos[F.tid] = base[c] + pre[c] + rank; }
    __syncthreads();
    int* PERM = (int*)(F.ws + WS_PERM); float* WPOS = (float*)(F.ws + WS_WPOS); const float* WTS = (const float*)(F.ws + WS_WTS);
    const bf16* H2B = (const bf16*)(F.ws + WS_H2B); bf16* XS = (bf16*)(F.ws + WS_XS);
    for (int rr = F.wave; rr < 64; rr += NWAVES) {
        const int m = blk * 64 + rr, pos = lpos[rr];
        const GAS u32x4* src = (const GAS u32x4*)(H2B + (size_t)m * DM); GAS u32x4* dst = (GAS u32x4*)(XS + (size_t)pos * DM);
        dst[F.lane] = src[F.lane]; dst[F.lane + 64] = src[F.lane + 64];
        if (F.lane == 0) { PERM[pos] = m; WPOS[2 * pos] = WTS[2 * m]; WPOS[2 * pos + 1] = WTS[2 * m + 1]; }
    }
    if (blk == 0) {
        int* TILES = (int*)(F.ws + WS_TILES);
        if (F.tid == 0) { TILES[0] = base[NCLS] >> 8; }
        if (F.tid < NCLS) { const int c = F.tid; for (int t = base[c] >> 8; t < (base[c + 1] >> 8); ++t) TILES[1 + t] = c; }
        for (int c = 0; c < NCLS; ++c) { const int lo = base[c] + tot[c], hi = base[c + 1]; for (int p = lo + F.tid; p < hi; p += NWAVES * 64) PERM[p] = -1; }
    }
}

struct SchedUp {
    int G, c; const int* TILES;
    __device__ __forceinline__ bool next(int i, pg8::Unit& u) const {
        const int nrt = TILES[0]; const int L = i * G + c; if (L >= nrt * 8) return false;
        int pm, pn; pg8::tile_of(L, nrt, 8, pm, pn);
        int ea, eb; cls_experts(TILES[1 + pm], ea, eb); const int e = (pn < 4) ? ea : eb;
        u.pm = pm; u.pn = pn; u.aux = 0; u.nt = 16; u.offA = (size_t)pm * 256 * 1024 * 2; u.offB = (size_t)(e * 1024 + 256 * (pn & 3)) * 1024 * 2; return true;
    }
};
struct EpiUp {
    static constexpr bool PERM = true;
    const float* WPOS; bf16* HID;
    __device__ __forceinline__ bool keep(const pg8::Unit&) const { return false; }
    __device__ __forceinline__ void operator()(pg8::Acc& acc, const pg8::Unit& u, int wr, int wc, int fr, int fq) const {
        const int row0 = u.pm * 256 + wr * 64 + fr, col0 = u.pn * 128 + wc * 32 + 8 * fq, half = u.pn >> 2;
#pragma unroll
        for (int ai = 0; ai < 2; ++ai)
#pragma unroll
            for (int m = 0; m < 4; ++m) { const int pos = row0 + ai * 128 + m * 16; const float w = WPOS[2 * pos + half];
                float h[8];
#pragma unroll
                for (int n = 0; n < 2; ++n)
#pragma unroll
                    for (int j = 0; j < 4; ++j) { const float gt = acc[ai][0][m][n][j], up = acc[ai][1][m][n][j]; h[4 * n + j] = w * gt * sigmoidf_(gt) * up; }
                u32x4 o; o.x = pg8::cvt_pk_bf16(h[0], h[1]); o.y = pg8::cvt_pk_bf16(h[2], h[3]); o.z = pg8::cvt_pk_bf16(h[4], h[5]); o.w = pg8::cvt_pk_bf16(h[6], h[7]);
                *(u32x4*)(HID + (size_t)pos * 1024 + col0) = o; }
    }
};
__device__ __forceinline__ void phase_up(Frame& F) {
    pg8::Gemm g{(const bf16*)(F.ws + WS_XS), (const bf16*)(F.ws + WS_WGU), 1024, 1024};
    EpiUp E{(const float*)(F.ws + WS_WPOS), (bf16*)(F.ws + WS_HID)};
    SchedUp S{F.G, (int)blockIdx.x, (const int*)(F.ws + WS_TILES)};
    run_gemm(F.lds, g, S, E);
}

struct SchedDown {
    int G, c; const int* TILES;
    __device__ __forceinline__ bool next(int i, pg8::Unit& u) const {
        const int nrt = TILES[0]; const int T = (i >> 1) * G + c; if (T >= nrt * 4) return false;
        int pm, pn; pg8::tile_of(T, nrt, 4, pm, pn); const int sub = i & 1;
        int ea, eb; cls_experts(TILES[1 + pm], ea, eb); const int e = sub ? eb : ea;
        u.pm = pm; u.pn = pn; u.aux = sub; u.nt = 8; u.offA = (size_t)pm * 256 * 1024 * 2 + (sub ? 512 * 2 : 0); u.offB = (size_t)(e * 1024 + pn * 256) * 512 * 2; return true;
    }
};
struct EpiDown {
    static constexpr bool PERM = false;
    const int* PERMT; float* X; bf16* X2B;
    __device__ __forceinline__ bool keep(const pg8::Unit& u) const { return u.aux == 0; }
    __device__ __forceinline__ void operator()(pg8::Acc& acc, const pg8::Unit& u, int wr, int wc, int fr, int fq) const {
        if (u.aux == 0) return;
        const int row0 = u.pm * 256 + wr * 64 + fr, col0 = u.pn * 256 + wc * 32 + 4 * fq;
#pragma unroll
        for (int ai = 0; ai < 2; ++ai)
#pragma unroll
            for (int m = 0; m < 4; ++m) { const int tok = PERMT[row0 + ai * 128 + m * 16]; if (tok < 0) continue; const size_t off = (size_t)tok * DM + col0;
#pragma unroll
                for (int bj = 0; bj < 2; ++bj)
#pragma unroll
                    for (int n = 0; n < 2; ++n) { const f32x4 o = *(const f32x4*)(X + off + bj * 128 + n * 16) + acc[ai][bj][m][n]; *(f32x4*)(X + off + bj * 128 + n * 16) = o;
                        u32x2 w; w.x = pg8::cvt_pk_bf16(o[0], o[1]); w.y = pg8::cvt_pk_bf16(o[2], o[3]); *(u32x2*)(X2B + off + bj * 128 + n * 16) = w; } }
    }
};
__device__ __forceinline__ void phase_down(Frame& F) {
    pg8::Gemm g{(const bf16*)(F.ws + WS_HID), (const bf16*)(F.ws + WS_WD), 1024, 512};
    EpiDown E{(const int*)(F.ws + WS_PERM), F.out, (bf16*)(F.ws + WS_X2B)};
    SchedDown S{F.G, (int)blockIdx.x, (const int*)(F.ws + WS_TILES)};
    run_gemm(F.lds, g, S, E);
}

struct EpiPle {
    static constexpr bool PERM = false;
    float* X; const bf16* PP;
    __device__ __forceinline__ bool keep(const pg8::Unit&) const { return false; }
    __device__ __forceinline__ void operator()(pg8::Acc& acc, const pg8::Unit& u, int wr, int wc, int fr, int fq) const {
        const int row0 = u.pm * 256 + wr * 64 + fr, col0 = u.pn * 256 + wc * 32 + 4 * fq;
#pragma unroll
        for (int ai = 0; ai < 2; ++ai)
#pragma unroll
            for (int m = 0; m < 4; ++m) { const size_t off = (size_t)(row0 + ai * 128 + m * 16) * DM + col0;
#pragma unroll
                for (int bj = 0; bj < 2; ++bj)
#pragma unroll
                    for (int n = 0; n < 2; ++n) { const size_t o2 = off + bj * 128 + n * 16; const f32x4 xv = *(const f32x4*)(X + o2); const u32x2 pp = *(const u32x2*)(PP + o2); const f32x4 a = acc[ai][bj][m][n];
                        f32x4 o; o[0] = xv[0] + sigmoidf_(a[0]) * bflo(pp.x); o[1] = xv[1] + sigmoidf_(a[1]) * bfhi(pp.x); o[2] = xv[2] + sigmoidf_(a[2]) * bflo(pp.y); o[3] = xv[3] + sigmoidf_(a[3]) * bfhi(pp.y);
                        *(f32x4*)(X + o2) = o; } }
    }
};
__device__ __forceinline__ void phase_ple(Frame& F) {
    pg8::Gemm g{(const bf16*)(F.ws + WS_X2B), (const bf16*)(F.ws + WS_WPG), 1024, 1024};
    EpiPle E{F.out, (const bf16*)(F.ws + WS_PP)};
    SchedPlain S{F.G, (int)blockIdx.x, 4, 16, 1024, 1024};
    run_gemm(F.lds, g, S, E);
}

__device__ __forceinline__ void phase_final(Frame& F) {
    const int gw = F.vcu * NWAVES + F.wave, NGW = F.G * NWAVES; const float* G = F.in[I_FING];
    for (int m = gw; m < M; m += NGW) {
        GAS f32x4* xr = (GAS f32x4*)(F.out + (size_t)m * DM) + F.lane;
        f32x4 v[4]; float s = 0.f;
#pragma unroll
        for (int j = 0; j < 4; ++j) { v[j] = xr[64 * j]; s += (v[j].x * v[j].x + v[j].y * v[j].y) + (v[j].z * v[j].z + v[j].w * v[j].w); }
        const float r = 1.0f / sqrtf(wave_sum(s) * (1.f / DM) + EPS);
#pragma unroll
        for (int j = 0; j < 4; ++j) { const f32x4 gg = *((const GAS f32x4*)G + F.lane + 64 * j); xr[64 * j] = v[j] * r * gg; }
    }
}

__global__ void __launch_bounds__(256) attn_naive(const bf16* __restrict__ Q, const bf16* __restrict__ K, const bf16* __restrict__ V, const float* __restrict__ KM, bf16* __restrict__ ACAT) {
    const int blk = blockIdx.x, qb = blk % NBLK, h = (blk / NBLK) % AH, b = blk / (NBLK * AH);
    const int t = qb * 256 + threadIdx.x; const size_t row = (size_t)b * SEQ + t;
    float q[64];
#pragma unroll
    for (int d = 0; d < 64; d += 2) { const unsigned w = *(const unsigned*)(Q + row * AW + h * 64 + d); q[d] = bflo(w); q[d + 1] = bfhi(w); }
    unsigned sel = 0;
    if (qb <= 3) sel = (1u << qb) - 1u;
    else {
        float g[8];
#pragma unroll
        for (int kb = 0; kb < 8; ++kb) { float a = 0.f; if (kb < qb) {
#pragma unroll
                for (int d = 0; d < 64; ++d) a += q[d] * KM[(size_t)((b * AH + h) * NBLK + kb) * 64 + d]; } else a = -INFINITY; g[kb] = a; }
#pragma unroll
        for (int r = 0; r < 3; ++r) { int best = -1; float bv = -INFINITY;
#pragma unroll
            for (int kb = 0; kb < 8; ++kb) if (kb < qb && !((sel >> kb) & 1u) && g[kb] > bv) { bv = g[kb]; best = kb; }
            if (best >= 0) sel |= 1u << best; }
    }
    const float sl2 = exp2f(-(float)(h + 1)) * LOG2E;
    float mx = -1e30f, l = 0.f; float o[64];
#pragma unroll
    for (int d = 0; d < 64; ++d) o[d] = 0.f;
    for (int kb = 0; kb <= qb; ++kb) {
        const bool act = (kb == qb) || ((sel >> kb) & 1u);
        for (int j = 0; j < 256; ++j) {
            const int tk = kb * 256 + j; const size_t krow = (size_t)b * SEQ + tk;
            float s = 0.f;
#pragma unroll
            for (int d = 0; d < 64; d += 2) { const unsigned w = *(const unsigned*)(K + krow * AW + h * 64 + d); s += q[d] * bflo(w) + q[d + 1] * bfhi(w); }
            s -= sl2 * (float)(t - tk);
            const bool ok = act && (tk <= t);
            if (ok) {
                const float mn = fmaxf(mx, s), f = exp2f(mx - mn), p = exp2f(s - mn);
                l = l * f + p;
#pragma unroll
                for (int d = 0; d < 64; d += 2) { const unsigned w = *(const unsigned*)(V + krow * AW + h * 64 + d); o[d] = o[d] * f + p * bflo(w); o[d + 1] = o[d + 1] * f + p * bfhi(w); }
                mx = mn;
            }
        }
    }
    const float rl = 1.f / l;
#pragma unroll
    for (int d = 0; d < 64; d += 2) *(unsigned*)(ACAT + row * 1536 + h * 64 + d) = pk2(o[d] * rl, o[d + 1] * rl);
}

__global__ void __launch_bounds__(64) ssd_naive(const bf16* __restrict__ XA, const float* __restrict__ DT, const bf16* __restrict__ Z, const float* __restrict__ ALOG, const float* __restrict__ DSKIP,
                                                bf16* __restrict__ ACAT, float* __restrict__ SUMSQ) {
    const int b = blockIdx.x / SH, j = blockIdx.x % SH, p = threadIdx.x, g = j / 8;
    const float a = -__expf(ALOG[j]), dsk = DSKIP[j];
    float hst[128];
#pragma unroll
    for (int n = 0; n < 128; ++n) hst[n] = 0.f;
    for (int t = 0; t < SEQ; ++t) {
        const size_t row = (size_t)b * SEQ + t;
        const float dt = DT[row * 16 + j], dA = __expf(dt * a);
        const float x = bf2f(XA[row * CONVD + j * 64 + p]), dtx = dt * x;
        const bf16* Bp = XA + row * CONVD + 1024 + g * 128; const bf16* Cp = XA + row * CONVD + 1280 + g * 128;
        float y = 0.f;
#pragma unroll
        for (int n = 0; n < 128; n += 2) { const unsigned bw = *(const unsigned*)(Bp + n), cw = *(const unsigned*)(Cp + n);
            hst[n] = hst[n] * dA + dtx * bflo(bw); y += bflo(cw) * hst[n];
            hst[n + 1] = hst[n + 1] * dA + dtx * bfhi(bw); y += bfhi(cw) * hst[n + 1]; }
        y += dsk * x;
        const float zz = bf2f(Z[row * DM + j * 64 + p]);
        const float u = y * zz * sigmoidf_(zz);
        ACAT[row * 1536 + 512 + j * 64 + p] = (bf16)f2bf(u);
        const float ss = wave_sum(u * u);
        if (p == 0) SUMSQ[row * 16 + j] = ss;
    }
}

enum { PH_PROLOGUE = 0, PH_PROJ, PH_CONV, PH_ATTN, PH_SSDY, PH_NORM, PH_MERGE, PH_X1, PH_ROUTE1, PH_ROUTE2, PH_UP, PH_DOWN, PH_PLE, PH_FINAL, PH_COUNT };

__global__ void __launch_bounds__(NWAVES * 64, 2) mk_fwd(Args args) {
    extern __shared__ __attribute__((aligned(16))) unsigned char lds[];
    Frame F;
    F.lds = (LAS unsigned char*)lds;
    F.tid = threadIdx.x; F.lane = F.tid & 63; F.wave = __builtin_amdgcn_readfirstlane(F.tid >> 6);
    F.G = gridDim.x; { const int bx = blockIdx.x; F.vcu = (F.G % 8 == 0) ? (bx % 8) * (F.G / 8) + bx / 8 : bx; }
    F.in = args.in; F.out = args.out; F.ws = args.ws;
    volatile LAS unsigned* MISC = (volatile LAS unsigned*)(F.lds + MISC_OFF);
    if (F.tid < 32) MISC[F.tid] = 0u;
    __syncthreads();
    XcdBarrier bar = xcd_barrier_post((unsigned*)(args.ws + WS_CTL) + CW_BAR + args.li * XCD_BAR_WORDS, MISC + 8);
    const int lo = args.ph_lo, hi = args.ph_hi;
#define IN(k) (lo <= (k) && (k) < hi)
#define SEAM(k) do { if (IN(k) && IN((k) + 1)) xcd_barrier(bar); } while (0)
    if (IN(PH_PROLOGUE)) { phase_prologue(F); } SEAM(PH_PROLOGUE);
    if (IN(PH_PROJ)) { phase_proj(F); } SEAM(PH_PROJ);
    if (IN(PH_CONV)) { phase_conv(F); } SEAM(PH_CONV);
    SEAM(PH_ATTN);
    SEAM(PH_SSDY);
    if (IN(PH_NORM)) { phase_norm(F); } SEAM(PH_NORM);
    if (IN(PH_MERGE)) { phase_merge(F); } SEAM(PH_MERGE);
    if (IN(PH_X1)) { phase_x1(F); } SEAM(PH_X1);
    if (IN(PH_ROUTE1)) { phase_route1(F); } SEAM(PH_ROUTE1);
    if (IN(PH_ROUTE2)) { phase_route2(F); } SEAM(PH_ROUTE2);
    if (IN(PH_UP)) { phase_up(F); } SEAM(PH_UP);
    if (IN(PH_DOWN)) { phase_down(F); } SEAM(PH_DOWN);
    if (IN(PH_PLE)) { phase_ple(F); } SEAM(PH_PLE);
    if (IN(PH_FINAL)) { phase_final(F); }
#undef IN
#undef SEAM
}

extern "C" void kernel_launch(void* const* d_in, const int* in_sizes, int n_in, void* d_out, int out_size, void* d_ws, size_t ws_size, hipStream_t stream) {
    static int grid = 0;
    if (grid == 0) {
        if (n_in != 24 || out_size != M * DM || ws_size < WS_END) { fprintf(stderr, "kernel_launch: unexpected shapes n_in %d out %d ws %zu\n", n_in, out_size, ws_size); grid = -1; return; }
        int dev = 0, cus = 0, per_cu = 0;
        if (hipGetDevice(&dev) != hipSuccess || hipDeviceGetAttribute(&cus, hipDeviceAttributeMultiprocessorCount, dev) != hipSuccess) { grid = -1; return; }
        if (hipFuncSetAttribute((const void*)mk_fwd, hipFuncAttributeMaxDynamicSharedMemorySize, LDS_BYTES) != hipSuccess) { fprintf(stderr, "kernel_launch: hipFuncSetAttribute failed\n"); grid = -1; return; }
        if (hipOccupancyMaxActiveBlocksPerMultiprocessor(&per_cu, (const void*)mk_fwd, NWAVES * 64, LDS_BYTES) != hipSuccess || per_cu < 1) { fprintf(stderr, "kernel_launch: occupancy query says %d\n", per_cu); grid = -1; return; }
        (void)hipGetLastError();
        grid = cus;
        if (grid != 256) { fprintf(stderr, "kernel_launch: built for 256 CUs, device has %d\n", cus); grid = -1; return; }
    }
    if (grid < 0) return;
    hipMemsetAsync((char*)d_ws + WS_CTL, 0, CTL_ZERO_BYTES, stream);
    Args a{};
    for (int i = 0; i < 24; ++i) a.in[i] = (const float*)d_in[i];
    a.out = (float*)d_out; a.ws = (unsigned char*)d_ws;
    unsigned char* ws = (unsigned char*)d_ws;
    int li = 0;
    auto frame = [&](int lo, int hi) { a.ph_lo = lo; a.ph_hi = hi; a.li = li++; hipLaunchKernelGGL(mk_fwd, dim3(grid), dim3(NWAVES * 64), LDS_BYTES, stream, a); };
    frame(PH_PROLOGUE, PH_ATTN);
    hipLaunchKernelGGL(attn_naive, dim3(NBATCH * AH * NBLK), dim3(256), 0, stream, (const bf16*)(ws + WS_Q), (const bf16*)(ws + WS_K), (const bf16*)(ws + WS_V), (const float*)(ws + WS_KMEAN), (bf16*)(ws + WS_ACAT));
    hipLaunchKernelGGL(ssd_naive, dim3(NBATCH * SH), dim3(64), 0, stream, (const bf16*)(ws + WS_XBCACT), (const float*)(ws + WS_DT), (const bf16*)(ws + WS_Z), (const float*)d_in[I_ALOG], (const float*)d_in[I_DSKIP],
                       (bf16*)(ws + WS_ACAT), (float*)(ws + WS_SUMSQ));
    frame(PH_NORM, PH_COUNT);
}
```

```cpp
#include <hip/hip_runtime.h>
#include <cstdio>
#include <cstdint>

#define LAS __attribute__((address_space(3)))
#define GAS __attribute__((address_space(1)))
typedef unsigned short bf16;
typedef short bf16x8 __attribute__((ext_vector_type(8)));
typedef float f32x4 __attribute__((ext_vector_type(4)));
typedef float f32x2 __attribute__((ext_vector_type(2)));
typedef unsigned u32x4 __attribute__((ext_vector_type(4)));
typedef unsigned u32x2 __attribute__((ext_vector_type(2)));

constexpr int M = 16384, DM = 1024, SEQ = 2048, NBATCH = 8;
constexpr int AH = 8, AD = 64, AW = 512, MBLK = 256, NBLK = 8;
constexpr int SH = 16, SPD = 64, SN = 128, CONVD = 1536, NCH = 8;
constexpr int NE = 16, FF = 512, NCLS = 24;
constexpr int PLE = 256;
constexpr int IN_DIM = 6160, OFF_DT = 4096, OFF_GA = 4112;
constexpr float EPS = 1e-6f;
constexpr float LOG2E = 1.4426950408889634f;
constexpr float C2 = 0.125f * LOG2E;
constexpr int MAXRT = 88;

constexpr size_t MiB = 1u << 20;
constexpr size_t WS_CTL = 0, CTL_ZERO_BYTES = 64 * 1024;
constexpr size_t WS_BCAT = 1 * MiB;
constexpr size_t WS_WOUT = 4 * MiB;
constexpr size_t WS_WPG = 6 * MiB;
constexpr size_t WS_DTRAW = 8 * MiB;
constexpr size_t WS_DT = 9 * MiB;
constexpr size_t WS_CS = 10 * MiB;
constexpr size_t WS_SUMSQ = 11 * MiB;
constexpr size_t WS_KMEAN = 12 * MiB;
constexpr size_t WS_CLS = 12 * MiB + 512 * 1024;
constexpr size_t WS_WTS = 12 * MiB + 768 * 1024;
constexpr size_t WS_HIST = 13 * MiB;
constexpr size_t WS_TILES = 13 * MiB + 256 * 1024;
constexpr size_t WS_PERM = 13 * MiB + 512 * 1024;
constexpr size_t WS_WPOS = 14 * MiB;
constexpr size_t WS_Q = 16 * MiB, WS_K = 32 * MiB, WS_V = 48 * MiB;
constexpr size_t WS_WGU = 16 * MiB;
constexpr size_t WS_WD = 48 * MiB;
constexpr size_t WS_Z = 64 * MiB;
constexpr size_t WS_MERGED = 64 * MiB;
constexpr size_t WS_H2B = 64 * MiB;
constexpr size_t WS_X2B = 64 * MiB;
constexpr size_t WS_XBC = 96 * MiB;
constexpr size_t WS_ACAT = 96 * MiB;
constexpr size_t WS_XS = 96 * MiB;
constexpr size_t WS_ACAT2 = 144 * MiB;
constexpr size_t WS_XBCACT = 144 * MiB;
constexpr size_t WS_HID = 144 * MiB;
constexpr size_t WS_PP = 192 * MiB;
constexpr size_t WS_WCAT2 = 224 * MiB;
constexpr size_t WS_STATES = 224 * MiB;
constexpr size_t WS_END = 256 * MiB;

constexpr int CW_BAR = 1024;

#define RLX_AGENT __ATOMIC_RELAXED, __HIP_MEMORY_SCOPE_AGENT
#define LDS_WAIT() asm volatile("s_waitcnt lgkmcnt(0)" ::: "memory")
#define VM_WAIT() asm volatile("s_waitcnt vmcnt(0)" ::: "memory")
__device__ __forceinline__ unsigned f2bf(float f) { unsigned u = __builtin_bit_cast(unsigned, f); return (u + 0x7fffu + ((u >> 16) & 1u)) >> 16; }
__device__ __forceinline__ unsigned pk2(float lo, float hi) { return f2bf(lo) | (f2bf(hi) << 16); }
__device__ __forceinline__ float bf2f(unsigned b) { return __builtin_bit_cast(float, b << 16); }
__device__ __forceinline__ float bflo(unsigned w) { return __builtin_bit_cast(float, w << 16); }
__device__ __forceinline__ float bfhi(unsigned w) { return __builtin_bit_cast(float, w & 0xffff0000u); }
__device__ __forceinline__ float sigmoidf_(float x) { return __builtin_amdgcn_rcpf(1.f + __builtin_amdgcn_exp2f(-x * LOG2E)); }
__device__ __forceinline__ float wave_sum(float v) {
#pragma unroll
    for (int o = 1; o < 64; o <<= 1) v += __shfl_xor(v, o);
    return v;
}

#define XB_TMO      128
#define XB_XCNT(j)  (256  + 64 * (j))
#define XB_XSUB(j)  (1280 + 64 * (j))
#define XB_XGEN(j)  (2304 + 64 * (j))
#define XB_TOP      3328
#define XB_TOPGEN   3392
#define XCD_BAR_WORDS 3456
#define XB_SPIN_CAP (1u << 20)
__device__ __forceinline__ unsigned xb_ld(unsigned* p)              { return __hip_atomic_load(p, __ATOMIC_RELAXED, __HIP_MEMORY_SCOPE_AGENT); }
__device__ __forceinline__ unsigned xb_add(unsigned* p, unsigned v) { return __hip_atomic_fetch_add(p, v, __ATOMIC_RELAXED, __HIP_MEMORY_SCOPE_AGENT); }
__device__ __forceinline__ unsigned xb_xcc_id() { return (unsigned)__builtin_amdgcn_s_getreg((3 << 11) | 20) & 0xFu; }
#define XB_SPIN(cond, bar) do { unsigned _sp = 0; while (cond) { __builtin_amdgcn_s_sleep(1); \
    if ((++_sp & 255u) == 0u) { if (xb_ld(&(bar)[XB_TMO])) break; if (_sp > XB_SPIN_CAP) { atomicAdd(&(bar)[XB_TMO], 1u); break; } } } } while (0)
struct XcdBarrier { unsigned* bar; unsigned x; volatile LAS unsigned* st; };
__device__ __forceinline__ XcdBarrier xcd_barrier_post(unsigned* bar, volatile LAS unsigned* st) {
    XcdBarrier b; b.bar = bar; b.x = xb_xcc_id(); b.st = st;
    if (threadIdx.x == 0) (void)xb_add(&bar[XB_XCNT(b.x)], 1u);
    return b;
}
__device__ __forceinline__ void xcd_barrier_complete(unsigned* bar, unsigned x, unsigned& nloc, unsigned& nx) {
    const unsigned G = gridDim.x * gridDim.y * gridDim.z;
    unsigned sum, cnt, mine, sp = 0u;
    for (;;) {
        sum = 0u; cnt = 0u; mine = 0u;
#pragma unroll
        for (unsigned j = 0; j < 16; ++j) { const unsigned c = xb_ld(&bar[XB_XCNT(j)]); sum += c; cnt += (c > 0u) ? 1u : 0u; mine = (j == x) ? c : mine; }
        if (sum == G) break;
        __builtin_amdgcn_s_sleep(1);
        if ((++sp & 255u) == 0u) { if (xb_ld(&bar[XB_TMO])) break; if (sp > XB_SPIN_CAP) { atomicAdd(&bar[XB_TMO], 1u); break; } }
    }
    nloc = mine > 0u ? mine : 1u; nx = cnt > 0u ? cnt : 1u;
}
__device__ __forceinline__ void xcd_barrier(const XcdBarrier& b) {
    asm volatile("s_waitcnt vmcnt(0)" ::: "memory");
    __syncthreads();
    if (threadIdx.x == 0) {
        unsigned* bar = b.bar;
        __builtin_amdgcn_s_waitcnt(0);
        unsigned nloc = b.st[0], nx = b.st[1];
        if (nloc == 0u) { xcd_barrier_complete(bar, b.x, nloc, nx); b.st[0] = nloc; b.st[1] = nx; }
        const unsigned old = xb_add(&bar[XB_XSUB(b.x)], 1u);
        const unsigned gen = old / nloc;
        if (old + 1u == (gen + 1u) * nloc) {
            __builtin_amdgcn_fence(__ATOMIC_RELEASE, "agent");
            asm volatile("s_waitcnt vmcnt(0)" ::: "memory");
            const unsigned og = xb_add(&bar[XB_TOP], 1u);
            const unsigned tg = og / nx;
            if (og + 1u == (tg + 1u) * nx) xb_add(&bar[XB_TOPGEN], 1u);
            else XB_SPIN(xb_ld(&bar[XB_TOPGEN]) == tg, bar);
            __builtin_amdgcn_fence(__ATOMIC_ACQUIRE, "agent");
            xb_add(&bar[XB_XGEN(b.x)], 1u);
            asm volatile("s_waitcnt vmcnt(0)" ::: "memory");
        } else {
            XB_SPIN(xb_ld(&bar[XB_XGEN(b.x)]) == gen, bar);
            __builtin_amdgcn_fence(__ATOMIC_ACQUIRE, "agent");
            asm volatile("s_waitcnt vmcnt(0)" ::: "memory");
        }
    }
    __syncthreads();
}

namespace pg8 {
constexpr int BM = 256, BK = 64, HALF = 128, HTB = HALF * BK * 2, STAGE_BYTES = 8 * HTB, NXCD = 8, WGM = 8;
__host__ __device__ __forceinline__ int lds_byte(int r, int c) { const int st = (r >> 4) * 2 + (c >> 5), rr = r & 15, cc = c & 31, ob = rr * 64 + cc * 2; return st * 1024 + (ob ^ (((ob >> 9) & 1) << 5)); }
__host__ __device__ __forceinline__ void stage_rc(int b, int& R, int& C) { const int st = b / 1024, sb = b % 1024, swz = sb ^ (((sb >> 9) & 1) << 5); R = (st >> 1) * 16 + swz / 64; C = (st & 1) * 32 + (swz % 64) / 2; }
__host__ __device__ __forceinline__ int perm32(int rho) { const int n = rho >> 4, i = rho & 15; return 8 * (i >> 2) + 4 * n + (i & 3); }

struct Unit { int pm, pn, aux, nt; size_t offA, offB; };
struct Gemm { const bf16* A; const bf16* Bt; int lda, ldb; };

__device__ __forceinline__ void tile_of(int L, int nM, int nN, int& pm, int& pn) {
    const int nwg = nM * nN; int wgid = L;
    { const int q = nwg / NXCD, r = nwg % NXCD, xcd = wgid % NXCD, off = wgid / NXCD; wgid = (xcd < r ? xcd * (q + 1) : r * (q + 1) + (xcd - r) * q) + off; }
    const int nig = WGM * nN, gid = wgid / nig, fm = gid * WGM, gsz = (nM - fm) < WGM ? (nM - fm) : WGM;
    pm = fm + ((wgid % nig) % gsz); pn = (wgid % nig) / gsz;
}
__device__ __forceinline__ unsigned cvt_pk_bf16(float lo, float hi) { unsigned r; asm volatile("v_cvt_pk_bf16_f32 %0, %1, %2" : "=v"(r) : "v"(lo), "v"(hi)); return r; }

typedef f32x4 Acc[2][2][4][2];

template <class Epi, class Sched>
__device__ __forceinline__ void gemm_simple(const Gemm g, const Sched& S, const Epi& E) {
    const int tid = threadIdx.x, wid = __builtin_amdgcn_readfirstlane(tid >> 6), lane = tid & 63, wr = wid >> 2, wc = wid & 3, fr = lane & 15, fq = lane >> 4;
    Unit cur; Acc acc;
#pragma unroll
    for (int a = 0; a < 2; ++a)
#pragma unroll
        for (int b = 0; b < 2; ++b)
#pragma unroll
            for (int m = 0; m < 4; ++m)
#pragma unroll
                for (int n = 0; n < 2; ++n) acc[a][b][m][n] = (f32x4){0.f, 0.f, 0.f, 0.f};
    for (int ui = 0; S.next(ui, cur); ++ui) {
        const char* cA = (const char*)g.A + cur.offA; const char* cB = (const char*)g.Bt + cur.offB;
        for (int kt = 0; kt < cur.nt * 2; ++kt) {
#pragma unroll
            for (int ai = 0; ai < 2; ++ai) {
                bf16x8 af[4];
#pragma unroll
                for (int m = 0; m < 4; ++m) af[m] = *(const bf16x8*)(cA + ((size_t)(ai * HALF + wr * 64 + m * 16 + fr) * g.lda + kt * 32 + fq * 8) * 2);
#pragma unroll
                for (int bj = 0; bj < 2; ++bj)
#pragma unroll
                    for (int n = 0; n < 2; ++n) {
                        const int rr = n * 16 + fr, br = bj * HALF + wc * 32 + (Epi::PERM ? perm32(rr) : rr);
                        const bf16x8 bfr = *(const bf16x8*)(cB + ((size_t)br * g.ldb + kt * 32 + fq * 8) * 2);
#pragma unroll
                        for (int m = 0; m < 4; ++m) acc[ai][bj][m][n] = __builtin_amdgcn_mfma_f32_16x16x32_bf16(bfr, af[m], acc[ai][bj][m][n], 0, 0, 0);
                    }
            }
        }
        E(acc, cur, wr, wc, fr, fq);
        if (!E.keep(cur)) {
#pragma unroll
            for (int a = 0; a < 2; ++a)
#pragma unroll
                for (int b = 0; b < 2; ++b)
#pragma unroll
                    for (int m = 0; m < 4; ++m)
#pragma unroll
                        for (int n = 0; n < 2; ++n) acc[a][b][m][n] = (f32x4){0.f, 0.f, 0.f, 0.f};
        }
    }
}

template <class Epi, class Sched, bool ALIGN_EPI = true, bool SP2 = true>
__device__ __forceinline__ void gemm_phase(LAS unsigned char* lds, const Gemm g, const Sched& S, const Epi& E) {
    const int tid = threadIdx.x, wid = __builtin_amdgcn_readfirstlane(tid >> 6), lane = tid & 63, wr = wid >> 2, wc = wid & 3, fr = lane & 15, fq = lane >> 4;
    unsigned voffA[2], voffB[2];
#pragma unroll
    for (int i = 0; i < 2; ++i) { int R, C; stage_rc(tid * 16 + i * 8192, R, C); const int Rb = Epi::PERM ? ((R & ~31) + perm32(R & 31)) : R;
        voffA[i] = (unsigned)(R * g.lda + C) * 2u; voffB[i] = (unsigned)(Rb * g.ldb + C) * 2u; }
    const size_t kstep = (size_t)(BK * 2);
    const size_t hstepA = (size_t)HALF * g.lda * 2, hstepB = (size_t)HALF * g.ldb * 2;
    const unsigned ldsw = (unsigned)wid * 1024u;
    const int aoff = lds_byte(wr * 64 + fr, fq * 8), boff = lds_byte(wc * 32 + fr, fq * 8);
#define PG8_SA(b, h) (((b) * 2 + (h)) * HTB)
#define PG8_SB(b, h) ((4 + (b) * 2 + (h)) * HTB)
#define PG8_STAGE(bufoff, gbase, voff) do { _Pragma("unroll") for (int _i = 0; _i < 2; ++_i) \
        __builtin_amdgcn_global_load_lds((const unsigned*)((const char*)(gbase) + (voff)[_i]), (LAS unsigned*)(lds + (bufoff) + ldsw + _i * 8192), 16, 0, 0); } while (0)
#define PG8_LDA(dst, b, h) do { _Pragma("unroll") for (int m = 0; m < 4; ++m) _Pragma("unroll") for (int k = 0; k < 2; ++k) dst[m][k] = *(const LAS bf16x8*)(lds + PG8_SA(b, h) + aoff + m * 2048 + k * 1024); } while (0)
#define PG8_LDB(dst, b, h) do { _Pragma("unroll") for (int n = 0; n < 2; ++n) _Pragma("unroll") for (int k = 0; k < 2; ++k) dst[n][k] = *(const LAS bf16x8*)(lds + PG8_SB(b, h) + boff + n * 2048 + k * 1024); } while (0)
#define PG8_MMA(ai, bj, At, Bt) do { __builtin_amdgcn_s_setprio(1); _Pragma("unroll") for (int m = 0; m < 4; ++m) _Pragma("unroll") for (int n = 0; n < 2; ++n) _Pragma("unroll") for (int k = 0; k < 2; ++k) \
        acc[ai][bj][m][n] = __builtin_amdgcn_mfma_f32_16x16x32_bf16(Bt[n][k], At[m][k], acc[ai][bj][m][n], 0, 0, 0); __builtin_amdgcn_s_setprio(0); } while (0)
#define PG8_WAIT_V(n) asm volatile("s_waitcnt vmcnt(" #n ")" ::: "memory")
#define PG8_WAIT_L(n) asm volatile("s_waitcnt lgkmcnt(" #n ")" ::: "memory")
#define PG8_BAR __builtin_amdgcn_s_barrier()
#define PG8_SCHED __builtin_amdgcn_sched_barrier(0)
    Unit cur, nxt; int ui = 0;
    if (!S.next(0, cur)) return;
    Acc acc;
#pragma unroll
    for (int a = 0; a < 2; ++a)
#pragma unroll
        for (int b = 0; b < 2; ++b)
#pragma unroll
            for (int m = 0; m < 4; ++m)
#pragma unroll
                for (int n = 0; n < 2; ++n) acc[a][b][m][n] = (f32x4){0.f, 0.f, 0.f, 0.f};
    bf16x8 At[4][2], B0[2][2], B1[2][2];
    const char* cA = (const char*)g.A + cur.offA; const char* cB = (const char*)g.Bt + cur.offB;
    if constexpr (SP2) {
        PG8_STAGE(PG8_SB(0, 0), cB, voffB); PG8_STAGE(PG8_SB(0, 1), cB + hstepB, voffB); PG8_STAGE(PG8_SA(0, 0), cA, voffA); PG8_STAGE(PG8_SA(0, 1), cA + hstepA, voffA);
        if (wr == 1) PG8_BAR;
        PG8_WAIT_V(2); PG8_BAR;
        PG8_STAGE(PG8_SB(1, 0), cB + kstep, voffB); PG8_STAGE(PG8_SA(1, 0), cA + kstep, voffA); PG8_STAGE(PG8_SB(1, 1), cB + hstepB + kstep, voffB);
        PG8_WAIT_V(6); PG8_BAR;
    } else {
        PG8_STAGE(PG8_SB(0, 0), cB, voffB); PG8_STAGE(PG8_SA(0, 0), cA, voffA); PG8_STAGE(PG8_SB(0, 1), cB + hstepB, voffB); PG8_STAGE(PG8_SA(0, 1), cA + hstepA, voffA);
        if (wr == 1) PG8_BAR;
        PG8_WAIT_V(4); PG8_BAR;
        PG8_STAGE(PG8_SB(1, 0), cB + kstep, voffB); PG8_STAGE(PG8_SA(1, 0), cA + kstep, voffA); PG8_STAGE(PG8_SB(1, 1), cB + hstepB + kstep, voffB);
        PG8_WAIT_V(6); PG8_BAR;
    }
    for (;;) {
        const bool has_next = S.next(ui + 1, nxt);
        const char* nA = has_next ? (const char*)g.A + nxt.offA : cA; const char* nB = has_next ? (const char*)g.Bt + nxt.offB : cB;
        const int nt = cur.nt;
        for (int t = 0; t < nt; t += 2) {
            const bool last = (t == nt - 2);
            const char* a1 = cA + (size_t)(t + 1) * kstep;
            const char* a2 = last ? nA : cA + (size_t)(t + 2) * kstep; const char* b2 = last ? nB : cB + (size_t)(t + 2) * kstep;
            const char* a3 = a2 + kstep; const char* b3 = b2 + kstep;
            if constexpr (SP2) {
            PG8_LDB(B0, 0, 0); PG8_LDB(B1, 0, 1); PG8_SCHED; PG8_LDA(At, 0, 0); PG8_STAGE(PG8_SA(1, 1), a1 + hstepA, voffA);
            PG8_WAIT_V(8); PG8_WAIT_L(0); PG8_BAR; PG8_MMA(0, 0, At, B0); PG8_MMA(0, 1, At, B1); PG8_BAR; PG8_SCHED;
            PG8_LDA(At, 0, 1); PG8_STAGE(PG8_SB(0, 0), b2, voffB); PG8_STAGE(PG8_SB(0, 1), b2 + hstepB, voffB); PG8_STAGE(PG8_SA(0, 0), a2, voffA);
            PG8_WAIT_V(8); PG8_WAIT_L(0); PG8_BAR; PG8_MMA(1, 0, At, B0); PG8_MMA(1, 1, At, B1); PG8_BAR; PG8_SCHED;
            PG8_LDB(B0, 1, 0); PG8_LDB(B1, 1, 1); PG8_SCHED; PG8_LDA(At, 1, 0); PG8_STAGE(PG8_SA(0, 1), a2 + hstepA, voffA);
            PG8_WAIT_V(8); PG8_WAIT_L(0); PG8_BAR; PG8_MMA(0, 0, At, B0); PG8_MMA(0, 1, At, B1); PG8_BAR; PG8_SCHED;
            PG8_LDA(At, 1, 1); PG8_STAGE(PG8_SB(1, 0), b3, voffB); PG8_STAGE(PG8_SB(1, 1), b3 + hstepB, voffB); PG8_STAGE(PG8_SA(1, 0), a3, voffA);
            PG8_WAIT_V(8); PG8_WAIT_L(0); PG8_BAR; PG8_MMA(1, 0, At, B0); PG8_MMA(1, 1, At, B1); PG8_BAR; PG8_SCHED;
            } else {
            PG8_LDB(B0, 0, 0); PG8_SCHED; PG8_LDA(At, 0, 0); PG8_STAGE(PG8_SA(1, 1), a1 + hstepA, voffA);
            PG8_WAIT_L(8); PG8_BAR; PG8_WAIT_L(0); PG8_MMA(0, 0, At, B0); PG8_BAR; PG8_SCHED;
            PG8_LDB(B1, 0, 1); PG8_STAGE(PG8_SB(0, 0), b2, voffB);
            PG8_BAR; PG8_WAIT_L(0); PG8_MMA(0, 1, At, B1); PG8_BAR;
            PG8_LDA(At, 0, 1); PG8_STAGE(PG8_SA(0, 0), a2, voffA);
            PG8_BAR; PG8_WAIT_L(0); PG8_MMA(1, 0, At, B0); PG8_BAR; PG8_SCHED;
            PG8_STAGE(PG8_SB(0, 1), b2 + hstepB, voffB);
            PG8_WAIT_V(6); PG8_BAR; PG8_MMA(1, 1, At, B1); PG8_BAR;
            PG8_LDB(B0, 1, 0); PG8_SCHED; PG8_LDA(At, 1, 0); PG8_STAGE(PG8_SA(0, 1), a2 + hstepA, voffA);
            PG8_WAIT_L(8); PG8_BAR; PG8_WAIT_L(0); PG8_MMA(0, 0, At, B0); PG8_BAR; PG8_SCHED;
            PG8_LDB(B1, 1, 1); PG8_STAGE(PG8_SB(1, 0), b3, voffB);
            PG8_BAR; PG8_WAIT_L(0); PG8_MMA(0, 1, At, B1); PG8_BAR;
            PG8_LDA(At, 1, 1); PG8_STAGE(PG8_SA(1, 0), a3, voffA);
            PG8_BAR; PG8_WAIT_L(0); PG8_MMA(1, 0, At, B0); PG8_BAR; PG8_SCHED;
            PG8_STAGE(PG8_SB(1, 1), b3 + hstepB, voffB);
            PG8_WAIT_V(6); PG8_BAR; PG8_MMA(1, 1, At, B1); PG8_BAR;
            }
        }
        if constexpr (ALIGN_EPI) { if (wr == 0) PG8_BAR; }
        E(acc, cur, wr, wc, fr, fq);
        if (!has_next) break;
        if (!E.keep(cur)) {
#pragma unroll
            for (int a = 0; a < 2; ++a)
#pragma unroll
                for (int b = 0; b < 2; ++b)
#pragma unroll
                    for (int m = 0; m < 4; ++m)
#pragma unroll
                        for (int n = 0; n < 2; ++n) acc[a][b][m][n] = (f32x4){0.f, 0.f, 0.f, 0.f};
        }
        cur = nxt; cA = nA; cB = nB; ++ui;
        if constexpr (ALIGN_EPI) { if (wr == 1) PG8_BAR; }
    }
    PG8_WAIT_V(0);
    if constexpr (!ALIGN_EPI) { if (wr == 0) PG8_BAR; }
    PG8_BAR;
#undef PG8_SA
#undef PG8_SB
#undef PG8_STAGE
#undef PG8_LDA
#undef PG8_LDB
#undef PG8_MMA
#undef PG8_WAIT_V
#undef PG8_WAIT_L
#undef PG8_BAR
#undef PG8_SCHED
}
}

#ifndef USE_FAST_GEMM
#define USE_FAST_GEMM 1
#endif
template <class Epi, class Sched>
__device__ __forceinline__ void run_gemm(LAS unsigned char* lds, const pg8::Gemm g, const Sched& S, const Epi& E) {
#if USE_FAST_GEMM
    pg8::gemm_phase<Epi, Sched, true, true>(lds, g, S, E);
#else
    pg8::gemm_simple<Epi, Sched>(g, S, E);
#endif
}

constexpr int NWAVES = 8;
constexpr int RING_BYTES = 131072;
constexpr int LDS_BYTES = 147456;
constexpr int MISC_OFF = LDS_BYTES - 128;

struct Args {
    const float* in[24]; float* out; unsigned char* ws; int ph_lo, ph_hi, li, pad;
};
enum { I_X = 0, I_P, I_MIXG, I_WIN, I_CONVW, I_CONVB, I_DTB, I_ALOG, I_DSKIP, I_SSDG, I_WOA, I_WOB, I_WOUT, I_FFNG, I_WRG, I_BRG, I_WRE, I_BRE, I_WGATE, I_WUP, I_WDOWN, I_WPP, I_WPG, I_FING };

struct Frame {
    LAS unsigned char* lds;
    int tid, lane, wave, vcu, G;
    const float* const* in; float* out; unsigned char* ws;
};

__device__ __forceinline__ void transpose_item(const float* W, int ldsrc, int k0, int c0, bf16* WT, int ldt, int r0, int kd0, LAS float* scr, int lane) {
#pragma unroll 8
    for (int i = 0; i < 32; ++i) { const int kk = 2 * i + (lane >> 5); scr[kk * 33 + (lane & 31)] = W[(size_t)(k0 + kk) * ldsrc + c0 + (lane & 31)]; }
    LDS_WAIT(); asm volatile("" ::: "memory");
    const int c = lane & 7;
#pragma unroll
    for (int j = 0; j < 4; ++j) { const int n = (lane >> 3) + 8 * j; const LAS float* s = scr + (8 * c) * 33 + n;
        u32x4 o; o.x = pk2(s[0 * 33], s[1 * 33]); o.y = pk2(s[2 * 33], s[3 * 33]); o.z = pk2(s[4 * 33], s[5 * 33]); o.w = pk2(s[6 * 33], s[7 * 33]);
        *(GAS u32x4*)(WT + (size_t)(r0 + n) * ldt + kd0 + k0 + 8 * c) = o; }
    LDS_WAIT(); asm volatile("" ::: "memory");
}

__device__ __forceinline__ void phase_prologue(Frame& F) {
    const int gw = F.vcu * NWAVES + F.wave, NGW = F.G * NWAVES;
    LAS float* scr = (LAS float*)(F.lds + F.wave * 8704);
    bf16* WCAT2 = (bf16*)(F.ws + WS_WCAT2); bf16* BCAT = (bf16*)(F.ws + WS_BCAT); bf16* WOUT = (bf16*)(F.ws + WS_WOUT); bf16* WPG = (bf16*)(F.ws + WS_WPG);
    constexpr int I0 = 16 * 128, I1 = 16 * 64, I2 = 4 * 32, I3 = 8 * 32, I4 = 16 * 32, I5 = 16 * 32, I6 = 16 * 32, NIT = I0 + I1 + I2 + I3 + I4 + I5 + I6;
    for (int it = gw; it < NIT; it += NGW) {
        int r = it;
        if (r < I0) { transpose_item(F.in[I_WIN], IN_DIM, 64 * (r / 128), 32 * (r % 128), WCAT2, 1280, 32 * (r % 128), 0, scr, F.lane); continue; } r -= I0;
        if (r < I1) { transpose_item(F.in[I_WIN], IN_DIM, 64 * (r / 64), OFF_GA + 32 * (r % 64), WCAT2, 1280, 4096 + 32 * (r % 64), 0, scr, F.lane); continue; } r -= I1;
        if (r < I2) { transpose_item(F.in[I_WPP], DM, 64 * (r / 32), 32 * (r % 32), WCAT2, 1280, 6144 + 32 * (r % 32), 1024, scr, F.lane); continue; } r -= I2;
        if (r < I3) { transpose_item(F.in[I_WOA], DM, 64 * (r / 32), 32 * (r % 32), BCAT, 1536, 32 * (r % 32), 0, scr, F.lane); continue; } r -= I3;
        if (r < I4) { transpose_item(F.in[I_WOB], DM, 64 * (r / 32), 32 * (r % 32), BCAT, 1536, 32 * (r % 32), 512, scr, F.lane); continue; } r -= I4;
        if (r < I5) { transpose_item(F.in[I_WOUT], DM, 64 * (r / 32), 32 * (r % 32), WOUT, 1024, 32 * (r % 32), 0, scr, F.lane); continue; } r -= I5;
        transpose_item(F.in[I_WPG], DM, 64 * (r / 32), 32 * (r % 32), WPG, 1024, 32 * (r % 32), 0, scr, F.lane);
    }
    __syncthreads();
    LAS float* wdt = (LAS float*)(F.lds + 8 * 8704);
    for (int i = F.tid; i < 16 * 1024; i += NWAVES * 64) { const int k = i >> 4, c = i & 15; wdt[c * 1024 + k] = F.in[I_WIN][(size_t)k * IN_DIM + OFF_DT + c]; }
    __syncthreads();
    bf16* ACAT2 = (bf16*)(F.ws + WS_ACAT2); float* DTRAW = (float*)(F.ws + WS_DTRAW);
    const float* X = F.in[I_X]; const float* P = F.in[I_P]; const float* G = F.in[I_MIXG];
    for (int m = gw; m < M; m += NGW) {
        const GAS f32x4* xr = (const GAS f32x4*)(X + (size_t)m * DM) + F.lane;
        f32x4 v[4]; float s = 0.f;
#pragma unroll
        for (int j = 0; j < 4; ++j) { v[j] = xr[64 * j]; s += (v[j].x * v[j].x + v[j].y * v[j].y) + (v[j].z * v[j].z + v[j].w * v[j].w); }
        const float r = 1.0f / sqrtf(wave_sum(s) * (1.f / DM) + EPS);
        GAS unsigned long long* o8 = (GAS unsigned long long*)(ACAT2 + (size_t)m * 1280) + F.lane;
#pragma unroll
        for (int j = 0; j < 4; ++j) { const f32x4 gg = *((const GAS f32x4*)G + F.lane + 64 * j); v[j] = v[j] * r * gg;
            o8[64 * j] = (unsigned long long)pk2(v[j].x, v[j].y) | ((unsigned long long)pk2(v[j].z, v[j].w) << 32); }
        float dv = 0.f;
#pragma unroll 2
        for (int c = 0; c < 16; ++c) { float a = 0.f;
#pragma unroll
            for (int j = 0; j < 4; ++j) { const f32x4 w = *(const LAS f32x4*)(wdt + c * 1024 + 256 * j + 4 * F.lane); a += (v[j].x * w.x + v[j].y * w.y) + (v[j].z * w.z + v[j].w * w.w); }
            a = wave_sum(a); dv = (F.lane == c) ? a : dv; }
        if (F.lane < 16) DTRAW[(size_t)m * 16 + F.lane] = dv;
        const f32x4 pv = *((const GAS f32x4*)(P + (size_t)m * PLE) + F.lane);
        *((GAS unsigned long long*)(ACAT2 + (size_t)m * 1280 + 1024) + F.lane) = (unsigned long long)pk2(pv.x, pv.y) | ((unsigned long long)pk2(pv.z, pv.w) << 32);
    }
}

struct EpiProj {
    static constexpr bool PERM = true;
    bf16 *Q, *K, *V, *Z, *XBC, *GA, *GB, *PP;
    __device__ __forceinline__ bool keep(const pg8::Unit&) const { return false; }
    __device__ __forceinline__ void operator()(pg8::Acc& acc, const pg8::Unit& u, int wr, int wc, int fr, int fq) const {
        const int pn = u.pn; bf16* base; int ldc, colt, act = 0;
        if (pn < 2) { base = Q; ldc = 512; colt = pn * 256; act = 1; }
        else if (pn < 4) { base = K; ldc = 512; colt = (pn - 2) * 256; }
        else if (pn < 6) { base = V; ldc = 512; colt = (pn - 4) * 256; }
        else if (pn < 10) { base = Z; ldc = 1024; colt = (pn - 6) * 256; }
        else if (pn < 16) { base = XBC; ldc = 1536; colt = (pn - 10) * 256; }
        else if (pn < 20) { base = GA; ldc = 1024; colt = (pn - 16) * 256; act = 2; }
        else if (pn < 24) { base = GB; ldc = 1024; colt = (pn - 20) * 256; act = 2; }
        else { base = PP; ldc = 1024; colt = (pn - 24) * 256; }
        const int row0 = u.pm * 256 + wr * 64 + fr, col0 = colt + wc * 32 + 8 * fq;
#pragma unroll
        for (int ai = 0; ai < 2; ++ai)
#pragma unroll
            for (int m = 0; m < 4; ++m) { bf16* rowp = base + (size_t)(row0 + ai * 128 + m * 16) * ldc + col0;
#pragma unroll
                for (int bj = 0; bj < 2; ++bj) { f32x4 v0 = acc[ai][bj][m][0], v1 = acc[ai][bj][m][1];
                    if (act == 1) { v0 = v0 * C2; v1 = v1 * C2; }
                    if (act == 2) {
#pragma unroll
                        for (int j = 0; j < 4; ++j) { v0[j] = sigmoidf_(v0[j]); v1[j] = sigmoidf_(v1[j]); } }
                    u32x4 w; w.x = pg8::cvt_pk_bf16(v0[0], v0[1]); w.y = pg8::cvt_pk_bf16(v0[2], v0[3]); w.z = pg8::cvt_pk_bf16(v1[0], v1[1]); w.w = pg8::cvt_pk_bf16(v1[2], v1[3]);
                    *(u32x4*)(rowp + bj * 128) = w; } }
    }
};
struct SchedProj {
    int G, c;
    __device__ __forceinline__ bool next(int i, pg8::Unit& u) const {
        const int L = i * G + c; constexpr int NP = 64 * 24, NQ = 64 * 4;
        if (L >= NP + NQ) return false;
        int pm, pn;
        if (L < NP) { pg8::tile_of(L, 64, 24, pm, pn); u.pm = pm; u.pn = pn; u.aux = 0; u.nt = 16; u.offA = (size_t)pm * 256 * 1280 * 2; u.offB = (size_t)pn * 256 * 1280 * 2; }
        else { pg8::tile_of(L - NP, 64, 4, pm, pn); u.pm = pm; u.pn = 24 + pn; u.aux = 0; u.nt = 4; u.offA = (size_t)pm * 256 * 1280 * 2 + 1024 * 2; u.offB = (size_t)(6144 + pn * 256) * 1280 * 2 + 1024 * 2; }
        return true;
    }
};
__device__ __forceinline__ void phase_proj(Frame& F) {
    pg8::Gemm g{(const bf16*)(F.ws + WS_ACAT2), (const bf16*)(F.ws + WS_WCAT2), 1280, 1280};
    EpiProj E{(bf16*)(F.ws + WS_Q), (bf16*)(F.ws + WS_K), (bf16*)(F.ws + WS_V), (bf16*)(F.ws + WS_Z), (bf16*)(F.ws + WS_XBC), (bf16*)F.out, (bf16*)F.out + (size_t)M * DM, (bf16*)(F.ws + WS_PP)};
    SchedProj S{F.G, (int)blockIdx.x};
    run_gemm(F.lds, g, S, E);
}

__device__ __forceinline__ void phase_conv(Frame& F) {
    const int gt = F.vcu * (NWAVES * 64) + F.tid, NGT = F.G * NWAVES * 64;
    const bf16* XBC = (const bf16*)(F.ws + WS_XBC); bf16* XA = (bf16*)(F.ws + WS_XBCACT);
    const float* CW = F.in[I_CONVW]; const float* CB = F.in[I_CONVB];
    for (int it = gt; it < M * (CONVD / 8); it += NGT) {
        const int m = it / (CONVD / 8), c0 = (it % (CONVD / 8)) * 8, s = m % SEQ;
        float a[8];
#pragma unroll
        for (int j = 0; j < 8; ++j) a[j] = CB[c0 + j];
#pragma unroll
        for (int k = 0; k < 4; ++k) { const int ds = 3 - k; if (s - ds >= 0) {
                const u32x4 r = *(const GAS u32x4*)(XBC + (size_t)(m - ds) * CONVD + c0);
                const f32x4 w0 = *(const GAS f32x4*)(CW + k * CONVD + c0), w1 = *(const GAS f32x4*)(CW + k * CONVD + c0 + 4);
                a[0] += bflo(r.x) * w0.x; a[1] += bfhi(r.x) * w0.y; a[2] += bflo(r.y) * w0.z; a[3] += bfhi(r.y) * w0.w;
                a[4] += bflo(r.z) * w1.x; a[5] += bfhi(r.z) * w1.y; a[6] += bflo(r.w) * w1.z; a[7] += bfhi(r.w) * w1.w; } }
#pragma unroll
        for (int j = 0; j < 8; ++j) a[j] = a[j] * sigmoidf_(a[j]);
        u32x4 o; o.x = pk2(a[0], a[1]); o.y = pk2(a[2], a[3]); o.z = pk2(a[4], a[5]); o.w = pk2(a[6], a[7]);
        *(GAS u32x4*)(XA + (size_t)m * CONVD + c0) = o;
    }
    {
        const int gw = F.vcu * NWAVES + F.wave, NGW = F.G * NWAVES;
        const float* DTRAW = (const float*)(F.ws + WS_DTRAW); float* DT = (float*)(F.ws + WS_DT); float* CS = (float*)(F.ws + WS_CS);
        for (int it = gw; it < (M / 256) * SH; it += NGW) {
            const int ch = it / SH, j = it % SH; const float bias = F.in[I_DTB][j], a = -__expf(F.in[I_ALOG][j]);
            float dt[4], cs[4]; float run = 0.f;
#pragma unroll
            for (int e = 0; e < 4; ++e) { const float x = DTRAW[(size_t)(ch * 256 + 4 * F.lane + e) * 16 + j] + bias; dt[e] = x > 20.f ? x : log1pf(__expf(x)); run += dt[e] * a; cs[e] = run; }
            float inc = run;
#pragma unroll
            for (int o = 1; o < 64; o <<= 1) { const float t = __shfl_up(inc, o); if (F.lane >= o) inc += t; }
            const float excl = inc - run;
#pragma unroll
            for (int e = 0; e < 4; ++e) { const size_t idx = (size_t)(ch * 256 + 4 * F.lane + e) * 16 + j; DT[idx] = dt[e]; CS[idx] = cs[e] + excl; }
        }
        const bf16* Kb = (const bf16*)(F.ws + WS_K); float* KM = (float*)(F.ws + WS_KMEAN);
        for (int it = gw; it < NBATCH * AH * NBLK; it += NGW) {
            const int b = it / (AH * NBLK), h = (it / NBLK) % AH, kb = it % NBLK;
            float s = 0.f;
            for (int r = 0; r < 256; ++r) s += bf2f(Kb[(size_t)(b * SEQ + kb * 256 + r) * AW + h * 64 + F.lane]);
            KM[(size_t)it * 64 + F.lane] = s * (1.f / 256.f);
        }
    }
}

__device__ __forceinline__ void phase_norm(Frame& F) {
    const int gw = F.vcu * NWAVES + F.wave, NGW = F.G * NWAVES;
    bf16* ACAT = (bf16*)(F.ws + WS_ACAT); const float* SS = (const float*)(F.ws + WS_SUMSQ); const float* NG = F.in[I_SSDG];
    for (int m = gw; m < M; m += NGW) {
        float s0 = 0.f, s1 = 0.f;
#pragma unroll
        for (int j = 0; j < 8; ++j) { s0 += SS[(size_t)m * 16 + j]; s1 += SS[(size_t)m * 16 + 8 + j]; }
        const float r0 = 1.0f / sqrtf(s0 * (1.f / 512.f) + EPS), r1 = 1.0f / sqrtf(s1 * (1.f / 512.f) + EPS);
        GAS u32x4* row = (GAS u32x4*)(ACAT + (size_t)m * 1536 + 512);
#pragma unroll
        for (int j = 0; j < 2; ++j) { const int c8 = F.lane + 64 * j; const float r = j == 0 ? r0 : r1;
            u32x4 w = row[c8]; const f32x4 g0 = *(const GAS f32x4*)(NG + 8 * c8), g1 = *(const GAS f32x4*)(NG + 8 * c8 + 4);
            w.x = pk2(bflo(w.x) * r * g0.x, bfhi(w.x) * r * g0.y); w.y = pk2(bflo(w.y) * r * g0.z, bfhi(w.y) * r * g0.w);
            w.z = pk2(bflo(w.z) * r * g1.x, bfhi(w.z) * r * g1.y); w.w = pk2(bflo(w.w) * r * g1.z, bfhi(w.w) * r * g1.w);
            row[c8] = w; }
    }
    LAS float* scr = (LAS float*)(F.lds + F.wave * 8704);
    bf16* WGU = (bf16*)(F.ws + WS_WGU); bf16* WD = (bf16*)(F.ws + WS_WD);
    constexpr int IG = NE * 16 * 16, ID = NE * 8 * 32;
    for (int it = gw; it < 2 * IG + ID; it += NGW) {
        int r = it;
        if (r < 2 * IG) { const int up = r >= IG; if (up) r -= IG; const int e = r / 256, kb = (r % 256) / 16, nb = r % 16;
            const float* W = F.in[up ? I_WUP : I_WGATE] + (size_t)e * DM * FF;
            const int j0 = 32 * nb, row0 = e * 1024 + 256 * (j0 / 128) + (j0 % 128) + (up ? 128 : 0);
            transpose_item(W, FF, 64 * kb, j0, WGU, 1024, row0, 0, scr, F.lane); }
        else { r -= 2 * IG; const int e = r / 256, kb = (r % 256) / 32, nb = r % 32;
            const float* W = F.in[I_WDOWN] + (size_t)e * FF * DM;
            transpose_item(W, DM, 64 * kb, 32 * nb, WD, 512, e * 1024 + 32 * nb, 0, scr, F.lane); }
    }
}

struct EpiMerge {
    static constexpr bool PERM = true;
    const bf16 *GA, *GB; bf16* OUT;
    __device__ __forceinline__ bool keep(const pg8::Unit& u) const { return u.aux == 0; }
    __device__ __forceinline__ void operator()(pg8::Acc& acc, const pg8::Unit& u, int wr, int wc, int fr, int fq) const {
        const int row0 = u.pm * 256 + wr * 64 + fr, col0 = u.pn * 256 + wc * 32 + 8 * fq;
#pragma unroll
        for (int ai = 0; ai < 2; ++ai)
#pragma unroll
            for (int m = 0; m < 4; ++m) { const size_t off = (size_t)(row0 + ai * 128 + m * 16) * DM + col0;
#pragma unroll
                for (int bj = 0; bj < 2; ++bj) {
                    const u32x4 gb = *(const u32x4*)(GB + off + bj * 128);
                    const float b[8] = {bflo(gb.x), bfhi(gb.x), bflo(gb.y), bfhi(gb.y), bflo(gb.z), bfhi(gb.z), bflo(gb.w), bfhi(gb.w)};
                    if (u.aux == 0) {
                        const u32x4 ga = *(const u32x4*)(GA + off + bj * 128);
                        const float a[8] = {bflo(ga.x), bfhi(ga.x), bflo(ga.y), bfhi(ga.y), bflo(ga.z), bfhi(ga.z), bflo(ga.w), bfhi(ga.w)};
#pragma unroll
                        for (int j = 0; j < 4; ++j) { acc[ai][bj][m][0][j] *= a[j] * __builtin_amdgcn_rcpf(fmaxf(b[j], 1e-30f)); acc[ai][bj][m][1][j] *= a[4 + j] * __builtin_amdgcn_rcpf(fmaxf(b[4 + j], 1e-30f)); }
                    } else {
                        const f32x4 v0 = acc[ai][bj][m][0], v1 = acc[ai][bj][m][1];
                        u32x4 w; w.x = pg8::cvt_pk_bf16(v0[0] * b[0], v0[1] * b[1]); w.y = pg8::cvt_pk_bf16(v0[2] * b[2], v0[3] * b[3]);
                        w.z = pg8::cvt_pk_bf16(v1[0] * b[4], v1[1] * b[5]); w.w = pg8::cvt_pk_bf16(v1[2] * b[6], v1[3] * b[7]);
                        *(u32x4*)(OUT + off + bj * 128) = w;
                    } } }
    }
};
struct SchedMerge {
    int G, c;
    __device__ __forceinline__ bool next(int i, pg8::Unit& u) const {
        const int T = (i >> 1) * G + c; if (T >= 256) return false;
        int pm, pn; pg8::tile_of(T, 64, 4, pm, pn); const int sub = i & 1;
        u.pm = pm; u.pn = pn; u.aux = sub; u.nt = sub ? 16 : 8;
        u.offA = (size_t)pm * 256 * 1536 * 2 + (sub ? 512 * 2 : 0); u.offB = (size_t)pn * 256 * 1536 * 2 + (sub ? 512 * 2 : 0);
        return true;
    }
};
__device__ __forceinline__ void phase_merge(Frame& F) {
    pg8::Gemm g{(const bf16*)(F.ws + WS_ACAT), (const bf16*)(F.ws + WS_BCAT), 1536, 1536};
    EpiMerge E{(const bf16*)F.out, (const bf16*)F.out + (size_t)M * DM, (bf16*)(F.ws + WS_MERGED)};
    SchedMerge S{F.G, (int)blockIdx.x};
    run_gemm(F.lds, g, S, E);
}

struct SchedPlain {
    int G, c, nN, nt, lda, ldb;
    __device__ __forceinline__ bool next(int i, pg8::Unit& u) const {
        const int L = i * G + c; if (L >= 64 * nN) return false;
        int pm, pn; pg8::tile_of(L, 64, nN, pm, pn);
        u.pm = pm; u.pn = pn; u.aux = 0; u.nt = nt; u.offA = (size_t)pm * 256 * lda * 2; u.offB = (size_t)pn * 256 * ldb * 2; return true;
    }
};
struct EpiX1 {
    static constexpr bool PERM = false;
    const float* X; float* OUT;
    __device__ __forceinline__ bool keep(const pg8::Unit&) const { return false; }
    __device__ __forceinline__ void operator()(pg8::Acc& acc, const pg8::Unit& u, int wr, int wc, int fr, int fq) const {
        const int row0 = u.pm * 256 + wr * 64 + fr, col0 = u.pn * 256 + wc * 32 + 4 * fq;
#pragma unroll
        for (int ai = 0; ai < 2; ++ai)
#pragma unroll
            for (int m = 0; m < 4; ++m) { const size_t off = (size_t)(row0 + ai * 128 + m * 16) * DM + col0;
#pragma unroll
                for (int bj = 0; bj < 2; ++bj)
#pragma unroll
                    for (int n = 0; n < 2; ++n) { const f32x4 xv = *(const f32x4*)(X + off + bj * 128 + n * 16); *(f32x4*)(OUT + off + bj * 128 + n * 16) = xv + acc[ai][bj][m][n]; } }
    }
};
__device__ __forceinline__ void phase_x1(Frame& F) {
    pg8::Gemm g{(const bf16*)(F.ws + WS_MERGED), (const bf16*)(F.ws + WS_WOUT), 1024, 1024};
    EpiX1 E{F.in[I_X], F.out};
    SchedPlain S{F.G, (int)blockIdx.x, 4, 16, 1024, 1024};
    run_gemm(F.lds, g, S, E);
}

__device__ __forceinline__ void cls_experts(int cls, int& ea, int& eb) { const int g = cls / 6, p = cls % 6; const int a = p < 3 ? 0 : (p < 5 ? 1 : 2), b = p < 3 ? p + 1 : (p < 5 ? p - 1 : 3); ea = g * 4 + a; eb = g * 4 + b; }
__device__ __forceinline__ void phase_route1(Frame& F) {
    LAS float* wl = (LAS float*)F.lds; LAS int* hist = (LAS int*)(F.lds + 20 * 1024 * 4);
    for (int i = F.tid; i < 4 * 1024; i += NWAVES * 64) { const int k = i >> 2, c = i & 3; wl[c * 1024 + k] = F.in[I_WRG][(size_t)k * 4 + c]; }
    for (int i = F.tid; i < 16 * 1024; i += NWAVES * 64) { const int k = i >> 4, c = i & 15; wl[(4 + c) * 1024 + k] = F.in[I_WRE][(size_t)k * 16 + c]; }
    if (F.tid < NCLS) hist[F.tid] = 0;
    __syncthreads();
    const float* X1 = F.out; const float* G = F.in[I_FFNG]; bf16* H2B = (bf16*)(F.ws + WS_H2B);
    int* CLS = (int*)(F.ws + WS_CLS); float* WTS = (float*)(F.ws + WS_WTS);
    const int blk = blockIdx.x;
    for (int rr = F.wave; rr < 64; rr += NWAVES) {
        const int m = blk * 64 + rr;
        const GAS f32x4* xr = (const GAS f32x4*)(X1 + (size_t)m * DM) + F.lane;
        f32x4 v[4]; float s = 0.f;
#pragma unroll
        for (int j = 0; j < 4; ++j) { v[j] = xr[64 * j]; s += (v[j].x * v[j].x + v[j].y * v[j].y) + (v[j].z * v[j].z + v[j].w * v[j].w); }
        const float r = 1.0f / sqrtf(wave_sum(s) * (1.f / DM) + EPS);
        GAS unsigned long long* o8 = (GAS unsigned long long*)(H2B + (size_t)m * DM) + F.lane;
#pragma unroll
        for (int j = 0; j < 4; ++j) { const f32x4 gg = *((const GAS f32x4*)G + F.lane + 64 * j); v[j] = v[j] * r * gg;
            o8[64 * j] = (unsigned long long)pk2(v[j].x, v[j].y) | ((unsigned long long)pk2(v[j].z, v[j].w) << 32); }
        float lg[20];
#pragma unroll
        for (int c = 0; c < 20; ++c) { float a = 0.f;
#pragma unroll
            for (int j = 0; j < 4; ++j) { const f32x4 w = *(const LAS f32x4*)(wl + c * 1024 + 256 * j + 4 * F.lane); a += (v[j].x * w.x + v[j].y * w.y) + (v[j].z * w.z + v[j].w * w.w); }
            lg[c] = wave_sum(a); }
        if (F.lane == 0) {
            float gl[4]; int gs = 0;
#pragma unroll
            for (int c = 0; c < 4; ++c) gl[c] = lg[c] + F.in[I_BRG][c];
#pragma unroll
            for (int c = 1; c < 4; ++c) if (gl[c] > gl[gs]) gs = c;
            float den = 0.f;
#pragma unroll
            for (int c = 0; c < 4; ++c) den += __expf(gl[c] - gl[gs]);
            const float gpw = 1.f / den;
            float el[4];
#pragma unroll
            for (int c = 0; c < 4; ++c) { float v0 = lg[4 + c] + F.in[I_BRE][c];
#pragma unroll
                for (int gg = 1; gg < 4; ++gg) v0 = (gs == gg) ? lg[4 + gg * 4 + c] + F.in[I_BRE][gg * 4 + c] : v0;
                el[c] = v0; }
            int i0 = 0;
#pragma unroll
            for (int c = 1; c < 4; ++c) if (el[c] > el[i0]) i0 = c;
            int i1 = (i0 == 0) ? 1 : 0;
#pragma unroll
            for (int c = 0; c < 4; ++c) if (c != i0 && el[c] > el[i1]) i1 = c;
            const float e1 = __expf(el[i1] - el[i0]), w0 = gpw / (1.f + e1), w1 = gpw * e1 / (1.f + e1);
            const int a = i0 < i1 ? i0 : i1, b = i0 < i1 ? i1 : i0; const float wa = i0 < i1 ? w0 : w1, wb = i0 < i1 ? w1 : w0;
            const int pair = (a == 0) ? (b - 1) : (a == 1 ? (b + 1) : 5);
            const int cls = gs * 6 + pair;
            CLS[m] = cls; WTS[2 * m] = wa; WTS[2 * m + 1] = wb;
            atomicAdd((int*)hist + cls, 1);
        }
    }
    __syncthreads();
    if (F.tid < NCLS) ((int*)(F.ws + WS_HIST))[blk * NCLS + F.tid] = hist[F.tid];
}

__device__ __forceinline__ void phase_route2(Frame& F) {
    LAS int* tot = (LAS int*)F.lds; LAS int* pre = tot + 32; LAS int* base = pre + 32; LAS int* lcls = base + 32; LAS int* lpos = lcls + 64;
    const int* HIST = (const int*)(F.ws + WS_HIST); const int blk = blockIdx.x;
    if (F.tid < NCLS) { int t = 0, p = 0; for (int b = 0; b < 256; ++b) { const int h = HIST[b * NCLS + F.tid]; if (b < blk) p += h; t += h; } tot[F.tid] = t; pre[F.tid] = p; }
    __syncthreads();
    if (F.tid == 0) { int acc = 0; for (int c = 0; c < NCLS; ++c) { base[c] = acc; acc += ((tot[c] + 255) >> 8) << 8; } base[NCLS] = acc; }
    const int* CLS = (const int*)(F.ws + WS_CLS);
    if (F.tid < 64) lcls[F.tid] = CLS[blk * 64 + F.tid];
    __syncthreads();
    if (F.tid < 64) { const int c = lcls[F.tid]; int rank = 0; for (int j = 0; j < F.tid; ++j) rank += (lcls[j] == c) ? 1 : 0; lpos[F.tid] = base[c] + pre[c] + rank; }
    __syncthreads();
    int* PERM = (int*)(F.ws + WS_PERM); float* WPOS = (float*)(F.ws + WS_WPOS); const float* WTS = (const float*)(F.ws + WS_WTS);
    const bf16* H2B = (const bf16*)(F.ws + WS_H2B); bf16* XS = (bf16*)(F.ws + WS_XS);
    for (int rr = F.wave; rr < 64; rr += NWAVES) {
        const int m = blk * 64 + rr, pos = lpos[rr];
        const GAS u32x4* src = (const GAS u32x4*)(H2B + (size_t)m * DM); GAS u32x4* dst = (GAS u32x4*)(XS + (size_t)pos * DM);
        dst[F.lane] = src[F.lane]; dst[F.lane + 64] = src[F.lane + 64];
        if (F.lane == 0) { PERM[pos] = m; WPOS[2 * pos] = WTS[2 * m]; WPOS[2 * pos + 1] = WTS[2 * m + 1]; }
    }
    if (blk == 0) {
        int* TILES = (int*)(F.ws + WS_TILES);
        if (F.tid == 0) { TILES[0] = base[NCLS] >> 8; }
        if (F.tid < NCLS) { const int c = F.tid; for (int t = base[c] >> 8; t < (base[c + 1] >> 8); ++t) TILES[1 + t] = c; }
        for (int c = 0; c < NCLS; ++c) { const int lo = base[c] + tot[c], hi = base[c + 1]; for (int p = lo + F.tid; p < hi; p += NWAVES * 64) PERM[p] = -1; }
    }
}

struct SchedUp {
    int G, c; const int* TILES;
    __device__ __forceinline__ bool next(int i, pg8::Unit& u) const {
        const int nrt = TILES[0]; const int L = i * G + c; if (L >= nrt * 8) return false;
        int pm, pn; pg8::tile_of(L, nrt, 8, pm, pn);
        int ea, eb; cls_experts(TILES[1 + pm], ea, eb); const int e = (pn < 4) ? ea : eb;
        u.pm = pm; u.pn = pn; u.aux = 0; u.nt = 16; u.offA = (size_t)pm * 256 * 1024 * 2; u.offB = (size_t)(e * 1024 + 256 * (pn & 3)) * 1024 * 2; return true;
    }
};
struct EpiUp {
    static constexpr bool PERM = true;
    const float* WPOS; bf16* HID;
    __device__ __forceinline__ bool keep(const pg8::Unit&) const { return false; }
    __device__ __forceinline__ void operator()(pg8::Acc& acc, const pg8::Unit& u, int wr, int wc, int fr, int fq) const {
        const int row0 = u.pm * 256 + wr * 64 + fr, col0 = u.pn * 128 + wc * 32 + 8 * fq, half = u.pn >> 2;
#pragma unroll
        for (int ai = 0; ai < 2; ++ai)
#pragma unroll
            for (int m = 0; m < 4; ++m) { const int pos = row0 + ai * 128 + m * 16; const float w = WPOS[2 * pos + half];
                float h[8];
#pragma unroll
                for (int n = 0; n < 2; ++n)
#pragma unroll
                    for (int j = 0; j < 4; ++j) { const float gt = acc[ai][0][m][n][j], up = acc[ai][1][m][n][j]; h[4 * n + j] = w * gt * sigmoidf_(gt) * up; }
                u32x4 o; o.x = pg8::cvt_pk_bf16(h[0], h[1]); o.y = pg8::cvt_pk_bf16(h[2], h[3]); o.z = pg8::cvt_pk_bf16(h[4], h[5]); o.w = pg8::cvt_pk_bf16(h[6], h[7]);
                *(u32x4*)(HID + (size_t)pos * 1024 + col0) = o; }
    }
};
__device__ __forceinline__ void phase_up(Frame& F) {
    pg8::Gemm g{(const bf16*)(F.ws + WS_XS), (const bf16*)(F.ws + WS_WGU), 1024, 1024};
    EpiUp E{(const float*)(F.ws + WS_WPOS), (bf16*)(F.ws + WS_HID)};
    SchedUp S{F.G, (int)blockIdx.x, (const int*)(F.ws + WS_TILES)};
    run_gemm(F.lds, g, S, E);
}

struct SchedDown {
    int G, c; const int* TILES;
    __device__ __forceinline__ bool next(int i, pg8::Unit& u) const {
        const int nrt = TILES[0]; const int T = (i >> 1) * G + c; if (T >= nrt * 4) return false;
        int pm, pn; pg8::tile_of(T, nrt, 4, pm, pn); const int sub = i & 1;
        int ea, eb; cls_experts(TILES[1 + pm], ea, eb); const int e = sub ? eb : ea;
        u.pm = pm; u.pn = pn; u.aux = sub; u.nt = 8; u.offA = (size_t)pm * 256 * 1024 * 2 + (sub ? 512 * 2 : 0); u.offB = (size_t)(e * 1024 + pn * 256) * 512 * 2; return true;
    }
};
struct EpiDown {
    static constexpr bool PERM = false;
    const int* PERMT; float* X; bf16* X2B;
    __device__ __forceinline__ bool keep(const pg8::Unit& u) const { return u.aux == 0; }
    __device__ __forceinline__ void operator()(pg8::Acc& acc, const pg8::Unit& u, int wr, int wc, int fr, int fq) const {
        if (u.aux == 0) return;
        const int row0 = u.pm * 256 + wr * 64 + fr, col0 = u.pn * 256 + wc * 32 + 4 * fq;
#pragma unroll
        for (int ai = 0; ai < 2; ++ai)
#pragma unroll
            for (int m = 0; m < 4; ++m) { const int tok = PERMT[row0 + ai * 128 + m * 16]; if (tok < 0) continue; const size_t off = (size_t)tok * DM + col0;
#pragma unroll
                for (int bj = 0; bj < 2; ++bj)
#pragma unroll
                    for (int n = 0; n < 2; ++n) { const f32x4 o = *(const f32x4*)(X + off + bj * 128 + n * 16) + acc[ai][bj][m][n]; *(f32x4*)(X + off + bj * 128 + n * 16) = o;
                        u32x2 w; w.x = pg8::cvt_pk_bf16(o[0], o[1]); w.y = pg8::cvt_pk_bf16(o[2], o[3]); *(u32x2*)(X2B + off + bj * 128 + n * 16) = w; } }
    }
};
__device__ __forceinline__ void phase_down(Frame& F) {
    pg8::Gemm g{(const bf16*)(F.ws + WS_HID), (const bf16*)(F.ws + WS_WD), 1024, 512};
    EpiDown E{(const int*)(F.ws + WS_PERM), F.out, (bf16*)(F.ws + WS_X2B)};
    SchedDown S{F.G, (int)blockIdx.x, (const int*)(F.ws + WS_TILES)};
    run_gemm(F.lds, g, S, E);
}

struct EpiPle {
    static constexpr bool PERM = false;
    float* X; const bf16* PP;
    __device__ __forceinline__ bool keep(const pg8::Unit&) const { return false; }
    __device__ __forceinline__ void operator()(pg8::Acc& acc, const pg8::Unit& u, int wr, int wc, int fr, int fq) const {
        const int row0 = u.pm * 256 + wr * 64 + fr, col0 = u.pn * 256 + wc * 32 + 4 * fq;
#pragma unroll
        for (int ai = 0; ai < 2; ++ai)
#pragma unroll
            for (int m = 0; m < 4; ++m) { const size_t off = (size_t)(row0 + ai * 128 + m * 16) * DM + col0;
#pragma unroll
                for (int bj = 0; bj < 2; ++bj)
#pragma unroll
                    for (int n = 0; n < 2; ++n) { const size_t o2 = off + bj * 128 + n * 16; const f32x4 xv = *(const f32x4*)(X + o2); const u32x2 pp = *(const u32x2*)(PP + o2); const f32x4 a = acc[ai][bj][m][n];
                        f32x4 o; o[0] = xv[0] + sigmoidf_(a[0]) * bflo(pp.x); o[1] = xv[1] + sigmoidf_(a[1]) * bfhi(pp.x); o[2] = xv[2] + sigmoidf_(a[2]) * bflo(pp.y); o[3] = xv[3] + sigmoidf_(a[3]) * bfhi(pp.y);
                        *(f32x4*)(X + o2) = o; } }
    }
};
__device__ __forceinline__ void phase_ple(Frame& F) {
    pg8::Gemm g{(const bf16*)(F.ws + WS_X2B), (const bf16*)(F.ws + WS_WPG), 1024, 1024};
    EpiPle E{F.out, (const bf16*)(F.ws + WS_PP)};
    SchedPlain S{F.G, (int)blockIdx.x, 4, 16, 1024, 1024};
    run_gemm(F.lds, g, S, E);
}

__device__ __forceinline__ void phase_final(Frame& F) {
    const int gw = F.vcu * NWAVES + F.wave, NGW = F.G * NWAVES; const float* G = F.in[I_FING];
    for (int m = gw; m < M; m += NGW) {
        GAS f32x4* xr = (GAS f32x4*)(F.out + (size_t)m * DM) + F.lane;
        f32x4 v[4]; float s = 0.f;
#pragma unroll
        for (int j = 0; j < 4; ++j) { v[j] = xr[64 * j]; s += (v[j].x * v[j].x + v[j].y * v[j].y) + (v[j].z * v[j].z + v[j].w * v[j].w); }
        const float r = 1.0f / sqrtf(wave_sum(s) * (1.f / DM) + EPS);
#pragma unroll
        for (int j = 0; j < 4; ++j) { const f32x4 gg = *((const GAS f32x4*)G + F.lane + 64 * j); xr[64 * j] = v[j] * r * gg; }
    }
}

namespace att {
typedef float f32x16 __attribute__((ext_vector_type(16)));
typedef short s16x4 __attribute__((ext_vector_type(4)));
typedef short v4i16_t __attribute__((ext_vector_type(4)));
typedef LAS const unsigned char* lptr;
__device__ __forceinline__ int crow(int r, int hi) { return (r & 3) + 8 * (r >> 2) + 4 * hi; }
__device__ __forceinline__ s16x4 vtr(lptr p) { return __builtin_bit_cast(s16x4, __builtin_amdgcn_ds_read_tr16_b64_v4i16((LAS v4i16_t*)p)); }
__device__ __forceinline__ void dma16(const void* g, LAS unsigned char* l) { __builtin_amdgcn_global_load_lds((const unsigned*)g, (LAS unsigned*)l, 16, 0, 0); }
__device__ __forceinline__ float swap_other(float v) { float w = v; asm volatile("" : "+v"(w)); auto rr = __builtin_amdgcn_permlane32_swap(__builtin_bit_cast(unsigned, v), __builtin_bit_cast(unsigned, w), false, false);
    unsigned a = rr[0], b = rr[1]; asm volatile("" : "+v"(a), "+v"(b)); return (threadIdx.x & 32) ? __builtin_bit_cast(float, a) : __builtin_bit_cast(float, b); }
__device__ __forceinline__ float swap_add(float v) { return v + swap_other(v); }
__device__ __forceinline__ float swap_max(float v) { return fmaxf(v, swap_other(v)); }
#define ATT_PACK(P, B) ((u32x4){pg8::cvt_pk_bf16(P[B], P[B + 1]), pg8::cvt_pk_bf16(P[B + 2], P[B + 3]), pg8::cvt_pk_bf16(P[B + 4], P[B + 5]), pg8::cvt_pk_bf16(P[B + 6], P[B + 7])})
__device__ __forceinline__ void pv(f32x16 (&o)[2], lptr vimg, u32x4 pw0, u32x4 pw1, u32x4 pw2, u32x4 pw3) {
    const bf16x8 pa[4] = {__builtin_bit_cast(bf16x8, pw0), __builtin_bit_cast(bf16x8, pw1), __builtin_bit_cast(bf16x8, pw2), __builtin_bit_cast(bf16x8, pw3)};
#pragma unroll
    for (int d0 = 0; d0 < 2; ++d0)
#pragma unroll
        for (int ks = 0; ks < 4; ++ks) { const s16x4 lo = vtr(vimg + d0 * 4096 + ks * 1024), hh = vtr(vimg + d0 * 4096 + ks * 1024 + 512);
            const bf16x8 vb = (bf16x8){lo[0], lo[1], lo[2], lo[3], hh[0], hh[1], hh[2], hh[3]};
            o[d0] = __builtin_amdgcn_mfma_f32_32x32x16_bf16(pa[ks], vb, o[d0], 0, 0, 0); }
}

__device__ __forceinline__ void attn_unit(Frame& F, int b, int h, int qb) {
    const int lane = F.lane, r32 = lane & 31, hi = lane >> 5, wid = F.wave;
    const bf16* Q = (const bf16*)(F.ws + WS_Q); const bf16* K = (const bf16*)(F.ws + WS_K); const bf16* V = (const bf16*)(F.ws + WS_V);
#ifdef DBG_ATT
    bf16* O = (bf16*)(F.ws + WS_WCAT2); constexpr int OP = 512;
#else
    bf16* O = (bf16*)(F.ws + WS_ACAT); constexpr int OP = 1536;
#endif
    const size_t rowbase = (size_t)b * SEQ; const int q0 = qb * 256;
    const bf16* Kh = K + rowbase * AW + h * 64; const bf16* Vh = V + rowbase * AW + h * 64;
    LAS unsigned char* lds = F.lds;
    LAS float* wsf = (LAS float*)(lds + 32768 + wid * 256);
    const bf16* ksrc = Kh + (size_t)lane * AW + wid * 8;
    const bf16* vsrc = Vh + (size_t)(16 * (wid & 3) + (lane >> 2)) * AW + (wid >> 2) * 32 + (lane & 3) * 8;
#define ATT_DMA(t, s) do { dma16(ksrc + (size_t)(t) * 64 * AW, lds + (s) * 8192 + wid * 1024); dma16(vsrc + (size_t)(t) * 64 * AW, lds + 16384 + (s) * 8192 + wid * 1024); } while (0)
    ATT_DMA(0, 0);
    const bf16* Qw = Q + (rowbase + q0 + wid * 32 + r32) * AW + h * 64;
    bf16x8 qr[4];
#pragma unroll
    for (int d0 = 0; d0 < 4; ++d0) qr[d0] = *(const bf16x8*)(Qw + d0 * 16 + hi * 8);
    unsigned sel = 0;
    if (qb <= 3) sel = (1u << qb) - 1u;
    else {
        const float* KM = (const float*)(F.ws + WS_KMEAN) + (size_t)((b * AH + h) * NBLK) * 64;
        float g[8];
#pragma unroll
        for (int kb = 0; kb < 8; ++kb) { float a = -INFINITY;
            if (kb < qb) { a = 0.f;
#pragma unroll
                for (int d0 = 0; d0 < 4; ++d0) { const f32x4 k0 = *(const f32x4*)(KM + kb * 64 + d0 * 16 + hi * 8), k1 = *(const f32x4*)(KM + kb * 64 + d0 * 16 + hi * 8 + 4);
                    const u32x4 qq = __builtin_bit_cast(u32x4, qr[d0]);
                    a += bflo(qq.x) * k0.x + bfhi(qq.x) * k0.y + bflo(qq.y) * k0.z + bfhi(qq.y) * k0.w + bflo(qq.z) * k1.x + bfhi(qq.z) * k1.y + bflo(qq.w) * k1.z + bfhi(qq.w) * k1.w; }
                a = swap_add(a); }
            g[kb] = a; }
#pragma unroll
        for (int r = 0; r < 3; ++r) { int best = -1; float bv = -INFINITY;
#pragma unroll
            for (int kb = 0; kb < 8; ++kb) if (kb < qb && !((sel >> kb) & 1u) && g[kb] > bv) { bv = g[kb]; best = kb; }
            if (best >= 0) sel |= 1u << best; }
    }
    const float sl2 = exp2f(-(float)(h + 1)) * LOG2E;
    float m_run = -1e30f, l_run = 0.f; f32x16 o[2]; o[0] = f32x16{}; o[1] = f32x16{};
    const int NT = 4 * (qb + 1), qloc = wid * 32 + r32;
    const lptr vp0 = (lptr)lds + 16384 + ((lane >> 4) & 1) * 32 + (lane & 3) * 8 + (4 * hi + ((lane & 15) >> 2)) * 64;
    const lptr kp0 = (lptr)lds + hi * 1024 + r32 * 16;
    __syncthreads();
    for (int t = 0; t < NT; ++t) {
        const int s = t & 1;
        if (t + 1 < NT) ATT_DMA(t + 1, s ^ 1);
        const int kb = t >> 2, jb = t & 3; const bool own = (kb == qb);
        if (!(own && (64 * jb > wid * 32 + 31))) {
            f32x16 p0 = f32x16{}, p1 = f32x16{};
#pragma unroll
            for (int d0 = 0; d0 < 4; ++d0) { const bf16x8 b0 = *(const LAS bf16x8*)(kp0 + s * 8192 + d0 * 2048), b1 = *(const LAS bf16x8*)(kp0 + s * 8192 + d0 * 2048 + 512);
                p0 = __builtin_amdgcn_mfma_f32_32x32x16_bf16(b0, qr[d0], p0, 0, 0, 0); p1 = __builtin_amdgcn_mfma_f32_32x32x16_bf16(b1, qr[d0], p1, 0, 0, 0); }
            const bool lane_on = own || ((sel >> kb) & 1u);
            float base = sl2 * (float)(64 * t + 4 * hi - (q0 + 255));
            base = lane_on ? base : -INFINITY;
#pragma unroll
            for (int r = 0; r < 16; ++r) { const float c = (float)((r & 3) + 8 * (r >> 2)); p0[r] += base + sl2 * c; p1[r] += base + sl2 * (c + 32.f); }
            if (own && (64 * jb + 63 > wid * 32)) {
#pragma unroll
                for (int r = 0; r < 16; ++r) { const int kv = 64 * jb + crow(r, hi); if (kv > qloc) p0[r] = -INFINITY; if (kv + 32 > qloc) p1[r] = -INFINITY; } }
            float rm = fmaxf(p0[0], p1[0]);
#pragma unroll
            for (int r = 1; r < 16; ++r) rm = fmaxf(rm, fmaxf(p0[r], p1[r]));
            rm = swap_max(rm);
            const float mn = fmaxf(m_run, rm), f = exp2f(m_run - mn);
            m_run = mn; l_run *= f;
            if (hi == 0) wsf[r32] = f;
            asm volatile("" ::: "memory");
#pragma unroll
            for (int r = 0; r < 16; ++r) { const float fr = wsf[crow(r, hi)]; o[0][r] *= fr; o[1][r] *= fr; }
            float sacc = 0.f;
#pragma unroll
            for (int r = 0; r < 16; ++r) { p0[r] = exp2f(p0[r] - mn); p1[r] = exp2f(p1[r] - mn); sacc += p0[r] + p1[r]; }
            l_run += sacc;
            pv(o, vp0 + s * 8192, ATT_PACK(p0, 0), ATT_PACK(p0, 8), ATT_PACK(p1, 0), ATT_PACK(p1, 8));
        }
        __syncthreads();
    }
#undef ATT_DMA
    l_run = swap_add(l_run);
    if (hi == 0) wsf[32 + r32] = l_run;
    asm volatile("" ::: "memory");
    LAS bf16* stg = (LAS bf16*)(lds + 34816 + wid * 4096);
#pragma unroll
    for (int r = 0; r < 16; ++r) { const int orow = crow(r, hi); const float rl = 1.0f / wsf[32 + orow];
        stg[orow * 64 + r32] = (bf16)f2bf(o[0][r] * rl); stg[orow * 64 + 32 + r32] = (bf16)f2bf(o[1][r] * rl); }
    asm volatile("s_waitcnt lgkmcnt(0)" ::: "memory");
    bf16* Ow = O + (rowbase + q0 + wid * 32) * OP + h * 64;
#pragma unroll
    for (int i = 0; i < 4; ++i) { const int row = i * 8 + (lane >> 3), ch = lane & 7; const u32x4 v = *(const LAS u32x4*)(stg + row * 64 + ch * 8); *(u32x4*)(Ow + (size_t)row * OP + ch * 8) = v; }
    __syncthreads();
}

__device__ __forceinline__ void ssd_state_unit(Frame& F, int b, int j, int nh) {
    const int lane = F.lane, r32 = lane & 31, hi = lane >> 5, wid = F.wave, tid = F.tid, g = j >> 3;
    const bf16* XA = (const bf16*)(F.ws + WS_XBCACT); const float* DT = (const float*)(F.ws + WS_DT); const float* CS = (const float*)(F.ws + WS_CS); bf16* ST = (bf16*)(F.ws + WS_STATES);
    LAS unsigned char* lds = F.lds; LAS float* scl = (LAS float*)(lds + 65536);
    const int pb = (wid >> 1) & 1, nbl = wid & 1;
    const int vpoff = ((lane >> 4) & 1) * 32 + (lane & 3) * 8 + (4 * hi + ((lane & 15) >> 2)) * 64;
    f32x16 hst = f32x16{};
    for (int c = 0; c < NCH; ++c) {
        const size_t rowc = (size_t)b * SEQ + c * 256;
        const float cs_end = CS[(rowc + 255) * 16 + j];
        if (tid < 256) scl[tid] = DT[(rowc + tid) * 16 + j] * __expf(cs_end - CS[(rowc + tid) * 16 + j]);
#pragma unroll
        for (int tt = 0; tt < 4; ++tt)
            dma16(XA + (rowc + 64 * tt + 16 * (wid & 3) + (lane >> 2)) * CONVD + 1024 + g * 128 + nh * 64 + (wid >> 2) * 32 + (lane & 3) * 8, lds + 32768 + tt * 8192 + wid * 1024);
        __syncthreads();
        { const int l = tid >> 1, dh = tid & 1; const float sc = scl[l];
            const u32x4* src = (const u32x4*)(XA + (rowc + l) * CONVD + j * 64 + dh * 32);
            LAS unsigned char* dst = lds + (l >> 6) * 8192 + dh * 4096 + ((l & 63) >> 4) * 1024 + (l & 15) * 64;
#pragma unroll
            for (int pc = 0; pc < 4; ++pc) { u32x4 w = src[pc];
                w.x = pk2(bflo(w.x) * sc, bfhi(w.x) * sc); w.y = pk2(bflo(w.y) * sc, bfhi(w.y) * sc); w.z = pk2(bflo(w.z) * sc, bfhi(w.z) * sc); w.w = pk2(bflo(w.w) * sc, bfhi(w.w) * sc);
                *(LAS u32x4*)(dst + pc * 16) = w; } }
        __syncthreads();
        if (wid < 4) {
            bf16* stp = ST + ((size_t)(((b * NCH + c) * SH + j) * 64 + 32 * pb)) * 128 + nh * 64 + 32 * nbl + r32;
#pragma unroll
            for (int r = 0; r < 16; ++r) stp[(size_t)crow(r, hi) * 128] = (bf16)f2bf(hst[r]);
            f32x16 acc = f32x16{};
#pragma unroll
            for (int tt = 0; tt < 4; ++tt)
#pragma unroll
                for (int ks = 0; ks < 4; ++ks) {
                    const lptr xa = (lptr)lds + tt * 8192 + pb * 4096 + ks * 1024 + vpoff, ba = (lptr)lds + 32768 + tt * 8192 + nbl * 4096 + ks * 1024 + vpoff;
                    const s16x4 alo = vtr(xa), ahi = vtr(xa + 512), blo = vtr(ba), bhi_ = vtr(ba + 512);
                    const bf16x8 av = (bf16x8){alo[0], alo[1], alo[2], alo[3], ahi[0], ahi[1], ahi[2], ahi[3]}, bv = (bf16x8){blo[0], blo[1], blo[2], blo[3], bhi_[0], bhi_[1], bhi_[2], bhi_[3]};
                    acc = __builtin_amdgcn_mfma_f32_32x32x16_bf16(av, bv, acc, 0, 0, 0); }
            const float dec = __expf(cs_end);
#pragma unroll
            for (int r = 0; r < 16; ++r) hst[r] = hst[r] * dec + acc[r];
        }
        __syncthreads();
    }
}

__device__ __forceinline__ void ssd_y_unit(Frame& F, int b, int c, int j) {
    const int lane = F.lane, r32 = lane & 31, hi = lane >> 5, wid = F.wave, tid = F.tid, g = j >> 3;
    const bf16* XA = (const bf16*)(F.ws + WS_XBCACT); const float* DT = (const float*)(F.ws + WS_DT); const float* CS = (const float*)(F.ws + WS_CS); const bf16* ST = (const bf16*)(F.ws + WS_STATES);
    const bf16* Z = (const bf16*)(F.ws + WS_Z); bf16* O = (bf16*)(F.ws + WS_ACAT); float* SUMSQ = (float*)(F.ws + WS_SUMSQ);
    LAS unsigned char* lds = F.lds; LAS float* csl = (LAS float*)(lds + 98304); LAS float* dtt = (LAS float*)(lds + 99328);
    const size_t rowc = (size_t)b * SEQ + c * 256;
#pragma unroll
    for (int tt = 0; tt < 4; ++tt) {
        dma16(XA + (rowc + 64 * tt + lane) * CONVD + 1024 + g * 128 + wid * 8, lds + tt * 16384 + wid * 1024);
        dma16(XA + (rowc + 64 * tt + lane) * CONVD + 1024 + g * 128 + (wid + 8) * 8, lds + tt * 16384 + (wid + 8) * 1024);
        dma16(XA + (rowc + 64 * tt + 16 * (wid & 3) + (lane >> 2)) * CONVD + j * 64 + (wid >> 2) * 32 + (lane & 3) * 8, lds + 65536 + tt * 8192 + wid * 1024);
    }
    if (tid < 256) { csl[tid] = CS[(rowc + tid) * 16 + j] * LOG2E; dtt[tid] = DT[(rowc + tid) * 16 + j]; }
    bf16x8 qr[8];
    const bf16* Cw = XA + (rowc + wid * 32 + r32) * CONVD + 1280 + g * 128 + hi * 8;
#pragma unroll
    for (int d0 = 0; d0 < 8; ++d0) qr[d0] = *(const bf16x8*)(Cw + d0 * 16);
    f32x16 o[2]; o[0] = f32x16{}; o[1] = f32x16{};
    const bf16* Hs = ST + ((size_t)(((b * NCH + c) * SH + j) * 64 + r32)) * 128 + hi * 8;
#pragma unroll
    for (int ks = 0; ks < 8; ++ks) { const bf16x8 h0 = *(const bf16x8*)(Hs + ks * 16), h1 = *(const bf16x8*)(Hs + 32 * 128 + ks * 16);
        o[0] = __builtin_amdgcn_mfma_f32_32x32x16_bf16(qr[ks], h0, o[0], 0, 0, 0); o[1] = __builtin_amdgcn_mfma_f32_32x32x16_bf16(qr[ks], h1, o[1], 0, 0, 0); }
    __syncthreads();
#pragma unroll
    for (int r = 0; r < 16; ++r) { const float e = exp2f(csl[wid * 32 + crow(r, hi)]); o[0][r] *= e; o[1][r] *= e; }
    const float cq = csl[wid * 32 + r32]; const int lq = wid * 32 + r32;
    const lptr vp0 = (lptr)lds + 65536 + ((lane >> 4) & 1) * 32 + (lane & 3) * 8 + (4 * hi + ((lane & 15) >> 2)) * 64;
    const lptr kp0 = (lptr)lds + hi * 1024 + r32 * 16;
    const int tq = wid >> 1;
    for (int t = 0; t <= tq; ++t) {
        f32x16 p0 = f32x16{}, p1 = f32x16{};
#pragma unroll
        for (int d0 = 0; d0 < 8; ++d0) { const bf16x8 b0 = *(const LAS bf16x8*)(kp0 + t * 16384 + d0 * 2048), b1 = *(const LAS bf16x8*)(kp0 + t * 16384 + d0 * 2048 + 512);
            p0 = __builtin_amdgcn_mfma_f32_32x32x16_bf16(b0, qr[d0], p0, 0, 0, 0); p1 = __builtin_amdgcn_mfma_f32_32x32x16_bf16(b1, qr[d0], p1, 0, 0, 0); }
#pragma unroll
        for (int r = 0; r < 16; ++r) { const int s0 = 64 * t + crow(r, hi), s1 = s0 + 32;
            const float e0 = exp2f(cq - csl[s0]) * dtt[s0], e1 = exp2f(cq - csl[s1]) * dtt[s1];
            p0[r] = (s0 <= lq) ? p0[r] * e0 : 0.f; p1[r] = (s1 <= lq) ? p1[r] * e1 : 0.f; }
        pv(o, vp0 + t * 8192, ATT_PACK(p0, 0), ATT_PACK(p0, 8), ATT_PACK(p1, 0), ATT_PACK(p1, 8));
    }
    __syncthreads();
    LAS float* stg = (LAS float*)(lds + wid * 8192);
#pragma unroll
    for (int r = 0; r < 16; ++r) { const int orow = crow(r, hi); stg[orow * 64 + r32] = o[0][r]; stg[orow * 64 + 32 + r32] = o[1][r]; }
    asm volatile("s_waitcnt lgkmcnt(0)" ::: "memory");
    const float dsk = F.in[I_DSKIP][j];
#pragma unroll
    for (int i = 0; i < 4; ++i) { const int row = i * 8 + (lane >> 3), ch = lane & 7; const size_t m = rowc + wid * 32 + row;
        const f32x4 y0 = *(const LAS f32x4*)(stg + row * 64 + ch * 8), y1 = *(const LAS f32x4*)(stg + row * 64 + ch * 8 + 4);
        const u32x4 xv = *(const u32x4*)(XA + m * CONVD + j * 64 + ch * 8), zv = *(const u32x4*)(Z + m * DM + j * 64 + ch * 8);
        const float y[8] = {y0.x, y0.y, y0.z, y0.w, y1.x, y1.y, y1.z, y1.w};
        const float x[8] = {bflo(xv.x), bfhi(xv.x), bflo(xv.y), bfhi(xv.y), bflo(xv.z), bfhi(xv.z), bflo(xv.w), bfhi(xv.w)};
        const float z[8] = {bflo(zv.x), bfhi(zv.x), bflo(zv.y), bfhi(zv.y), bflo(zv.z), bfhi(zv.z), bflo(zv.w), bfhi(zv.w)};
        float u[8]; float ss = 0.f;
#pragma unroll
        for (int e = 0; e < 8; ++e) { u[e] = (y[e] + dsk * x[e]) * z[e] * sigmoidf_(z[e]); ss += u[e] * u[e]; }
        ss += __shfl_xor(ss, 1); ss += __shfl_xor(ss, 2); ss += __shfl_xor(ss, 4);
        if (ch == 0) SUMSQ[m * 16 + j] = ss;
        u32x4 w; w.x = pk2(u[0], u[1]); w.y = pk2(u[2], u[3]); w.z = pk2(u[4], u[5]); w.w = pk2(u[6], u[7]);
        *(u32x4*)(O + m * 1536 + 512 + j * 64 + ch * 8) = w; }
    __syncthreads();
}
}

#ifndef FAST_ATTN
#define FAST_ATTN 1
#endif
#ifndef FAST_SSD
#define FAST_SSD 1
#endif
__device__ __forceinline__ void phase_attn(Frame& F) {
    const int v = F.vcu;
#if FAST_SSD
    att::ssd_state_unit(F, v >> 5, (v >> 1) & 15, v & 1);
#endif
#if FAST_ATTN
    { const int bh = v >> 2, s = v & 3; att::attn_unit(F, bh >> 3, bh & 7, s); att::attn_unit(F, bh >> 3, bh & 7, 7 - s); }
#endif
}
__device__ __forceinline__ void phase_ssdy(Frame& F) {
#if FAST_SSD
    for (int i = 0; i < 4; ++i) { const int u = F.vcu * 4 + i; att::ssd_y_unit(F, u >> 7, (u >> 4) & 7, u & 15); }
#endif
}

__global__ void __launch_bounds__(256) attn_naive(const bf16* __restrict__ Q, const bf16* __restrict__ K, const bf16* __restrict__ V, const float* __restrict__ KM, bf16* __restrict__ ACAT) {
    const int blk = blockIdx.x, qb = blk % NBLK, h = (blk / NBLK) % AH, b = blk / (NBLK * AH);
    const int t = qb * 256 + threadIdx.x; const size_t row = (size_t)b * SEQ + t;
    float q[64];
#pragma unroll
    for (int d = 0; d < 64; d += 2) { const unsigned w = *(const unsigned*)(Q + row * AW + h * 64 + d); q[d] = bflo(w); q[d + 1] = bfhi(w); }
    unsigned sel = 0;
    if (qb <= 3) sel = (1u << qb) - 1u;
    else {
        float g[8];
#pragma unroll
        for (int kb = 0; kb < 8; ++kb) { float a = 0.f; if (kb < qb) {
#pragma unroll
                for (int d = 0; d < 64; ++d) a += q[d] * KM[(size_t)((b * AH + h) * NBLK + kb) * 64 + d]; } else a = -INFINITY; g[kb] = a; }
#pragma unroll
        for (int r = 0; r < 3; ++r) { int best = -1; float bv = -INFINITY;
#pragma unroll
            for (int kb = 0; kb < 8; ++kb) if (kb < qb && !((sel >> kb) & 1u) && g[kb] > bv) { bv = g[kb]; best = kb; }
            if (best >= 0) sel |= 1u << best; }
    }
    const float sl2 = exp2f(-(float)(h + 1)) * LOG2E;
    float mx = -1e30f, l = 0.f; float o[64];
#pragma unroll
    for (int d = 0; d < 64; ++d) o[d] = 0.f;
    for (int kb = 0; kb <= qb; ++kb) {
        const bool act = (kb == qb) || ((sel >> kb) & 1u);
        for (int j = 0; j < 256; ++j) {
            const int tk = kb * 256 + j; const size_t krow = (size_t)b * SEQ + tk;
            float s = 0.f;
#pragma unroll
            for (int d = 0; d < 64; d += 2) { const unsigned w = *(const unsigned*)(K + krow * AW + h * 64 + d); s += q[d] * bflo(w) + q[d + 1] * bfhi(w); }
            s -= sl2 * (float)(t - tk);
            const bool ok = act && (tk <= t);
            if (ok) {
                const float mn = fmaxf(mx, s), f = exp2f(mx - mn), p = exp2f(s - mn);
                l = l * f + p;
#pragma unroll
                for (int d = 0; d < 64; d += 2) { const unsigned w = *(const unsigned*)(V + krow * AW + h * 64 + d); o[d] = o[d] * f + p * bflo(w); o[d + 1] = o[d + 1] * f + p * bfhi(w); }
                mx = mn;
            }
        }
    }
    const float rl = 1.f / l;
#pragma unroll
    for (int d = 0; d < 64; d += 2) *(unsigned*)(ACAT + row * 1536 + h * 64 + d) = pk2(o[d] * rl, o[d + 1] * rl);
}

__global__ void __launch_bounds__(64) ssd_naive(const bf16* __restrict__ XA, const float* __restrict__ DT, const bf16* __restrict__ Z, const float* __restrict__ ALOG, const float* __restrict__ DSKIP,
                                                bf16* __restrict__ ACAT, float* __restrict__ SUMSQ) {
    const int b = blockIdx.x / SH, j = blockIdx.x % SH, p = threadIdx.x, g = j / 8;
    const float a = -__expf(ALOG[j]), dsk = DSKIP[j];
    float hst[128];
#pragma unroll
    for (int n = 0; n < 128; ++n) hst[n] = 0.f;
    for (int t = 0; t < SEQ; ++t) {
        const size_t row = (size_t)b * SEQ + t;
        const float dt = DT[row * 16 + j], dA = __expf(dt * a);
        const float x = bf2f(XA[row * CONVD + j * 64 + p]), dtx = dt * x;
        const bf16* Bp = XA + row * CONVD + 1024 + g * 128; const bf16* Cp = XA + row * CONVD + 1280 + g * 128;
        float y = 0.f;
#pragma unroll
        for (int n = 0; n < 128; n += 2) { const unsigned bw = *(const unsigned*)(Bp + n), cw = *(const unsigned*)(Cp + n);
            hst[n] = hst[n] * dA + dtx * bflo(bw); y += bflo(cw) * hst[n];
            hst[n + 1] = hst[n + 1] * dA + dtx * bfhi(bw); y += bfhi(cw) * hst[n + 1]; }
        y += dsk * x;
        const float zz = bf2f(Z[row * DM + j * 64 + p]);
        const float u = y * zz * sigmoidf_(zz);
        ACAT[row * 1536 + 512 + j * 64 + p] = (bf16)f2bf(u);
        const float ss = wave_sum(u * u);
        if (p == 0) SUMSQ[row * 16 + j] = ss;
    }
}


#ifdef DBG_ATT
__global__ void dbg_cmp(const bf16* __restrict__ A, const bf16* __restrict__ Bf, float* acc) {
    float d2 = 0.f, n2 = 0.f;
    for (size_t i = (size_t)blockIdx.x * blockDim.x + threadIdx.x; i < (size_t)M * 512; i += (size_t)gridDim.x * blockDim.x) {
        const size_t row = i / 512; const int col = (int)(i % 512), h = col / 64, qb = (int)((row % SEQ) / 256);
        bool on = true;
        if (DBG_ATT == 1) on = qb == 0; else if (DBG_ATT == 2) on = qb >= 1 && qb <= 3; else if (DBG_ATT == 3) on = qb >= 4; else if (DBG_ATT >= 10) on = (h == DBG_ATT - 10);
        if (!on) continue;
        const float a = bf2f(A[row * 1536 + col]), b = bf2f(Bf[row * 512 + col]);
        d2 += (a - b) * (a - b); n2 += a * a;
    }
    d2 = wave_sum(d2); n2 = wave_sum(n2);
    if ((threadIdx.x & 63) == 0) { atomicAdd(acc, d2); atomicAdd(acc + 1, n2); }
}
__global__ void dbg_apply(float* out, const float* acc) {
    const float m = sqrtf(acc[0] / fmaxf(acc[1], 1e-30f));
    for (size_t i = (size_t)blockIdx.x * blockDim.x + threadIdx.x; i < (size_t)M * DM; i += (size_t)gridDim.x * blockDim.x) out[i] *= (1.f + m);
}
#endif
enum { PH_PROLOGUE = 0, PH_PROJ, PH_CONV, PH_ATTN, PH_SSDY, PH_NORM, PH_MERGE, PH_X1, PH_ROUTE1, PH_ROUTE2, PH_UP, PH_DOWN, PH_PLE, PH_FINAL, PH_COUNT };

__global__ void __launch_bounds__(NWAVES * 64, 2) mk_fwd(Args args) {
    extern __shared__ __attribute__((aligned(16))) unsigned char lds[];
    Frame F;
    F.lds = (LAS unsigned char*)lds;
    F.tid = threadIdx.x; F.lane = F.tid & 63; F.wave = __builtin_amdgcn_readfirstlane(F.tid >> 6);
    F.G = gridDim.x; { const int bx = blockIdx.x; F.vcu = (F.G % 8 == 0) ? (bx % 8) * (F.G / 8) + bx / 8 : bx; }
    F.in = args.in; F.out = args.out; F.ws = args.ws;
    volatile LAS unsigned* MISC = (volatile LAS unsigned*)(F.lds + MISC_OFF);
    if (F.tid < 32) MISC[F.tid] = 0u;
    __syncthreads();
    XcdBarrier bar = xcd_barrier_post((unsigned*)(args.ws + WS_CTL) + CW_BAR + args.li * XCD_BAR_WORDS, MISC + 8);
    const int lo = args.ph_lo, hi = args.ph_hi;
#define IN(k) (lo <= (k) && (k) < hi)
#define SEAM(k) do { if (IN(k) && IN((k) + 1)) xcd_barrier(bar); } while (0)
    if (IN(PH_PROLOGUE)) { phase_prologue(F); } SEAM(PH_PROLOGUE);
    if (IN(PH_PROJ)) { phase_proj(F); } SEAM(PH_PROJ);
    if (IN(PH_CONV)) { phase_conv(F); } SEAM(PH_CONV);
    if (IN(PH_ATTN)) { phase_attn(F); } SEAM(PH_ATTN);
    if (IN(PH_SSDY)) { phase_ssdy(F); } SEAM(PH_SSDY);
    if (IN(PH_NORM)) { phase_norm(F); } SEAM(PH_NORM);
    if (IN(PH_MERGE)) { phase_merge(F); } SEAM(PH_MERGE);
    if (IN(PH_X1)) { phase_x1(F); } SEAM(PH_X1);
    if (IN(PH_ROUTE1)) { phase_route1(F); } SEAM(PH_ROUTE1);
    if (IN(PH_ROUTE2)) { phase_route2(F); } SEAM(PH_ROUTE2);
    if (IN(PH_UP)) { phase_up(F); } SEAM(PH_UP);
    if (IN(PH_DOWN)) { phase_down(F); } SEAM(PH_DOWN);
    if (IN(PH_PLE)) { phase_ple(F); } SEAM(PH_PLE);
    if (IN(PH_FINAL)) { phase_final(F); }
#undef IN
#undef SEAM
}

extern "C" void kernel_launch(void* const* d_in, const int* in_sizes, int n_in, void* d_out, int out_size, void* d_ws, size_t ws_size, hipStream_t stream) {
    static int grid = 0;
    if (grid == 0) {
        if (n_in != 24 || out_size != M * DM || ws_size < WS_END) { fprintf(stderr, "kernel_launch: unexpected shapes n_in %d out %d ws %zu\n", n_in, out_size, ws_size); grid = -1; return; }
        int dev = 0, cus = 0, per_cu = 0;
        if (hipGetDevice(&dev) != hipSuccess || hipDeviceGetAttribute(&cus, hipDeviceAttributeMultiprocessorCount, dev) != hipSuccess) { grid = -1; return; }
        if (hipFuncSetAttribute((const void*)mk_fwd, hipFuncAttributeMaxDynamicSharedMemorySize, LDS_BYTES) != hipSuccess) { fprintf(stderr, "kernel_launch: hipFuncSetAttribute failed\n"); grid = -1; return; }
        if (hipOccupancyMaxActiveBlocksPerMultiprocessor(&per_cu, (const void*)mk_fwd, NWAVES * 64, LDS_BYTES) != hipSuccess || per_cu < 1) { fprintf(stderr, "kernel_launch: occupancy query says %d\n", per_cu); grid = -1; return; }
        (void)hipGetLastError();
        grid = cus;
        if (grid != 256) { fprintf(stderr, "kernel_launch: built for 256 CUs, device has %d\n", cus); grid = -1; return; }
    }
    if (grid < 0) return;
    hipMemsetAsync((char*)d_ws + WS_CTL, 0, CTL_ZERO_BYTES, stream);
    Args a{};
    for (int i = 0; i < 24; ++i) a.in[i] = (const float*)d_in[i];
    a.out = (float*)d_out; a.ws = (unsigned char*)d_ws;
    unsigned char* ws = (unsigned char*)d_ws;
    int li = 0;
    auto frame = [&](int lo, int hi) { a.ph_lo = lo; a.ph_hi = hi; a.li = li++; hipLaunchKernelGGL(mk_fwd, dim3(grid), dim3(NWAVES * 64), LDS_BYTES, stream, a); };
#ifdef DBG_ATT
    frame(PH_PROLOGUE, PH_SSDY);
    hipLaunchKernelGGL(attn_naive, dim3(NBATCH * AH * NBLK), dim3(256), 0, stream, (const bf16*)(ws + WS_Q), (const bf16*)(ws + WS_K), (const bf16*)(ws + WS_V), (const float*)(ws + WS_KMEAN), (bf16*)(ws + WS_ACAT));
    hipLaunchKernelGGL(ssd_naive, dim3(NBATCH * SH), dim3(64), 0, stream, (const bf16*)(ws + WS_XBCACT), (const float*)(ws + WS_DT), (const bf16*)(ws + WS_Z), (const float*)d_in[I_ALOG], (const float*)d_in[I_DSKIP],
                       (bf16*)(ws + WS_ACAT), (float*)(ws + WS_SUMSQ));
    hipLaunchKernelGGL(dbg_cmp, dim3(1024), dim3(256), 0, stream, (const bf16*)(ws + WS_ACAT), (const bf16*)(ws + WS_WCAT2), (float*)(ws + WS_CTL) + 64);
    frame(PH_SSDY, PH_COUNT);
    hipLaunchKernelGGL(dbg_apply, dim3(1024), dim3(256), 0, stream, (float*)d_out, (const float*)(ws + WS_CTL) + 64);
#elif FAST_ATTN && FAST_SSD
    frame(PH_PROLOGUE, PH_COUNT);
#else
    frame(PH_PROLOGUE, PH_SSDY);
#if !FAST_ATTN
    hipLaunchKernelGGL(attn_naive, dim3(NBATCH * AH * NBLK), dim3(256), 0, stream, (const bf16*)(ws + WS_Q), (const bf16*)(ws + WS_K), (const bf16*)(ws + WS_V), (const float*)(ws + WS_KMEAN), (bf16*)(ws + WS_ACAT));
#endif
#if !FAST_SSD
    hipLaunchKernelGGL(ssd_naive, dim3(NBATCH * SH), dim3(64), 0, stream, (const bf16*)(ws + WS_XBCACT), (const float*)(ws + WS_DT), (const bf16*)(ws + WS_Z), (const float*)d_in[I_ALOG], (const float*)d_in[I_DSKIP],
                       (bf16*)(ws + WS_ACAT), (float*)(ws + WS_SUMSQ));
#endif
    frame(PH_SSDY, PH_COUNT);
#endif
}
```

```cpp
#include <hip/hip_runtime.h>
#include <cstdio>
#include <cstdint>

#define LAS __attribute__((address_space(3)))
#define GAS __attribute__((address_space(1)))
typedef unsigned short bf16;
typedef short bf16x8 __attribute__((ext_vector_type(8)));
typedef float f32x4 __attribute__((ext_vector_type(4)));
typedef float f32x2 __attribute__((ext_vector_type(2)));
typedef unsigned u32x4 __attribute__((ext_vector_type(4)));
typedef unsigned u32x2 __attribute__((ext_vector_type(2)));

constexpr int M = 16384, DM = 1024, SEQ = 2048, NBATCH = 8;
constexpr int AH = 8, AD = 64, AW = 512, MBLK = 256, NBLK = 8;
constexpr int SH = 16, SPD = 64, SN = 128, CONVD = 1536, NCH = 8;
constexpr int NE = 16, FF = 512, NCLS = 24;
constexpr int PLE = 256;
constexpr int IN_DIM = 6160, OFF_DT = 4096, OFF_GA = 4112;
constexpr float EPS = 1e-6f;
constexpr float LOG2E = 1.4426950408889634f;
constexpr float C2 = 0.125f * LOG2E;
constexpr int MAXRT = 88;

constexpr size_t MiB = 1u << 20;
constexpr size_t WS_CTL = 0, CTL_ZERO_BYTES = 128 * 1024;
constexpr size_t WS_BCAT = 1 * MiB;
constexpr size_t WS_WOUT = 4 * MiB;
constexpr size_t WS_WPG = 6 * MiB;
constexpr size_t WS_DTRAW = 8 * MiB;
constexpr size_t WS_SSQP = 8 * MiB;
constexpr size_t WS_DT = 9 * MiB;
constexpr size_t WS_CS = 10 * MiB;
constexpr size_t WS_SUMSQ = 11 * MiB;
constexpr size_t WS_KMEAN = 12 * MiB;
constexpr size_t WS_CLS = 12 * MiB + 512 * 1024;
constexpr size_t WS_WTS = 12 * MiB + 768 * 1024;
constexpr size_t WS_HIST = 13 * MiB;
constexpr size_t WS_TILES = 13 * MiB + 256 * 1024;
constexpr size_t WS_PERM = 13 * MiB + 512 * 1024;
constexpr size_t WS_WRT = 13 * MiB + 768 * 1024;
constexpr size_t WS_WPOS = 14 * MiB;
constexpr size_t WS_XB = 15 * MiB;
constexpr size_t WS_RNORM = 15 * MiB + 512 * 1024;
constexpr size_t WS_Q = 16 * MiB, WS_K = 32 * MiB, WS_V = 48 * MiB;
constexpr size_t WS_X1B = 144 * MiB;
constexpr size_t WS_Z = 64 * MiB;
constexpr size_t WS_MERGED = 64 * MiB;
constexpr size_t WS_X2B = 64 * MiB;
constexpr size_t WS_XBC = 96 * MiB;
constexpr size_t WS_ACAT = 96 * MiB;
constexpr size_t WS_XS = 96 * MiB;
constexpr size_t WS_ACAT2 = 144 * MiB;
constexpr size_t WS_XBCACT = 144 * MiB;
constexpr size_t WS_WGU = 16 * MiB;
constexpr size_t WS_WD = 48 * MiB;
constexpr size_t WS_PP = 192 * MiB;
constexpr size_t WS_WCAT2 = 224 * MiB;
constexpr size_t WS_STATES = 224 * MiB;
constexpr size_t WS_END = 256 * MiB;

constexpr int CW_BAR = 1024;
constexpr int CW_PANEL = 8192;
constexpr int CW_MOE = 12288;

#define RLX_AGENT __ATOMIC_RELAXED, __HIP_MEMORY_SCOPE_AGENT
#define LDS_WAIT() asm volatile("s_waitcnt lgkmcnt(0)" ::: "memory")
#define VM_WAIT() asm volatile("s_waitcnt vmcnt(0)" ::: "memory")
__device__ __forceinline__ unsigned f2bf(float f) { unsigned u = __builtin_bit_cast(unsigned, f); return (u + 0x7fffu + ((u >> 16) & 1u)) >> 16; }
__device__ __forceinline__ unsigned pk2(float lo, float hi) { return f2bf(lo) | (f2bf(hi) << 16); }
__device__ __forceinline__ float bf2f(unsigned b) { return __builtin_bit_cast(float, b << 16); }
__device__ __forceinline__ float bflo(unsigned w) { return __builtin_bit_cast(float, w << 16); }
__device__ __forceinline__ float bfhi(unsigned w) { return __builtin_bit_cast(float, w & 0xffff0000u); }
__device__ __forceinline__ float sigmoidf_(float x) { return __builtin_amdgcn_rcpf(1.f + __builtin_amdgcn_exp2f(-x * LOG2E)); }
template <int CTRL> __device__ __forceinline__ float dpp_f(float v) { return __builtin_bit_cast(float, __builtin_amdgcn_update_dpp(0, __builtin_bit_cast(int, v), CTRL, 0xf, 0xf, true)); }
__device__ __forceinline__ float other32(float v) { float w = v; asm volatile("" : "+v"(w)); auto rr = __builtin_amdgcn_permlane32_swap(__builtin_bit_cast(unsigned, v), __builtin_bit_cast(unsigned, w), false, false);
    unsigned a = rr[0], b = rr[1]; asm volatile("" : "+v"(a), "+v"(b)); return (threadIdx.x & 32) ? __builtin_bit_cast(float, a) : __builtin_bit_cast(float, b); }
__device__ __forceinline__ float other16(float v) { float w = v; asm volatile("" : "+v"(w)); auto rr = __builtin_amdgcn_permlane16_swap(__builtin_bit_cast(unsigned, v), __builtin_bit_cast(unsigned, w), false, false);
    unsigned a = rr[0], b = rr[1]; asm volatile("" : "+v"(a), "+v"(b)); return (threadIdx.x & 16) ? __builtin_bit_cast(float, a) : __builtin_bit_cast(float, b); }
__device__ __forceinline__ float wave_sum(float v) {
    v += dpp_f<0xB1>(v); v += dpp_f<0x4E>(v); v += dpp_f<0x141>(v); v += dpp_f<0x140>(v);
    v += other16(v); v += other32(v);
    return v;
}

#define XB_TMO      128
#define XB_XCNT(j)  (256  + 64 * (j))
#define XB_XSUB(j)  (1280 + 64 * (j))
#define XB_XGEN(j)  (2304 + 64 * (j))
#define XB_TOP      3328
#define XB_TOPGEN   3392
#define XCD_BAR_WORDS 3456
#define XB_SPIN_CAP (1u << 20)
__device__ __forceinline__ unsigned xb_ld(unsigned* p)              { return __hip_atomic_load(p, __ATOMIC_RELAXED, __HIP_MEMORY_SCOPE_AGENT); }
__device__ __forceinline__ unsigned xb_add(unsigned* p, unsigned v) { return __hip_atomic_fetch_add(p, v, __ATOMIC_RELAXED, __HIP_MEMORY_SCOPE_AGENT); }
__device__ __forceinline__ unsigned xb_xcc_id() { return (unsigned)__builtin_amdgcn_s_getreg((3 << 11) | 20) & 0xFu; }
#define XB_SPIN(cond, bar) do { unsigned _sp = 0; while (cond) { __builtin_amdgcn_s_sleep(1); \
    if ((++_sp & 255u) == 0u) { if (xb_ld(&(bar)[XB_TMO])) break; if (_sp > XB_SPIN_CAP) { atomicAdd(&(bar)[XB_TMO], 1u); break; } } } } while (0)
struct XcdBarrier { unsigned* bar; unsigned x; volatile LAS unsigned* st; };
__device__ __forceinline__ XcdBarrier xcd_barrier_post(unsigned* bar, volatile LAS unsigned* st) {
    XcdBarrier b; b.bar = bar; b.x = xb_xcc_id(); b.st = st;
    if (threadIdx.x == 0) (void)xb_add(&bar[XB_XCNT(b.x)], 1u);
    return b;
}
__device__ __forceinline__ void xcd_barrier_complete(unsigned* bar, unsigned x, unsigned& nloc, unsigned& nx) {
    const unsigned G = gridDim.x * gridDim.y * gridDim.z;
    unsigned sum, cnt, mine, sp = 0u;
    for (;;) {
        sum = 0u; cnt = 0u; mine = 0u;
#pragma unroll
        for (unsigned j = 0; j < 16; ++j) { const unsigned c = xb_ld(&bar[XB_XCNT(j)]); sum += c; cnt += (c > 0u) ? 1u : 0u; mine = (j == x) ? c : mine; }
        if (sum == G) break;
        __builtin_amdgcn_s_sleep(1);
        if ((++sp & 255u) == 0u) { if (xb_ld(&bar[XB_TMO])) break; if (sp > XB_SPIN_CAP) { atomicAdd(&bar[XB_TMO], 1u); break; } }
    }
    nloc = mine > 0u ? mine : 1u; nx = cnt > 0u ? cnt : 1u;
}
__device__ __forceinline__ void xcd_barrier(const XcdBarrier& b) {
    asm volatile("s_waitcnt vmcnt(0)" ::: "memory");
    __syncthreads();
    if (threadIdx.x == 0) {
        unsigned* bar = b.bar;
        __builtin_amdgcn_s_waitcnt(0);
        unsigned nloc = b.st[0], nx = b.st[1];
        if (nloc == 0u) { xcd_barrier_complete(bar, b.x, nloc, nx); b.st[0] = nloc; b.st[1] = nx; }
        const unsigned old = xb_add(&bar[XB_XSUB(b.x)], 1u);
        const unsigned gen = old / nloc;
        if (old + 1u == (gen + 1u) * nloc) {
            __builtin_amdgcn_fence(__ATOMIC_RELEASE, "agent");
            asm volatile("s_waitcnt vmcnt(0)" ::: "memory");
            const unsigned og = xb_add(&bar[XB_TOP], 1u);
            const unsigned tg = og / nx;
            if (og + 1u == (tg + 1u) * nx) xb_add(&bar[XB_TOPGEN], 1u);
            else XB_SPIN(xb_ld(&bar[XB_TOPGEN]) == tg, bar);
            __builtin_amdgcn_fence(__ATOMIC_ACQUIRE, "agent");
            xb_add(&bar[XB_XGEN(b.x)], 1u);
            asm volatile("s_waitcnt vmcnt(0)" ::: "memory");
        } else {
            XB_SPIN(xb_ld(&bar[XB_XGEN(b.x)]) == gen, bar);
            __builtin_amdgcn_fence(__ATOMIC_ACQUIRE, "agent");
            asm volatile("s_waitcnt vmcnt(0)" ::: "memory");
        }
    }
    __syncthreads();
}

namespace pg8 {
constexpr int BM = 256, BK = 64, HALF = 128, HTB = HALF * BK * 2, STAGE_BYTES = 8 * HTB, NXCD = 8, WGM = 8;
__host__ __device__ __forceinline__ int lds_byte(int r, int c) { const int st = (r >> 4) * 2 + (c >> 5), rr = r & 15, cc = c & 31, ob = rr * 64 + cc * 2; return st * 1024 + (ob ^ (((ob >> 9) & 1) << 5)); }
__host__ __device__ __forceinline__ void stage_rc(int b, int& R, int& C) { const int st = b / 1024, sb = b % 1024, swz = sb ^ (((sb >> 9) & 1) << 5); R = (st >> 1) * 16 + swz / 64; C = (st & 1) * 32 + (swz % 64) / 2; }
__host__ __device__ __forceinline__ int perm32(int rho) { const int n = rho >> 4, i = rho & 15; return 8 * (i >> 2) + 4 * n + (i & 3); }

struct Unit { int pm, pn, aux, nt; size_t offA, offB; int sel; };
struct Gemm { const bf16* A; const bf16* Bt; int lda, ldb; };

__device__ __forceinline__ void tile_of(int L, int nM, int nN, int& pm, int& pn) {
    const int nwg = nM * nN; int wgid = L;
    { const int q = nwg / NXCD, r = nwg % NXCD, xcd = wgid % NXCD, off = wgid / NXCD; wgid = (xcd < r ? xcd * (q + 1) : r * (q + 1) + (xcd - r) * q) + off; }
    const int nig = WGM * nN, gid = wgid / nig, fm = gid * WGM, gsz = (nM - fm) < WGM ? (nM - fm) : WGM;
    pm = fm + ((wgid % nig) % gsz); pn = (wgid % nig) / gsz;
}
__device__ __forceinline__ unsigned cvt_pk_bf16(float lo, float hi) { unsigned r; asm volatile("v_cvt_pk_bf16_f32 %0, %1, %2" : "=v"(r) : "v"(lo), "v"(hi)); return r; }

typedef f32x4 Acc[2][2][4][2];

template <class Epi, class Sched>
__device__ __forceinline__ void gemm_simple(LAS unsigned char* lds, const Gemm g, const Sched& S, const Epi& E) {
    const int tid = threadIdx.x, wid = __builtin_amdgcn_readfirstlane(tid >> 6), lane = tid & 63, wr = wid >> 2, wc = wid & 3, fr = lane & 15, fq = lane >> 4;
    Unit cur; Acc acc;
#pragma unroll
    for (int a = 0; a < 2; ++a)
#pragma unroll
        for (int b = 0; b < 2; ++b)
#pragma unroll
            for (int m = 0; m < 4; ++m)
#pragma unroll
                for (int n = 0; n < 2; ++n) acc[a][b][m][n] = (f32x4){0.f, 0.f, 0.f, 0.f};
    for (int ui = 0; S.next(ui, cur); ++ui) {
        const char* cA = (const char*)g.A + cur.offA; const char* cB = (const char*)g.Bt + cur.offB;
        for (int kt = 0; kt < cur.nt * 2; ++kt) {
#pragma unroll
            for (int ai = 0; ai < 2; ++ai) {
                bf16x8 af[4];
#pragma unroll
                for (int m = 0; m < 4; ++m) af[m] = *(const bf16x8*)(cA + ((size_t)(ai * HALF + wr * 64 + m * 16 + fr) * g.lda + kt * 32 + fq * 8) * 2);
#pragma unroll
                for (int bj = 0; bj < 2; ++bj)
#pragma unroll
                    for (int n = 0; n < 2; ++n) {
                        const int rr = n * 16 + fr, br = bj * HALF + wc * 32 + (Epi::PERM ? perm32(rr) : rr);
                        const bf16x8 bfr = *(const bf16x8*)(cB + ((size_t)br * g.ldb + kt * 32 + fq * 8) * 2);
#pragma unroll
                        for (int m = 0; m < 4; ++m) acc[ai][bj][m][n] = __builtin_amdgcn_mfma_f32_16x16x32_bf16(bfr, af[m], acc[ai][bj][m][n], 0, 0, 0);
                    }
            }
        }
        if constexpr (Epi::AFTER_DRAIN) { __syncthreads(); E.fused(acc, cur, wr, wc, fr, fq, lds, wid, lane); } else E(acc, cur, wr, wc, fr, fq);
        if (!E.keep(cur)) {
#pragma unroll
            for (int a = 0; a < 2; ++a)
#pragma unroll
                for (int b = 0; b < 2; ++b)
#pragma unroll
                    for (int m = 0; m < 4; ++m)
#pragma unroll
                        for (int n = 0; n < 2; ++n) acc[a][b][m][n] = (f32x4){0.f, 0.f, 0.f, 0.f};
        }
    }
}

template <class Epi, class Sched, bool ALIGN_EPI = true, bool SP2 = true>
__device__ __forceinline__ void gemm_phase(LAS unsigned char* lds, const Gemm g, const Sched& S, const Epi& E) {
    const int tid = threadIdx.x, wid = __builtin_amdgcn_readfirstlane(tid >> 6), lane = tid & 63, wr = wid >> 2, wc = wid & 3, fr = lane & 15, fq = lane >> 4;
    unsigned voffA[2], voffB[2];
#pragma unroll
    for (int i = 0; i < 2; ++i) { int R, C; stage_rc(tid * 16 + i * 8192, R, C); const int Rb = Epi::PERM ? ((R & ~31) + perm32(R & 31)) : R;
        voffA[i] = (unsigned)(R * g.lda + C) * 2u; voffB[i] = (unsigned)(Rb * g.ldb + C) * 2u; }
    const size_t kstep = (size_t)(BK * 2);
    const size_t hstepA = (size_t)HALF * g.lda * 2, hstepB = (size_t)HALF * g.ldb * 2;
    const unsigned ldsw = (unsigned)wid * 1024u;
    const int aoff = lds_byte(wr * 64 + fr, fq * 8), boff = lds_byte(wc * 32 + fr, fq * 8);
#define PG8_SA(b, h) (((b) * 2 + (h)) * HTB)
#define PG8_SB(b, h) ((4 + (b) * 2 + (h)) * HTB)
#define PG8_STAGE(bufoff, gbase, voff) do { _Pragma("unroll") for (int _i = 0; _i < 2; ++_i) \
        __builtin_amdgcn_global_load_lds((const unsigned*)((const char*)(gbase) + (voff)[_i]), (LAS unsigned*)(lds + (bufoff) + ldsw + _i * 8192), 16, 0, 0); } while (0)
#define PG8_LDA(dst, b, h) do { _Pragma("unroll") for (int m = 0; m < 4; ++m) _Pragma("unroll") for (int k = 0; k < 2; ++k) dst[m][k] = *(const LAS bf16x8*)(lds + PG8_SA(b, h) + aoff + m * 2048 + k * 1024); } while (0)
#define PG8_LDB(dst, b, h) do { _Pragma("unroll") for (int n = 0; n < 2; ++n) _Pragma("unroll") for (int k = 0; k < 2; ++k) dst[n][k] = *(const LAS bf16x8*)(lds + PG8_SB(b, h) + boff + n * 2048 + k * 1024); } while (0)
#define PG8_MMA(ai, bj, At, Bt) do { __builtin_amdgcn_s_setprio(1); _Pragma("unroll") for (int m = 0; m < 4; ++m) _Pragma("unroll") for (int n = 0; n < 2; ++n) _Pragma("unroll") for (int k = 0; k < 2; ++k) \
        acc[ai][bj][m][n] = __builtin_amdgcn_mfma_f32_16x16x32_bf16(Bt[n][k], At[m][k], acc[ai][bj][m][n], 0, 0, 0); __builtin_amdgcn_s_setprio(0); } while (0)
#define PG8_WAIT_V(n) asm volatile("s_waitcnt vmcnt(" #n ")" ::: "memory")
#define PG8_WAIT_L(n) asm volatile("s_waitcnt lgkmcnt(" #n ")" ::: "memory")
#define PG8_BAR __builtin_amdgcn_s_barrier()
#define PG8_SCHED __builtin_amdgcn_sched_barrier(0)
    Unit cur, nxt; int ui = 0;
    if (!S.next(0, cur)) return;
    Acc acc;
#pragma unroll
    for (int a = 0; a < 2; ++a)
#pragma unroll
        for (int b = 0; b < 2; ++b)
#pragma unroll
            for (int m = 0; m < 4; ++m)
#pragma unroll
                for (int n = 0; n < 2; ++n) acc[a][b][m][n] = (f32x4){0.f, 0.f, 0.f, 0.f};
    bf16x8 At[4][2], B0[2][2], B1[2][2];
    const char* cA = (const char*)g.A + cur.offA; const char* cB = (const char*)g.Bt + cur.offB;
    if constexpr (SP2) {
        PG8_STAGE(PG8_SB(0, 0), cB, voffB); PG8_STAGE(PG8_SB(0, 1), cB + hstepB, voffB); PG8_STAGE(PG8_SA(0, 0), cA, voffA); PG8_STAGE(PG8_SA(0, 1), cA + hstepA, voffA);
        if (wr == 1) PG8_BAR;
        PG8_WAIT_V(2); PG8_BAR;
        PG8_STAGE(PG8_SB(1, 0), cB + kstep, voffB); PG8_STAGE(PG8_SA(1, 0), cA + kstep, voffA); PG8_STAGE(PG8_SB(1, 1), cB + hstepB + kstep, voffB);
        PG8_WAIT_V(6); PG8_BAR;
    } else {
        PG8_STAGE(PG8_SB(0, 0), cB, voffB); PG8_STAGE(PG8_SA(0, 0), cA, voffA); PG8_STAGE(PG8_SB(0, 1), cB + hstepB, voffB); PG8_STAGE(PG8_SA(0, 1), cA + hstepA, voffA);
        if (wr == 1) PG8_BAR;
        PG8_WAIT_V(4); PG8_BAR;
        PG8_STAGE(PG8_SB(1, 0), cB + kstep, voffB); PG8_STAGE(PG8_SA(1, 0), cA + kstep, voffA); PG8_STAGE(PG8_SB(1, 1), cB + hstepB + kstep, voffB);
        PG8_WAIT_V(6); PG8_BAR;
    }
    for (;;) {
        const bool has_next = S.next(ui + 1, nxt);
        const char* nA = has_next ? (const char*)g.A + nxt.offA : cA; const char* nB = has_next ? (const char*)g.Bt + nxt.offB : cB;
        const int nt = cur.nt;
        for (int t = 0; t < nt; t += 2) {
            const bool last = (t == nt - 2);
            const char* a1 = cA + (size_t)(t + 1) * kstep;
            const char* a2 = last ? nA : cA + (size_t)(t + 2) * kstep; const char* b2 = last ? nB : cB + (size_t)(t + 2) * kstep;
            const char* a3 = a2 + kstep; const char* b3 = b2 + kstep;
            if constexpr (SP2) {
            PG8_LDB(B0, 0, 0); PG8_LDB(B1, 0, 1); PG8_SCHED; PG8_LDA(At, 0, 0); PG8_STAGE(PG8_SA(1, 1), a1 + hstepA, voffA);
            PG8_WAIT_V(8); PG8_WAIT_L(0); PG8_BAR; PG8_MMA(0, 0, At, B0); PG8_MMA(0, 1, At, B1); PG8_BAR; PG8_SCHED;
            PG8_LDA(At, 0, 1); PG8_STAGE(PG8_SB(0, 0), b2, voffB); PG8_STAGE(PG8_SB(0, 1), b2 + hstepB, voffB); PG8_STAGE(PG8_SA(0, 0), a2, voffA);
            PG8_WAIT_V(8); PG8_WAIT_L(0); PG8_BAR; PG8_MMA(1, 0, At, B0); PG8_MMA(1, 1, At, B1); PG8_BAR; PG8_SCHED;
            PG8_LDB(B0, 1, 0); PG8_LDB(B1, 1, 1); PG8_SCHED; PG8_LDA(At, 1, 0); PG8_STAGE(PG8_SA(0, 1), a2 + hstepA, voffA);
            PG8_WAIT_V(8); PG8_WAIT_L(0); PG8_BAR; PG8_MMA(0, 0, At, B0); PG8_MMA(0, 1, At, B1); PG8_BAR; PG8_SCHED;
            PG8_LDA(At, 1, 1); PG8_STAGE(PG8_SB(1, 0), b3, voffB); PG8_STAGE(PG8_SB(1, 1), b3 + hstepB, voffB); PG8_STAGE(PG8_SA(1, 0), a3, voffA);
            PG8_WAIT_V(8); PG8_WAIT_L(0); PG8_BAR; PG8_MMA(1, 0, At, B0); PG8_MMA(1, 1, At, B1); PG8_BAR; PG8_SCHED;
            } else {
            PG8_LDB(B0, 0, 0); PG8_SCHED; PG8_LDA(At, 0, 0); PG8_STAGE(PG8_SA(1, 1), a1 + hstepA, voffA);
            PG8_WAIT_L(8); PG8_BAR; PG8_WAIT_L(0); PG8_MMA(0, 0, At, B0); PG8_BAR; PG8_SCHED;
            PG8_LDB(B1, 0, 1); PG8_STAGE(PG8_SB(0, 0), b2, voffB);
            PG8_BAR; PG8_WAIT_L(0); PG8_MMA(0, 1, At, B1); PG8_BAR;
            PG8_LDA(At, 0, 1); PG8_STAGE(PG8_SA(0, 0), a2, voffA);
            PG8_BAR; PG8_WAIT_L(0); PG8_MMA(1, 0, At, B0); PG8_BAR; PG8_SCHED;
            PG8_STAGE(PG8_SB(0, 1), b2 + hstepB, voffB);
            PG8_WAIT_V(6); PG8_BAR; PG8_MMA(1, 1, At, B1); PG8_BAR;
            PG8_LDB(B0, 1, 0); PG8_SCHED; PG8_LDA(At, 1, 0); PG8_STAGE(PG8_SA(0, 1), a2 + hstepA, voffA);
            PG8_WAIT_L(8); PG8_BAR; PG8_WAIT_L(0); PG8_MMA(0, 0, At, B0); PG8_BAR; PG8_SCHED;
            PG8_LDB(B1, 1, 1); PG8_STAGE(PG8_SB(1, 0), b3, voffB);
            PG8_BAR; PG8_WAIT_L(0); PG8_MMA(0, 1, At, B1); PG8_BAR;
            PG8_LDA(At, 1, 1); PG8_STAGE(PG8_SA(1, 0), a3, voffA);
            PG8_BAR; PG8_WAIT_L(0); PG8_MMA(1, 0, At, B0); PG8_BAR; PG8_SCHED;
            PG8_STAGE(PG8_SB(1, 1), b3 + hstepB, voffB);
            PG8_WAIT_V(6); PG8_BAR; PG8_MMA(1, 1, At, B1); PG8_BAR;
            }
        }
        if constexpr (ALIGN_EPI) { if (wr == 0) PG8_BAR; }
        if constexpr (!Epi::AFTER_DRAIN) E(acc, cur, wr, wc, fr, fq);
        if (!has_next) break;
        if (!E.keep(cur)) {
#pragma unroll
            for (int a = 0; a < 2; ++a)
#pragma unroll
                for (int b = 0; b < 2; ++b)
#pragma unroll
                    for (int m = 0; m < 4; ++m)
#pragma unroll
                        for (int n = 0; n < 2; ++n) acc[a][b][m][n] = (f32x4){0.f, 0.f, 0.f, 0.f};
        }
        cur = nxt; cA = nA; cB = nB; ++ui;
        if constexpr (ALIGN_EPI) { if (wr == 1) PG8_BAR; }
    }
    PG8_WAIT_V(0);
    if constexpr (!ALIGN_EPI) { if (wr == 0) PG8_BAR; }
    PG8_BAR;
    if constexpr (Epi::AFTER_DRAIN) E.fused(acc, cur, wr, wc, fr, fq, lds, wid, lane);
#undef PG8_SA
#undef PG8_SB
#undef PG8_STAGE
#undef PG8_LDA
#undef PG8_LDB
#undef PG8_MMA
#undef PG8_WAIT_V
#undef PG8_WAIT_L
#undef PG8_BAR
#undef PG8_SCHED
}
struct Gemm2 { const bf16* A0; const bf16* B0; int lda0, ldb0; const bf16* A1; const bf16* B1; int lda1, ldb1; const int* gather; };
template <class Epi, class Sched>
__device__ __forceinline__ void gemm_phase2(LAS unsigned char* lds, const Gemm2 g, const Sched& S, const Epi& E) {
    const int tid = threadIdx.x, wid = __builtin_amdgcn_readfirstlane(tid >> 6), lane = tid & 63, wr = wid >> 2, wc = wid & 3, fr = lane & 15, fq = lane >> 4;
    int RA[2], RB[2], CC[2];
#pragma unroll
    for (int i = 0; i < 2; ++i) { int R, C; stage_rc(tid * 16 + i * 8192, R, C); RA[i] = R; RB[i] = Epi::PERM ? ((R & ~31) + perm32(R & 31)) : R; CC[i] = C; }
    const size_t kstep = (size_t)(BK * 2);
    const unsigned ldsw = (unsigned)wid * 1024u;
    const int aoff = lds_byte(wr * 64 + fr, fq * 8), boff = lds_byte(wc * 32 + fr, fq * 8);
#define PG8_SA(b, h) (((b) * 2 + (h)) * HTB)
#define PG8_SB(b, h) ((4 + (b) * 2 + (h)) * HTB)
#define PG8_STAGE2(bufoff, gbase, v0, v1) do { \
        __builtin_amdgcn_global_load_lds((const unsigned*)((const char*)(gbase) + (v0)), (LAS unsigned*)(lds + (bufoff) + ldsw), 16, 0, 0); \
        __builtin_amdgcn_global_load_lds((const unsigned*)((const char*)(gbase) + (v1)), (LAS unsigned*)(lds + (bufoff) + ldsw + 8192), 16, 0, 0); } while (0)
#define PG8_LDA(dst, b, h) do { _Pragma("unroll") for (int m = 0; m < 4; ++m) _Pragma("unroll") for (int k = 0; k < 2; ++k) dst[m][k] = *(const LAS bf16x8*)(lds + PG8_SA(b, h) + aoff + m * 2048 + k * 1024); } while (0)
#define PG8_LDB(dst, b, h) do { _Pragma("unroll") for (int n = 0; n < 2; ++n) _Pragma("unroll") for (int k = 0; k < 2; ++k) dst[n][k] = *(const LAS bf16x8*)(lds + PG8_SB(b, h) + boff + n * 2048 + k * 1024); } while (0)
#define PG8_MMA(ai, bj, At, Bt) do { __builtin_amdgcn_s_setprio(1); _Pragma("unroll") for (int m = 0; m < 4; ++m) _Pragma("unroll") for (int n = 0; n < 2; ++n) _Pragma("unroll") for (int k = 0; k < 2; ++k) \
        acc[ai][bj][m][n] = __builtin_amdgcn_mfma_f32_16x16x32_bf16(Bt[n][k], At[m][k], acc[ai][bj][m][n], 0, 0, 0); __builtin_amdgcn_s_setprio(0); } while (0)
#define PG8_WAIT_V(n) asm volatile("s_waitcnt vmcnt(" #n ")" ::: "memory")
#define PG8_WAIT_L(n) asm volatile("s_waitcnt lgkmcnt(" #n ")" ::: "memory")
#define PG8_BAR __builtin_amdgcn_s_barrier()
#define PG8_SCHED __builtin_amdgcn_sched_barrier(0)
#define PG8_OPS(u, pA, pB, vA0, vA1, vA0h, vA1h, vB0, vB1, hA, hB) do { const int lda_ = (u).sel ? g.lda1 : g.lda0, ldb_ = (u).sel ? g.ldb1 : g.ldb0; \
        pA = (const char*)((u).sel ? g.A1 : g.A0) + (u).offA; pB = (const char*)((u).sel ? g.B1 : g.B0) + (u).offB; \
        vB0 = (unsigned)(RB[0] * ldb_ + CC[0]) * 2u; vB1 = (unsigned)(RB[1] * ldb_ + CC[1]) * 2u; hB = (size_t)HALF * ldb_ * 2; \
        if ((u).sel == 0 && g.gather) { const int* gp_ = g.gather + (u).pm * 256; int t0 = gp_[RA[0]], t1 = gp_[RA[1]], t2 = gp_[RA[0] + 128], t3 = gp_[RA[1] + 128]; \
            t0 = t0 < 0 ? 0 : t0; t1 = t1 < 0 ? 0 : t1; t2 = t2 < 0 ? 0 : t2; t3 = t3 < 0 ? 0 : t3; \
            vA0 = (unsigned)(t0 * lda_ + CC[0]) * 2u; vA1 = (unsigned)(t1 * lda_ + CC[1]) * 2u; vA0h = (unsigned)(t2 * lda_ + CC[0]) * 2u; vA1h = (unsigned)(t3 * lda_ + CC[1]) * 2u; hA = 0; } \
        else { vA0 = (unsigned)(RA[0] * lda_ + CC[0]) * 2u; vA1 = (unsigned)(RA[1] * lda_ + CC[1]) * 2u; vA0h = vA0; vA1h = vA1; hA = (size_t)HALF * lda_ * 2; } } while (0)
    Unit cur, nxt; int ui = 0;
    if (!S.next(0, cur)) return;
    Acc acc;
#pragma unroll
    for (int a = 0; a < 2; ++a)
#pragma unroll
        for (int b = 0; b < 2; ++b)
#pragma unroll
            for (int m = 0; m < 4; ++m)
#pragma unroll
                for (int n = 0; n < 2; ++n) acc[a][b][m][n] = (f32x4){0.f, 0.f, 0.f, 0.f};
    bf16x8 At[4][2], B0[2][2], B1[2][2];
    const char *cA, *cB; unsigned cvA0, cvA1, cvA0h, cvA1h, cvB0, cvB1; size_t chA, chB;
    PG8_OPS(cur, cA, cB, cvA0, cvA1, cvA0h, cvA1h, cvB0, cvB1, chA, chB);
    S.a_ready(cur);
    PG8_STAGE2(PG8_SB(0, 0), cB, cvB0, cvB1); PG8_STAGE2(PG8_SB(0, 1), cB + chB, cvB0, cvB1); PG8_STAGE2(PG8_SA(0, 0), cA, cvA0, cvA1); PG8_STAGE2(PG8_SA(0, 1), cA + chA, cvA0h, cvA1h);
    if (wr == 1) PG8_BAR;
    PG8_WAIT_V(2); PG8_BAR;
    PG8_STAGE2(PG8_SB(1, 0), cB + kstep, cvB0, cvB1); PG8_STAGE2(PG8_SA(1, 0), cA + kstep, cvA0, cvA1); PG8_STAGE2(PG8_SB(1, 1), cB + chB + kstep, cvB0, cvB1);
    PG8_WAIT_V(6); PG8_BAR;
    for (;;) {
        const bool has_next = S.next(ui + 1, nxt);
        const char *nA = cA, *nB = cB; unsigned nvA0 = cvA0, nvA1 = cvA1, nvA0h = cvA0h, nvA1h = cvA1h, nvB0 = cvB0, nvB1 = cvB1; size_t nhA = chA, nhB = chB;
        if (has_next) PG8_OPS(nxt, nA, nB, nvA0, nvA1, nvA0h, nvA1h, nvB0, nvB1, nhA, nhB);
        const int nt = cur.nt;
        for (int t = 0; t < nt; t += 2) {
            const bool last = (t == nt - 2);
            const char* a1 = cA + (size_t)(t + 1) * kstep;
            const char* a2 = last ? nA : cA + (size_t)(t + 2) * kstep; const char* b2 = last ? nB : cB + (size_t)(t + 2) * kstep;
            const char* a3 = a2 + kstep; const char* b3 = b2 + kstep;
            const unsigned sA0 = last ? nvA0 : cvA0, sA1 = last ? nvA1 : cvA1, sA0h = last ? nvA0h : cvA0h, sA1h = last ? nvA1h : cvA1h, sB0 = last ? nvB0 : cvB0, sB1 = last ? nvB1 : cvB1;
            const size_t hA2 = last ? nhA : chA, hB2 = last ? nhB : chB;
            if (last && has_next) S.a_ready(nxt);
            PG8_LDB(B0, 0, 0); PG8_LDB(B1, 0, 1); PG8_SCHED; PG8_LDA(At, 0, 0); PG8_STAGE2(PG8_SA(1, 1), a1 + chA, cvA0h, cvA1h);
            PG8_WAIT_V(8); PG8_WAIT_L(0); PG8_BAR; PG8_MMA(0, 0, At, B0); PG8_MMA(0, 1, At, B1); PG8_BAR; PG8_SCHED;
            PG8_LDA(At, 0, 1); PG8_STAGE2(PG8_SB(0, 0), b2, sB0, sB1); PG8_STAGE2(PG8_SB(0, 1), b2 + hB2, sB0, sB1); PG8_STAGE2(PG8_SA(0, 0), a2, sA0, sA1);
            PG8_WAIT_V(8); PG8_WAIT_L(0); PG8_BAR; PG8_MMA(1, 0, At, B0); PG8_MMA(1, 1, At, B1); PG8_BAR; PG8_SCHED;
            PG8_LDB(B0, 1, 0); PG8_LDB(B1, 1, 1); PG8_SCHED; PG8_LDA(At, 1, 0); PG8_STAGE2(PG8_SA(0, 1), a2 + hA2, sA0h, sA1h);
            PG8_WAIT_V(8); PG8_WAIT_L(0); PG8_BAR; PG8_MMA(0, 0, At, B0); PG8_MMA(0, 1, At, B1); PG8_BAR; PG8_SCHED;
            PG8_LDA(At, 1, 1); PG8_STAGE2(PG8_SB(1, 0), b3, sB0, sB1); PG8_STAGE2(PG8_SB(1, 1), b3 + hB2, sB0, sB1); PG8_STAGE2(PG8_SA(1, 0), a3, sA0, sA1);
            PG8_WAIT_V(8); PG8_WAIT_L(0); PG8_BAR; PG8_MMA(1, 0, At, B0); PG8_MMA(1, 1, At, B1); PG8_BAR; PG8_SCHED;
        }
        if (wr == 0) PG8_BAR;
        E(acc, cur, wr, wc, fr, fq);
        if (!has_next) break;
        if (!E.keep(cur)) {
#pragma unroll
            for (int a = 0; a < 2; ++a)
#pragma unroll
                for (int b = 0; b < 2; ++b)
#pragma unroll
                    for (int m = 0; m < 4; ++m)
#pragma unroll
                        for (int n = 0; n < 2; ++n) acc[a][b][m][n] = (f32x4){0.f, 0.f, 0.f, 0.f};
        }
        cur = nxt; cA = nA; cB = nB; cvA0 = nvA0; cvA1 = nvA1; cvA0h = nvA0h; cvA1h = nvA1h; cvB0 = nvB0; cvB1 = nvB1; chA = nhA; chB = nhB; ++ui;
        if (wr == 1) PG8_BAR;
    }
    PG8_WAIT_V(0);
    PG8_BAR;
#undef PG8_SA
#undef PG8_SB
#undef PG8_STAGE2
#undef PG8_LDA
#undef PG8_LDB
#undef PG8_MMA
#undef PG8_WAIT_V
#undef PG8_WAIT_L
#undef PG8_BAR
#undef PG8_SCHED
#undef PG8_OPS
}
}

#ifndef USE_FAST_GEMM
#define USE_FAST_GEMM 1
#endif
template <class Epi, class Sched>
__device__ __forceinline__ void run_gemm(LAS unsigned char* lds, const pg8::Gemm g, const Sched& S, const Epi& E) {
#if USE_FAST_GEMM
    pg8::gemm_phase<Epi, Sched, !Epi::AFTER_DRAIN, true>(lds, g, S, E);
#else
    pg8::gemm_simple<Epi, Sched>(lds, g, S, E);
#endif
}

constexpr int NWAVES = 8;
constexpr int RING_BYTES = 131072;
constexpr int LDS_BYTES = 163840;
constexpr int MISC_OFF = LDS_BYTES - 128;

struct Args {
    const float* in[24]; float* out; unsigned char* ws; int ph_lo, ph_hi, li, pad;
};
enum { I_X = 0, I_P, I_MIXG, I_WIN, I_CONVW, I_CONVB, I_DTB, I_ALOG, I_DSKIP, I_SSDG, I_WOA, I_WOB, I_WOUT, I_FFNG, I_WRG, I_BRG, I_WRE, I_BRE, I_WGATE, I_WUP, I_WDOWN, I_WPP, I_WPG, I_FING };

struct Frame {
    LAS unsigned char* lds;
    int tid, lane, wave, vcu, G;
    const float* const* in; float* out; unsigned char* ws; float pscale, live;
};

__device__ __forceinline__ void transpose_item(const float* W, int ldsrc, int k0, int c0, bf16* WT, int ldt, int r0, int kd0, LAS float* scr, int lane, const float* ks = nullptr, float cs = 1.f) {
    float wv[32];
#pragma unroll
    for (int i = 0; i < 32; ++i) wv[i] = W[(size_t)(k0 + 2 * i + (lane >> 5)) * ldsrc + c0 + (lane & 31)];
    if (cs != 1.f) {
#pragma unroll
        for (int i = 0; i < 32; ++i) wv[i] *= cs; }
    if (ks) {
#pragma unroll
        for (int i = 0; i < 32; ++i) wv[i] *= ks[k0 + 2 * i + (lane >> 5)]; }
#pragma unroll
    for (int i = 0; i < 32; ++i) scr[(2 * i + (lane >> 5)) * 33 + (lane & 31)] = wv[i];
    LDS_WAIT(); asm volatile("" ::: "memory");
    const int c = lane & 7;
#pragma unroll
    for (int j = 0; j < 4; ++j) { const int n = (lane >> 3) + 8 * j; const LAS float* s = scr + (8 * c) * 33 + n;
        u32x4 o; o.x = pk2(s[0 * 33], s[1 * 33]); o.y = pk2(s[2 * 33], s[3 * 33]); o.z = pk2(s[4 * 33], s[5 * 33]); o.w = pk2(s[6 * 33], s[7 * 33]);
        *(GAS u32x4*)(WT + (size_t)(r0 + n) * ldt + kd0 + k0 + 8 * c) = o; }
    LDS_WAIT(); asm volatile("" ::: "memory");
}

__device__ __forceinline__ void phase_prologue(Frame& F) {
    const int gw = F.vcu * NWAVES + F.wave, NGW = F.G * NWAVES;
    LAS float* scr = (LAS float*)(F.lds + F.wave * 8704);
    bf16* WCAT2 = (bf16*)(F.ws + WS_WCAT2); bf16* BCAT = (bf16*)(F.ws + WS_BCAT); bf16* WOUT = (bf16*)(F.ws + WS_WOUT); bf16* WPG = (bf16*)(F.ws + WS_WPG);
    constexpr int I0 = 16 * 128, I1 = 16 * 64, I2 = 4 * 32, I3 = 8 * 32, I4 = 16 * 32, I5 = 16 * 32, I6 = 16 * 32, NIT = I0 + I1 + I2 + I3 + I4 + I5 + I6;
    float wreg[32];
#pragma unroll
    for (int q = 0; q < 32; ++q) { const int i = F.tid + q * (NWAVES * 64); wreg[q] = F.in[I_WIN][(size_t)(i >> 4) * IN_DIM + OFF_DT + (i & 15)]; }
    for (int it = gw; it < NIT; it += NGW) {
        int r = it;
        if (r < I0) { transpose_item(F.in[I_WIN], IN_DIM, 64 * (r / 128), 32 * (r % 128), WCAT2, 1280, 32 * (r % 128), 0, scr, F.lane, nullptr, (r % 128) < 16 ? C2 : 1.f); continue; } r -= I0;
        if (r < I1) { transpose_item(F.in[I_WIN], IN_DIM, 64 * (r / 64), OFF_GA + 32 * (r % 64), WCAT2, 1280, 4096 + 32 * (r % 64), 0, scr, F.lane); continue; } r -= I1;
        if (r < I2) { transpose_item(F.in[I_WPP], DM, 64 * (r / 32), 32 * (r % 32), WCAT2, 1280, 6144 + 32 * (r % 32), 1024, scr, F.lane); continue; } r -= I2;
        if (r < I3) { transpose_item(F.in[I_WOA], DM, 64 * (r / 32), 32 * (r % 32), BCAT, 1536, 32 * (r % 32), 0, scr, F.lane); continue; } r -= I3;
        if (r < I4) { transpose_item(F.in[I_WOB], DM, 64 * (r / 32), 32 * (r % 32), BCAT, 1536, 32 * (r % 32), 512, scr, F.lane, F.in[I_SSDG]); continue; } r -= I4;
        if (r < I5) { transpose_item(F.in[I_WOUT], DM, 64 * (r / 32), 32 * (r % 32), WOUT, 1024, 32 * (r % 32), 0, scr, F.lane); continue; } r -= I5;
        transpose_item(F.in[I_WPG], DM, 64 * (r / 32), 32 * (r % 32), WPG, 1024, 32 * (r % 32), 0, scr, F.lane);
    }
    { bf16* WRT = (bf16*)(F.ws + WS_WRT); const int gt = F.vcu * (NWAVES * 64) + F.tid;
      if (gt < 32 * 1024) { const int c = gt >> 10, k = gt & 1023; float v = c < 4 ? F.in[I_WRG][(size_t)k * 4 + c] : (c < 20 ? F.in[I_WRE][(size_t)k * 16 + c - 4] : 0.f); WRT[gt] = (bf16)f2bf(v * F.in[I_FFNG][k]); } }
    LAS bf16* WH = (LAS bf16*)(F.lds + 8 * 8704); LAS bf16* WL = WH + 16 * 1032;
#pragma unroll
    for (int q = 0; q < 32; ++q) { const int i = F.tid + q * (NWAVES * 64), k = i >> 4, c = i & 15; const float w = wreg[q];
        const unsigned h = f2bf(w); WH[c * 1032 + k] = (bf16)h; WL[c * 1032 + k] = (bf16)f2bf(w - __builtin_bit_cast(float, h << 16)); }
    LAS bf16* XL = (LAS bf16*)F.lds;
    __syncthreads();
    bf16* ACAT2 = (bf16*)(F.ws + WS_ACAT2); float* DTRAW = (float*)(F.ws + WS_DTRAW);
    const float* X = F.in[I_X]; const float* P = F.in[I_P]; const float* G = F.in[I_MIXG];
    for (int base = gw, trip = 0; base < M; base += 4 * NGW, ++trip) {
        f32x4 v[4][4]; float rs[4];
#pragma unroll
        for (int i = 0; i < 4; ++i) { const GAS f32x4* xr = (const GAS f32x4*)(X + (size_t)(base + i * NGW) * DM) + F.lane;
#pragma unroll
            for (int j = 0; j < 4; ++j) v[i][j] = xr[64 * j]; }
        const f32x4 pv0 = *((const GAS f32x4*)(P + (size_t)(base + 0 * NGW) * PLE) + F.lane), pv1 = *((const GAS f32x4*)(P + (size_t)(base + 1 * NGW) * PLE) + F.lane),
                    pv2 = *((const GAS f32x4*)(P + (size_t)(base + 2 * NGW) * PLE) + F.lane), pv3 = *((const GAS f32x4*)(P + (size_t)(base + 3 * NGW) * PLE) + F.lane);
        f32x4 gg[4];
#pragma unroll
        for (int j = 0; j < 4; ++j) gg[j] = *((const GAS f32x4*)G + F.lane + 64 * j);
#pragma unroll
        for (int i = 0; i < 4; ++i) { float s = 0.f;
#pragma unroll
            for (int j = 0; j < 4; ++j) s += (v[i][j].x * v[i][j].x + v[i][j].y * v[i][j].y) + (v[i][j].z * v[i][j].z + v[i][j].w * v[i][j].w);
            rs[i] = 1.0f / sqrtf(wave_sum(s) * (1.f / DM) + EPS); }
        if (trip) { asm volatile("s_waitcnt lgkmcnt(0)" ::: "memory"); __builtin_amdgcn_s_barrier(); asm volatile("" ::: "memory"); }
#pragma unroll
        for (int i = 0; i < 4; ++i) { GAS unsigned long long* o8 = (GAS unsigned long long*)(ACAT2 + (size_t)(base + i * NGW) * 1280) + F.lane;
            LAS unsigned long long* l8 = (LAS unsigned long long*)(XL + (F.wave * 4 + i) * 1032) + F.lane;
#pragma unroll
            for (int j = 0; j < 4; ++j) { v[i][j] = v[i][j] * rs[i] * gg[j]; const unsigned long long pk = (unsigned long long)pk2(v[i][j].x, v[i][j].y) | ((unsigned long long)pk2(v[i][j].z, v[i][j].w) << 32); o8[64 * j] = pk; l8[64 * j] = pk; } }
        *((GAS unsigned long long*)(ACAT2 + (size_t)(base + 0 * NGW) * 1280 + 1024) + F.lane) = (unsigned long long)pk2(pv0.x, pv0.y) | ((unsigned long long)pk2(pv0.z, pv0.w) << 32);
        *((GAS unsigned long long*)(ACAT2 + (size_t)(base + 1 * NGW) * 1280 + 1024) + F.lane) = (unsigned long long)pk2(pv1.x, pv1.y) | ((unsigned long long)pk2(pv1.z, pv1.w) << 32);
        *((GAS unsigned long long*)(ACAT2 + (size_t)(base + 2 * NGW) * 1280 + 1024) + F.lane) = (unsigned long long)pk2(pv2.x, pv2.y) | ((unsigned long long)pk2(pv2.z, pv2.w) << 32);
        *((GAS unsigned long long*)(ACAT2 + (size_t)(base + 3 * NGW) * 1280 + 1024) + F.lane) = (unsigned long long)pk2(pv3.x, pv3.y) | ((unsigned long long)pk2(pv3.z, pv3.w) << 32);
        asm volatile("s_waitcnt lgkmcnt(0)" ::: "memory"); __builtin_amdgcn_s_barrier(); asm volatile("" ::: "memory");
        if (F.wave < 2) {
            const int fr = F.lane & 15, fq = F.lane >> 4;
            const LAS bf16* ap = XL + (16 * F.wave + fr) * 1032 + fq * 8; const LAS bf16* bh = WH + fr * 1032 + fq * 8; const LAS bf16* bl = WL + fr * 1032 + fq * 8;
            f32x4 acc = {0.f, 0.f, 0.f, 0.f};
#pragma unroll 8
            for (int ks = 0; ks < 32; ++ks) { const bf16x8 a = *(const LAS bf16x8*)(ap + ks * 32);
                acc = __builtin_amdgcn_mfma_f32_16x16x32_bf16(a, *(const LAS bf16x8*)(bh + ks * 32), acc, 0, 0, 0); acc = __builtin_amdgcn_mfma_f32_16x16x32_bf16(a, *(const LAS bf16x8*)(bl + ks * 32), acc, 0, 0, 0); }
#pragma unroll
            for (int j = 0; j < 4; ++j) DTRAW[(size_t)(F.vcu * NWAVES + 4 * F.wave + fq + (j + 4 * trip) * NGW) * 16 + fr] = acc[j];
        }
    }
    asm volatile("s_waitcnt lgkmcnt(0)" ::: "memory"); __builtin_amdgcn_s_barrier(); asm volatile("" ::: "memory");
}

struct EpiProj {
    static constexpr bool PERM = true, AFTER_DRAIN = false;
    bf16 *Q, *K, *V, *Z, *XBC, *GA, *GB, *PP;
    __device__ __forceinline__ bool keep(const pg8::Unit&) const { return false; }
    __device__ __forceinline__ void operator()(pg8::Acc& acc, const pg8::Unit& u, int wr, int wc, int fr, int fq) const {
        const int pn = u.pn; bf16* base; int ldc, colt; bool gate = false;
        if (pn < 2) { base = Q; ldc = 512; colt = pn * 256; }
        else if (pn < 4) { base = K; ldc = 512; colt = (pn - 2) * 256; }
        else if (pn < 6) { base = V; ldc = 512; colt = (pn - 4) * 256; }
        else if (pn < 10) { base = Z; ldc = 1024; colt = (pn - 6) * 256; }
        else if (pn < 16) { base = XBC; ldc = 1536; colt = (pn - 10) * 256; }
        else if (pn < 20) { base = GA; ldc = 1024; colt = (pn - 16) * 256; gate = true; }
        else if (pn < 24) { base = GB; ldc = 1024; colt = (pn - 20) * 256; gate = true; }
        else { base = PP; ldc = 1024; colt = (pn - 24) * 256; }
        char* bp = (char*)base;
        const unsigned off0 = (unsigned)((u.pm * 256 + wr * 64 + fr) * ldc + colt + wc * 32 + 8 * fq) * 2u, mstep = 32u * (unsigned)ldc, astep = 256u * (unsigned)ldc;
        if (gate) {
#pragma unroll
            for (int ai = 0; ai < 2; ++ai)
#pragma unroll
                for (int m = 0; m < 4; ++m) { const unsigned o = off0 + ai * astep + m * mstep;
#pragma unroll
                    for (int bj = 0; bj < 2; ++bj) { f32x4 v0 = acc[ai][bj][m][0], v1 = acc[ai][bj][m][1];
#pragma unroll
                        for (int j = 0; j < 4; ++j) { v0[j] = sigmoidf_(v0[j]); v1[j] = sigmoidf_(v1[j]); }
                        u32x4 w; w.x = pg8::cvt_pk_bf16(v0[0], v0[1]); w.y = pg8::cvt_pk_bf16(v0[2], v0[3]); w.z = pg8::cvt_pk_bf16(v1[0], v1[1]); w.w = pg8::cvt_pk_bf16(v1[2], v1[3]);
                        { char* q = bp + (size_t)(o + bj * 256); asm volatile("" : "+v"(q)); *(u32x4*)q = w; } } }
        } else {
#pragma unroll
            for (int ai = 0; ai < 2; ++ai)
#pragma unroll
                for (int m = 0; m < 4; ++m) { const unsigned o = off0 + ai * astep + m * mstep;
#pragma unroll
                    for (int bj = 0; bj < 2; ++bj) { f32x4 v0 = acc[ai][bj][m][0], v1 = acc[ai][bj][m][1];
                        u32x4 w; w.x = pg8::cvt_pk_bf16(v0[0], v0[1]); w.y = pg8::cvt_pk_bf16(v0[2], v0[3]); w.z = pg8::cvt_pk_bf16(v1[0], v1[1]); w.w = pg8::cvt_pk_bf16(v1[2], v1[3]);
                        { char* q = bp + (size_t)(o + bj * 256); asm volatile("" : "+v"(q)); *(u32x4*)q = w; } } }
        }
    }
};
struct SchedProj {
    int G, c;
    __device__ __forceinline__ bool next(int i, pg8::Unit& u) const {
        const int L = i * G + c; constexpr int NP = 64 * 24, NQ = 64 * 4;
        if (L >= NP + NQ) return false;
        int pm, pn;
        if (L < NP) { pg8::tile_of(L, 64, 24, pm, pn); u.pm = pm; u.pn = pn; u.aux = 0; u.sel = 0; u.nt = 16; u.offA = (size_t)pm * 256 * 1280 * 2; u.offB = (size_t)pn * 256 * 1280 * 2; }
        else { pg8::tile_of(L - NP, 64, 4, pm, pn); u.pm = pm; u.pn = 24 + pn; u.aux = 0; u.nt = 4; u.offA = (size_t)pm * 256 * 1280 * 2 + 1024 * 2; u.offB = (size_t)(6144 + pn * 256) * 1280 * 2 + 1024 * 2; }
        return true;
    }
};
__device__ __forceinline__ void phase_proj(Frame& F) {
    pg8::Gemm g{(const bf16*)(F.ws + WS_ACAT2), (const bf16*)(F.ws + WS_WCAT2), 1280, 1280};
    EpiProj E{(bf16*)(F.ws + WS_Q), (bf16*)(F.ws + WS_K), (bf16*)(F.ws + WS_V), (bf16*)(F.ws + WS_Z), (bf16*)(F.ws + WS_XBC), (bf16*)F.out, (bf16*)F.out + (size_t)M * DM, (bf16*)(F.ws + WS_PP)};
    SchedProj S{F.G, (int)blockIdx.x};
    run_gemm(F.lds, g, S, E);
}

__device__ __forceinline__ void phase_conv(Frame& F) {
    const int gt = F.vcu * (NWAVES * 64) + F.tid, NGT = F.G * NWAVES * 64;
    const bf16* XBC = (const bf16*)(F.ws + WS_XBC); bf16* XA = (bf16*)(F.ws + WS_XBCACT);
    const float* CW = F.in[I_CONVW]; const float* CB = F.in[I_CONVB];
    const int gwc = F.vcu * NWAVES + F.wave; const bool grid2k = (F.G * NWAVES == 2048);
    for (int it = grid2k ? (((gwc & 3) == 3) ? (CONVD / 8) * (M / 32) : (gwc - (gwc >> 2)) * 64 + F.lane) : gt; it < (CONVD / 8) * (M / 32); it += NGT) {
        const int c0 = (it % (CONVD / 8)) * 8, m0 = (it / (CONVD / 8)) * 32; const bool first = (m0 % SEQ) == 0;
        float w[4][8], bs[8], win[3][8];
#pragma unroll
        for (int k = 0; k < 4; ++k) { const f32x4 w0 = *(const GAS f32x4*)(CW + k * CONVD + c0), w1 = *(const GAS f32x4*)(CW + k * CONVD + c0 + 4);
            w[k][0] = w0.x; w[k][1] = w0.y; w[k][2] = w0.z; w[k][3] = w0.w; w[k][4] = w1.x; w[k][5] = w1.y; w[k][6] = w1.z; w[k][7] = w1.w; }
        { const f32x4 b0 = *(const GAS f32x4*)(CB + c0), b1 = *(const GAS f32x4*)(CB + c0 + 4); bs[0] = b0.x; bs[1] = b0.y; bs[2] = b0.z; bs[3] = b0.w; bs[4] = b1.x; bs[5] = b1.y; bs[6] = b1.z; bs[7] = b1.w; }
#pragma unroll
        for (int k = 0; k < 3; ++k) { u32x4 r = {0u, 0u, 0u, 0u}; if (!first) r = *(const GAS u32x4*)(XBC + (size_t)(m0 - 3 + k) * CONVD + c0);
            win[k][0] = bflo(r.x); win[k][1] = bfhi(r.x); win[k][2] = bflo(r.y); win[k][3] = bfhi(r.y); win[k][4] = bflo(r.z); win[k][5] = bfhi(r.z); win[k][6] = bflo(r.w); win[k][7] = bfhi(r.w); }
#pragma unroll 1
        for (int tb = 0; tb < 4; ++tb) {
            u32x4 rr[8];
#pragma unroll
            for (int k = 0; k < 8; ++k) rr[k] = *(const GAS u32x4*)(XBC + (size_t)(m0 + tb * 8 + k) * CONVD + c0);
#pragma unroll
            for (int k = 0; k < 8; ++k) { const u32x4 r = rr[k];
                const float x[8] = {bflo(r.x), bfhi(r.x), bflo(r.y), bfhi(r.y), bflo(r.z), bfhi(r.z), bflo(r.w), bfhi(r.w)};
                float a[8];
#pragma unroll
                for (int j = 0; j < 8; ++j) { a[j] = bs[j] + w[0][j] * win[0][j] + w[1][j] * win[1][j] + w[2][j] * win[2][j] + w[3][j] * x[j]; a[j] = a[j] * sigmoidf_(a[j]);
                    win[0][j] = win[1][j]; win[1][j] = win[2][j]; win[2][j] = x[j]; }
                u32x4 o; o.x = pk2(a[0], a[1]); o.y = pk2(a[2], a[3]); o.z = pk2(a[4], a[5]); o.w = pk2(a[6], a[7]);
                *(GAS u32x4*)(XA + (size_t)(m0 + tb * 8 + k) * CONVD + c0) = o; }
        }
    }
    {
        constexpr int CONV_WAVES = (CONVD / 8) * (M / 32) / 64;
        const int gw0 = F.vcu * NWAVES + F.wave, NGW0 = F.G * NWAVES;
        const bool spare = (NGW0 == 2048);
        const int gw = spare ? (((gw0 & 3) == 3) ? (gw0 >> 2) : -1) : gw0, NGW = spare ? 512 : NGW0;
        const float* DTRAW = (const float*)(F.ws + WS_DTRAW); float* DT = (float*)(F.ws + WS_DT); float* CS = (float*)(F.ws + WS_CS);
        for (int it = gw < 0 ? (M / 256) * SH : gw; it < (M / 256) * SH; it += NGW) {
            const int ch = it / SH, j = it % SH; const float bias = F.in[I_DTB][j], a = -__expf(F.in[I_ALOG][j]);
            float dt[4], cs[4]; float run = 0.f;
#pragma unroll
            for (int e = 0; e < 4; ++e) { const float x = DTRAW[(size_t)(ch * 256 + 4 * F.lane + e) * 16 + j] + bias; dt[e] = x > 20.f ? x : log1pf(__expf(x)); run += dt[e] * a; cs[e] = run; }
            float inc = run;
#pragma unroll
            for (int o = 1; o < 64; o <<= 1) { const float t = __shfl_up(inc, o); if (F.lane >= o) inc += t; }
            const float excl = inc - run;
#pragma unroll
            for (int e = 0; e < 4; ++e) { const size_t idx = (size_t)(ch * 256 + 4 * F.lane + e) * 16 + j; DT[idx] = dt[e]; CS[idx] = cs[e] + excl; }
        }
        const bf16* Kb = (const bf16*)(F.ws + WS_K); float* KM = (float*)(F.ws + WS_KMEAN);
        for (int it = gw < 0 ? NBATCH * AH * NBLK : gw; it < NBATCH * AH * NBLK; it += NGW) {
            const int b = it / (AH * NBLK), h = (it / NBLK) % AH, kb = it % NBLK;
            const int rg = F.lane >> 3, chk = F.lane & 7;
            const bf16* kp = Kb + (size_t)(b * SEQ + kb * 256 + rg) * AW + h * 64 + chk * 8;
            float a[8] = {0.f, 0.f, 0.f, 0.f, 0.f, 0.f, 0.f, 0.f};
            u32x4 kw[32];
#pragma unroll
            for (int r = 0; r < 32; ++r) kw[r] = *(const GAS u32x4*)(kp + (size_t)r * 8 * AW);
#pragma unroll
            for (int r = 0; r < 32; ++r) { const u32x4 w = kw[r];
                a[0] += bflo(w.x); a[1] += bfhi(w.x); a[2] += bflo(w.y); a[3] += bfhi(w.y); a[4] += bflo(w.z); a[5] += bfhi(w.z); a[6] += bflo(w.w); a[7] += bfhi(w.w); }
#pragma unroll
            for (int e = 0; e < 8; ++e) { a[e] += __shfl_xor(a[e], 8); a[e] += __shfl_xor(a[e], 16); a[e] += __shfl_xor(a[e], 32); }
            if (rg == 0) { f32x4 o0 = {a[0], a[1], a[2], a[3]}, o1 = {a[4], a[5], a[6], a[7]}; o0 = o0 * (1.f / 256.f); o1 = o1 * (1.f / 256.f);
                *(GAS f32x4*)(KM + (size_t)it * 64 + chk * 8) = o0; *(GAS f32x4*)(KM + (size_t)it * 64 + chk * 8 + 4) = o1; }
        }
    }
}

__device__ __forceinline__ void phase_norm(Frame& F) {
    const int gw = F.vcu * NWAVES + F.wave, NGW = F.G * NWAVES;
    LAS float* scr = (LAS float*)(F.lds + F.wave * 8704);
    bf16* WGU = (bf16*)(F.ws + WS_WGU); bf16* WD = (bf16*)(F.ws + WS_WD);
    constexpr int IG = NE * 16 * 16, ID = NE * 8 * 32;
    for (int it = gw; it < 2 * IG + ID; it += NGW) {
        int r = it;
        if (r < 2 * IG) { const int up = r >= IG; if (up) r -= IG; const int e = r / 256, kb = (r % 256) / 16, nb = r % 16;
            const float* W = F.in[up ? I_WUP : I_WGATE] + (size_t)e * DM * FF;
            const int j0 = 32 * nb, row0 = e * 1024 + 256 * (j0 / 128) + (j0 % 128) + (up ? 128 : 0);
            transpose_item(W, FF, 64 * kb, j0, WGU, 1024, row0, 0, scr, F.lane, F.in[I_FFNG]); }
        else { r -= 2 * IG; const int e = r / 256, kb = (r % 256) / 32, nb = r % 32;
            const float* W = F.in[I_WDOWN] + (size_t)e * FF * DM;
            transpose_item(W, DM, 64 * kb, 32 * nb, WD, 512, e * 1024 + 32 * nb, 0, scr, F.lane); }
    }
}

struct EpiMerge {
    static constexpr bool PERM = true, AFTER_DRAIN = false;
    const bf16 *GA, *GB; bf16* OUT; const LAS float* RN;
    __device__ __forceinline__ bool keep(const pg8::Unit& u) const { return u.aux < 2; }
    __device__ __forceinline__ void operator()(pg8::Acc& acc, const pg8::Unit& u, int wr, int wc, int fr, int fq) const {
        const int row0 = u.pm * 256 + wr * 64 + fr, col0 = u.pn * 256 + wc * 32 + 8 * fq;
#pragma unroll
        for (int ai = 0; ai < 2; ++ai)
#pragma unroll
            for (int m = 0; m < 4; ++m) { const int row = row0 + ai * 128 + m * 16; const size_t off = (size_t)row * DM + col0;
                const f32x2 rn = *(const LAS f32x2*)(RN + 2 * (row - u.pm * 256));
                if (u.aux == 1) { const float f = rn.x / rn.y;
#pragma unroll
                    for (int bj = 0; bj < 2; ++bj) { acc[ai][bj][m][0] = acc[ai][bj][m][0] * f; acc[ai][bj][m][1] = acc[ai][bj][m][1] * f; }
                } else if (u.aux == 0) {
                    const u32x4 gb0 = *(const u32x4*)(GB + off), gb1 = *(const u32x4*)(GB + off + 128), ga0 = *(const u32x4*)(GA + off), ga1 = *(const u32x4*)(GA + off + 128);
                    const float r0 = rn.x;
#pragma unroll
                    for (int bj = 0; bj < 2; ++bj) { const u32x4 g = bj ? gb1 : gb0, h = bj ? ga1 : ga0;
                        const float b[8] = {bflo(g.x), bfhi(g.x), bflo(g.y), bfhi(g.y), bflo(g.z), bfhi(g.z), bflo(g.w), bfhi(g.w)};
                        const float a[8] = {bflo(h.x), bfhi(h.x), bflo(h.y), bfhi(h.y), bflo(h.z), bfhi(h.z), bflo(h.w), bfhi(h.w)};
#pragma unroll
                        for (int j = 0; j < 4; ++j) { acc[ai][bj][m][0][j] *= a[j] * __builtin_amdgcn_rcpf(fmaxf(b[j] * r0, 1e-30f)); acc[ai][bj][m][1][j] *= a[4 + j] * __builtin_amdgcn_rcpf(fmaxf(b[4 + j] * r0, 1e-30f)); } }
                } else {
                    const u32x4 gb0 = *(const u32x4*)(GB + off), gb1 = *(const u32x4*)(GB + off + 128);
                    const float r1 = rn.y;
#pragma unroll
                    for (int bj = 0; bj < 2; ++bj) { const u32x4 g = bj ? gb1 : gb0;
                        const float b[8] = {bflo(g.x), bfhi(g.x), bflo(g.y), bfhi(g.y), bflo(g.z), bfhi(g.z), bflo(g.w), bfhi(g.w)};
                        const f32x4 v0 = acc[ai][bj][m][0] * r1, v1 = acc[ai][bj][m][1] * r1;
                        u32x4 w; w.x = pg8::cvt_pk_bf16(v0[0] * b[0], v0[1] * b[1]); w.y = pg8::cvt_pk_bf16(v0[2] * b[2], v0[3] * b[3]);
                        w.z = pg8::cvt_pk_bf16(v1[0] * b[4], v1[1] * b[5]); w.w = pg8::cvt_pk_bf16(v1[2] * b[6], v1[3] * b[7]);
                        *(u32x4*)(OUT + off + bj * 128) = w; }
                }
            }
    }
};
struct SchedMerge {
    int G, c;
    __device__ __forceinline__ bool next(int i, pg8::Unit& u) const {
        const int T = (i / 3) * G + c; if (T >= 256) return false;
        int pm, pn; pg8::tile_of(T, 64, 4, pm, pn); const int sub = i % 3;
        u.pm = pm; u.pn = pn; u.aux = sub; u.nt = 8;
        u.offA = (size_t)pm * 256 * 1536 * 2 + sub * 512 * 2; u.offB = (size_t)pn * 256 * 1536 * 2 + sub * 512 * 2;
        return true;
    }
};
__device__ __forceinline__ void phase_merge(Frame& F) {
    LAS float* rnt = (LAS float*)(F.lds + 140 * 1024);
    { int pm0, pn0; pg8::tile_of((int)blockIdx.x, 64, 4, pm0, pn0);
      if (F.tid < 256) { const f32x4* sp = (const f32x4*)((const float*)(F.ws + WS_SUMSQ) + (size_t)(pm0 * 256 + F.tid) * 16); const f32x4 a = sp[0], b = sp[1], c = sp[2], d = sp[3];
        rnt[2 * F.tid] = 1.0f / sqrtf(((a.x + a.y + a.z + a.w) + (b.x + b.y + b.z + b.w)) * (1.f / 512.f) + EPS); rnt[2 * F.tid + 1] = 1.0f / sqrtf(((c.x + c.y + c.z + c.w) + (d.x + d.y + d.z + d.w)) * (1.f / 512.f) + EPS); } }
    __syncthreads();
    pg8::Gemm g{(const bf16*)(F.ws + WS_ACAT), (const bf16*)(F.ws + WS_BCAT), 1536, 1536};
    EpiMerge E{(const bf16*)F.out, (const bf16*)F.out + (size_t)M * DM, (bf16*)(F.ws + WS_MERGED), rnt};
    SchedMerge S{F.G, (int)blockIdx.x};
    run_gemm(F.lds, g, S, E);
}

struct SchedPlain {
    int G, c, nN, nt, lda, ldb;
    __device__ __forceinline__ bool next(int i, pg8::Unit& u) const {
        const int L = i * G + c; if (L >= 64 * nN) return false;
        int pm, pn; pg8::tile_of(L, 64, nN, pm, pn);
        u.pm = pm; u.pn = pn; u.aux = 0; u.nt = nt; u.offA = (size_t)pm * 256 * lda * 2; u.offB = (size_t)pn * 256 * ldb * 2; return true;
    }
};
struct EpiX1 {
    static constexpr bool PERM = true, AFTER_DRAIN = false;
    const float* X; bf16* X1B; float* SSQP;
    __device__ __forceinline__ bool keep(const pg8::Unit&) const { return false; }
    __device__ __forceinline__ void operator()(pg8::Acc& acc, const pg8::Unit& u, int wr, int wc, int fr, int fq) const {
        const int row0 = u.pm * 256 + wr * 64 + fr, col0 = u.pn * 256 + wc * 32 + 8 * fq;
#pragma unroll
        for (int ai = 0; ai < 2; ++ai)
#pragma unroll
            for (int m = 0; m < 4; ++m) { const int row = row0 + ai * 128 + m * 16; const size_t off = (size_t)row * DM + col0; float ssq = 0.f;
                const f32x4 xl[2][2] = {{*(const f32x4*)(X + off), *(const f32x4*)(X + off + 4)}, {*(const f32x4*)(X + off + 128), *(const f32x4*)(X + off + 132)}};
#pragma unroll
                for (int bj = 0; bj < 2; ++bj) { const f32x4 v0 = xl[bj][0] + acc[ai][bj][m][0], v1 = xl[bj][1] + acc[ai][bj][m][1];
                    ssq += (v0[0] * v0[0] + v0[1] * v0[1]) + (v0[2] * v0[2] + v0[3] * v0[3]) + (v1[0] * v1[0] + v1[1] * v1[1]) + (v1[2] * v1[2] + v1[3] * v1[3]);
                    u32x4 w; w.x = pg8::cvt_pk_bf16(v0[0], v0[1]); w.y = pg8::cvt_pk_bf16(v0[2], v0[3]); w.z = pg8::cvt_pk_bf16(v1[0], v1[1]); w.w = pg8::cvt_pk_bf16(v1[2], v1[3]);
                    *(u32x4*)(X1B + off + bj * 128) = w; }
                ssq += other16(ssq); ssq += other32(ssq);
                if (fq == 0) SSQP[(size_t)row * 16 + u.pn * 4 + wc] = ssq; }
    }
};
__device__ __forceinline__ void phase_x1(Frame& F) {
    pg8::Gemm g{(const bf16*)(F.ws + WS_MERGED), (const bf16*)(F.ws + WS_WOUT), 1024, 1024};
    EpiX1 E{F.in[I_X], (bf16*)(F.ws + WS_X1B), (float*)(F.ws + WS_SSQP)};
    SchedPlain S{F.G, (int)blockIdx.x, 4, 16, 1024, 1024};
    run_gemm(F.lds, g, S, E);
}

__device__ __forceinline__ void cls_experts(int cls, int& ea, int& eb) { const int g = cls / 6, p = cls % 6; const int a = p < 3 ? 0 : (p < 5 ? 1 : 2), b = p < 3 ? p + 1 : (p < 5 ? p - 1 : 3); ea = g * 4 + a; eb = g * 4 + b; }
__device__ __forceinline__ void phase_route1(Frame& F) {
    LAS float* lgt = (LAS float*)F.lds; LAS int* hist = (LAS int*)(F.lds + 64 * 33 * 4);
    const int blk = blockIdx.x, lane = F.lane, fr = lane & 15, fq = lane >> 4, rf = F.wave >> 1, cf = F.wave & 1;
    if (F.tid < NCLS) hist[F.tid] = 0;
    const bf16* Ap = (const bf16*)(F.ws + WS_X1B) + (size_t)(blk * 64 + rf * 16 + fr) * DM + fq * 8;
    const bf16* Bp = (const bf16*)(F.ws + WS_WRT) + (size_t)(cf * 16 + fr) * DM + fq * 8;
    f32x4 acc = {0.f, 0.f, 0.f, 0.f};
#pragma unroll 8
    for (int ks = 0; ks < 32; ++ks) { const bf16x8 a = *(const bf16x8*)(Ap + ks * 32), b = *(const bf16x8*)(Bp + ks * 32); acc = __builtin_amdgcn_mfma_f32_16x16x32_bf16(a, b, acc, 0, 0, 0); }
#pragma unroll
    for (int j = 0; j < 4; ++j) lgt[(rf * 16 + 4 * fq + j) * 33 + cf * 16 + fr] = acc[j];
    __syncthreads();
    int* CLS = (int*)(F.ws + WS_CLS); float* WTS = (float*)(F.ws + WS_WTS); const float* SSQP = (const float*)(F.ws + WS_SSQP);
    if (F.tid < 64) {
        const int m = blk * 64 + F.tid;
        const f32x4* sp = (const f32x4*)(SSQP + (size_t)m * 16); const f32x4 sa = sp[0], sb = sp[1], sc = sp[2], sd = sp[3];
        const float ssq = ((sa.x + sa.y + sa.z + sa.w) + (sb.x + sb.y + sb.z + sb.w)) + ((sc.x + sc.y + sc.z + sc.w) + (sd.x + sd.y + sd.z + sd.w));
        const float r = 1.0f / sqrtf(ssq * (1.f / DM) + EPS);
        float lg[20];
#pragma unroll
        for (int c = 0; c < 20; ++c) lg[c] = lgt[F.tid * 33 + c] * r + (c < 4 ? F.in[I_BRG][c] : F.in[I_BRE][c - 4]);
        int gs = 0;
#pragma unroll
        for (int c = 1; c < 4; ++c) if (lg[c] > lg[gs]) gs = c;
        float den = 0.f;
#pragma unroll
        for (int c = 0; c < 4; ++c) den += __expf(lg[c] - lg[gs]);
        const float gpw = 1.f / den;
        float el[4];
#pragma unroll
        for (int c = 0; c < 4; ++c) { float v0 = lg[4 + c];
#pragma unroll
            for (int g4 = 1; g4 < 4; ++g4) v0 = (gs == g4) ? lg[4 + g4 * 4 + c] : v0;
            el[c] = v0; }
        int i0 = 0;
#pragma unroll
        for (int c = 1; c < 4; ++c) if (el[c] > el[i0]) i0 = c;
        int i1 = (i0 == 0) ? 1 : 0;
#pragma unroll
        for (int c = 0; c < 4; ++c) if (c != i0 && el[c] > el[i1]) i1 = c;
        const float e1 = __expf(el[i1] - el[i0]), w0 = gpw / (1.f + e1), w1 = gpw * e1 / (1.f + e1);
        const int a = i0 < i1 ? i0 : i1, b = i0 < i1 ? i1 : i0; const float wa = i0 < i1 ? w0 : w1, wb = i0 < i1 ? w1 : w0;
        const int pair = (a == 0) ? (b - 1) : (a == 1 ? (b + 1) : 5);
        const int cls = gs * 6 + pair;
        CLS[m] = cls; *(f32x4*)(WTS + 4 * (size_t)m) = (f32x4){wa, wb, r, 0.f};
        atomicAdd((int*)hist + cls, 1);
    }
    __syncthreads();
    if (F.tid < NCLS) ((int*)(F.ws + WS_HIST))[blk * NCLS + F.tid] = hist[F.tid];
}

__device__ __forceinline__ void phase_route2(Frame& F) {
    LAS int* tot = (LAS int*)F.lds; LAS int* pre = tot + 32; LAS int* base = pre + 32; LAS int* lcls = base + 32; LAS int* lpos = lcls + 64;
    const int* HIST = (const int*)(F.ws + WS_HIST); const int blk = blockIdx.x;
    LAS int* hl = (LAS int*)(F.lds + 4096);
    for (int i = F.tid; i < 256 * NCLS; i += NWAVES * 64) hl[i] = HIST[i];
    __syncthreads();
    if (F.tid < NCLS) { int t = 0, p = 0; for (int b = 0; b < 256; ++b) { const int h = hl[b * NCLS + F.tid]; if (b < blk) p += h; t += h; } tot[F.tid] = t; pre[F.tid] = p; }
    __syncthreads();
    if (F.tid == 0) { int acc = 0; for (int c = 0; c < NCLS; ++c) { base[c] = acc; acc += ((tot[c] + 255) >> 8) << 8; } base[NCLS] = acc; }
    const int* CLS = (const int*)(F.ws + WS_CLS);
    if (F.tid < 64) lcls[F.tid] = CLS[blk * 64 + F.tid];
    __syncthreads();
    if (F.tid < 64) { const int c = lcls[F.tid]; int rank = 0; for (int j = 0; j < F.tid; ++j) rank += (lcls[j] == c) ? 1 : 0; lpos[F.tid] = base[c] + pre[c] + rank; }
    __syncthreads();
    int* PERM = (int*)(F.ws + WS_PERM); float* WPOS = (float*)(F.ws + WS_WPOS); const float* WTS = (const float*)(F.ws + WS_WTS);
    if (F.tid < 64) { const int m = blk * 64 + F.tid, pos = lpos[F.tid]; PERM[pos] = m; *(f32x4*)(WPOS + 4 * (size_t)pos) = *(const f32x4*)(WTS + 4 * (size_t)m); }
    if (blk == 0) {
        int* TILES = (int*)(F.ws + WS_TILES);
        if (F.tid == 0) { TILES[0] = base[NCLS] >> 8; }
        if (F.tid < NCLS) { const int c = F.tid; for (int t = base[c] >> 8; t < (base[c + 1] >> 8); ++t) TILES[1 + t] = c; }
        for (int c = 0; c < NCLS; ++c) { const int lo = base[c] + tot[c], hi = base[c + 1]; for (int p = lo + F.tid; p < hi; p += NWAVES * 64) { PERM[p] = -1; *(f32x4*)(WPOS + 4 * (size_t)p) = (f32x4){0.f, 0.f, 0.f, 0.f}; } }
    }
}

struct SchedMoeUp {
    int G, c; const int* TILES;
    __device__ __forceinline__ bool next(int i, pg8::Unit& u) const {
        const int nrt = TILES[0], L = i * G + c; if (L >= nrt * 8) return false;
        const int pm = L >> 3, pn = L & 7; int ea, eb; cls_experts(TILES[1 + pm], ea, eb); const int e = (pn < 4) ? ea : eb;
        u.pm = pm; u.pn = pn; u.aux = 0; u.nt = 16; u.sel = 0; u.offA = 0; u.offB = (size_t)(e * 1024 + 256 * (pn & 3)) * 1024 * 2; return true;
    }
    __device__ __forceinline__ void a_ready(const pg8::Unit&) const {}
};
struct SchedMoeDown {
    int G, c; const int* TILES; unsigned* cnt;
    __device__ __forceinline__ bool next(int i, pg8::Unit& u) const {
        const int nrt = TILES[0], n_up = nrt * 8, n_dn = nrt * 4;
        const int iu = c < n_up ? (n_up - c + G - 1) / G : 0;
        const int D = (iu + (i >> 1)) * G + c - n_up, sub = i & 1; if (D >= n_dn) return false;
        const int pm = D >> 2, pn = D & 3; int ea, eb; cls_experts(TILES[1 + pm], ea, eb); const int e = sub ? eb : ea;
        u.pm = pm; u.pn = pn; u.aux = 1 + sub; u.nt = 8; u.sel = 1; u.offA = (size_t)pm * 256 * 1024 * 2 + (sub ? 512 * 2 : 0); u.offB = (size_t)(e * 1024 + pn * 256) * 512 * 2; return true;
    }
    __device__ __forceinline__ void a_ready(const pg8::Unit& u) const {
        if (u.aux != 1) return;
        if (threadIdx.x < 64) { unsigned sp = 0;
            while ((unsigned)__builtin_amdgcn_readfirstlane(__hip_atomic_load(cnt + 64 * u.pm, __ATOMIC_RELAXED, __HIP_MEMORY_SCOPE_AGENT)) < 64u) { __builtin_amdgcn_s_sleep(2); if (++sp > (1u << 16)) break; }
            __builtin_amdgcn_fence(__ATOMIC_ACQUIRE, "agent");
            asm volatile("s_waitcnt vmcnt(0)" ::: "memory"); }
        asm volatile("" ::: "memory"); __builtin_amdgcn_s_barrier(); asm volatile("" ::: "memory");
    }
};
struct EpiMoe {
    static constexpr bool PERM = true, AFTER_DRAIN = false;
    const float* WPOS; bf16* HID; const int* PERMT; const bf16* X1B; bf16* X2B; unsigned* cnt;
    __device__ __forceinline__ bool keep(const pg8::Unit& u) const { return u.aux == 1; }
    __device__ __forceinline__ void operator()(pg8::Acc& acc, const pg8::Unit& u, int wr, int wc, int fr, int fq) const {
        if (u.aux == 1) return;
        if (u.aux == 0) {
            const int row0 = u.pm * 256 + wr * 64 + fr, col0 = u.pn * 128 + wc * 32 + 8 * fq, half = u.pn >> 2;
            const __amdgpu_buffer_rsrc_t rs = __builtin_amdgcn_make_buffer_rsrc((void*)HID, 0, MAXRT * 256 * 1024 * 2, 0x00020000);
            f32x4 wvs[2][4];
#pragma unroll
            for (int ai = 0; ai < 2; ++ai)
#pragma unroll
                for (int m = 0; m < 4; ++m) wvs[ai][m] = *(const f32x4*)(WPOS + 4 * (size_t)(row0 + ai * 128 + m * 16));
#pragma unroll
            for (int ai = 0; ai < 2; ++ai)
#pragma unroll
                for (int m = 0; m < 4; ++m) { const int pos = row0 + ai * 128 + m * 16; const f32x4 wv = wvs[ai][m]; const float w = half ? wv.y : wv.x, r = wv.z;
                    float h[8];
#pragma unroll
                    for (int n = 0; n < 2; ++n)
#pragma unroll
                        for (int j = 0; j < 4; ++j) { const float gt = r * acc[ai][0][m][n][j], up = r * acc[ai][1][m][n][j]; h[4 * n + j] = w * gt * sigmoidf_(gt) * up; }
                    u32x4 o; o.x = pg8::cvt_pk_bf16(h[0], h[1]); o.y = pg8::cvt_pk_bf16(h[2], h[3]); o.z = pg8::cvt_pk_bf16(h[4], h[5]); o.w = pg8::cvt_pk_bf16(h[6], h[7]);
                    __builtin_amdgcn_raw_buffer_store_b128(o, rs, (int)(((size_t)pos * 1024 + col0) * 2), 0, 16); }
            asm volatile("s_waitcnt vmcnt(0)" ::: "memory");
            if (fr == 0 && fq == 0) __hip_atomic_fetch_add(cnt + 64 * u.pm, 1u, __ATOMIC_RELAXED, __HIP_MEMORY_SCOPE_AGENT);
            return;
        }
        const int row0 = u.pm * 256 + wr * 64 + fr, col0 = u.pn * 256 + wc * 32 + 8 * fq;
        int toks[2][4];
#pragma unroll
        for (int ai = 0; ai < 2; ++ai)
#pragma unroll
            for (int m = 0; m < 4; ++m) toks[ai][m] = PERMT[row0 + ai * 128 + m * 16];
#pragma unroll
        for (int ai = 0; ai < 2; ++ai)
#pragma unroll
            for (int m = 0; m < 4; ++m) { const int tok = toks[ai][m]; if (tok < 0) continue; const size_t off = (size_t)tok * DM + col0;
                const u32x4 xws[2] = {*(const u32x4*)(X1B + off), *(const u32x4*)(X1B + off + 128)};
#pragma unroll
                for (int bj = 0; bj < 2; ++bj) { const u32x4 xw = xws[bj]; const f32x4 a0 = acc[ai][bj][m][0], a1 = acc[ai][bj][m][1];
                    u32x4 w; w.x = pg8::cvt_pk_bf16(bflo(xw.x) + a0[0], bfhi(xw.x) + a0[1]); w.y = pg8::cvt_pk_bf16(bflo(xw.y) + a0[2], bfhi(xw.y) + a0[3]);
                    w.z = pg8::cvt_pk_bf16(bflo(xw.z) + a1[0], bfhi(xw.z) + a1[1]); w.w = pg8::cvt_pk_bf16(bflo(xw.w) + a1[2], bfhi(xw.w) + a1[3]);
                    *(u32x4*)(X2B + off + bj * 128) = w; } }
    }
};
__device__ __forceinline__ void phase_up(Frame& F) {
    unsigned* cnt = (unsigned*)(F.ws + WS_CTL) + CW_MOE;
    pg8::Gemm2 g{(const bf16*)(F.ws + WS_X1B), (const bf16*)(F.ws + WS_WGU), 1024, 1024, (const bf16*)F.out, (const bf16*)(F.ws + WS_WD), 1024, 512, (const int*)(F.ws + WS_PERM)};
    EpiMoe E{(const float*)(F.ws + WS_WPOS), (bf16*)F.out, (const int*)(F.ws + WS_PERM), (const bf16*)(F.ws + WS_X1B), (bf16*)(F.ws + WS_X2B), cnt};
    SchedMoeUp SU{F.G, (int)blockIdx.x, (const int*)(F.ws + WS_TILES)};
    pg8::gemm_phase2(F.lds, g, SU, E);
    SchedMoeDown SD{F.G, (int)blockIdx.x, (const int*)(F.ws + WS_TILES), cnt};
    pg8::gemm_phase2(F.lds, g, SD, E);
}

struct EpiPleFinal {
    static constexpr bool PERM = false, AFTER_DRAIN = true;
    const bf16* X2B; const bf16* PP; const float* G; float* OUT; unsigned* xb; unsigned* cnt;
    __device__ __forceinline__ bool keep(const pg8::Unit&) const { return false; }
    __device__ __forceinline__ void fused(pg8::Acc& acc, const pg8::Unit& u, int wr, int wc, int fr, int fq, LAS unsigned char* lds, int wid, int lane) const {
        LAS float* P = (LAS float*)lds; LAS float* S = (LAS float*)(lds + 8192);
        const int row0 = u.pm * 256 + wr * 64 + fr, col0 = u.pn * 256 + wc * 32 + 4 * fq;
#pragma unroll
        for (int ai = 0; ai < 2; ++ai)
#pragma unroll
            for (int m = 0; m < 4; ++m) { const size_t off = (size_t)(row0 + ai * 128 + m * 16) * DM + col0; float s = 0.f;
                u32x2 xvs[2][2], pps[2][2];
#pragma unroll
                for (int bj = 0; bj < 2; ++bj)
#pragma unroll
                    for (int n = 0; n < 2; ++n) { xvs[bj][n] = *(const u32x2*)(X2B + off + bj * 128 + n * 16); pps[bj][n] = *(const u32x2*)(PP + off + bj * 128 + n * 16); }
#pragma unroll
                for (int bj = 0; bj < 2; ++bj)
#pragma unroll
                    for (int n = 0; n < 2; ++n) { const u32x2 xv = xvs[bj][n], pp = pps[bj][n]; const f32x4 a = acc[ai][bj][m][n];
                        f32x4 o; o[0] = bflo(xv.x) + sigmoidf_(a[0]) * bflo(pp.x); o[1] = bfhi(xv.x) + sigmoidf_(a[1]) * bfhi(pp.x); o[2] = bflo(xv.y) + sigmoidf_(a[2]) * bflo(pp.y); o[3] = bfhi(xv.y) + sigmoidf_(a[3]) * bfhi(pp.y);
                        acc[ai][bj][m][n] = o; s += (o[0] * o[0] + o[1] * o[1]) + (o[2] * o[2] + o[3] * o[3]); }
                s += other16(s); s += other32(s);
                if (fq == 0) P[(ai * 128 + wr * 64 + m * 16 + fr) * 4 + wc] = s; }
        asm volatile("s_waitcnt lgkmcnt(0)" ::: "memory"); __builtin_amdgcn_s_barrier(); asm volatile("" ::: "memory");
        const int row = wid * 32 + (lane & 31);
        if (lane < 32) { const f32x4 p4 = *(const LAS f32x4*)(P + row * 4); const float t = (p4.x + p4.y) + (p4.z + p4.w);
            __hip_atomic_store(xb + (size_t)(u.pm * 256 + row) * 4 + u.pn, __builtin_bit_cast(unsigned, t), __ATOMIC_RELAXED, __HIP_MEMORY_SCOPE_AGENT); }
        asm volatile("s_waitcnt vmcnt(0)" ::: "memory");
        if (lane == 0) __hip_atomic_fetch_add(cnt + 64 * u.pm, 1u, __ATOMIC_RELAXED, __HIP_MEMORY_SCOPE_AGENT);
        if (wid == 0) {
            unsigned sp = 0;
            while ((unsigned)__builtin_amdgcn_readfirstlane(__hip_atomic_load(cnt + 64 * u.pm, __ATOMIC_RELAXED, __HIP_MEMORY_SCOPE_AGENT)) < 32u) { __builtin_amdgcn_s_sleep(2); if (++sp > (1u << 22)) break; }
            __builtin_amdgcn_fence(__ATOMIC_ACQUIRE, "agent");
        }
        asm volatile("s_waitcnt vmcnt(0) lgkmcnt(0)" ::: "memory"); __builtin_amdgcn_s_barrier(); asm volatile("" ::: "memory");
        if (lane < 32) { float q = 0.f;
#pragma unroll
            for (int t = 0; t < 4; ++t) q += __builtin_bit_cast(float, __hip_atomic_load(xb + (size_t)(u.pm * 256 + row) * 4 + t, __ATOMIC_RELAXED, __HIP_MEMORY_SCOPE_AGENT));
            S[row] = 1.0f / sqrtf(q * (1.f / DM) + EPS); }
        asm volatile("s_waitcnt lgkmcnt(0)" ::: "memory"); __builtin_amdgcn_s_barrier(); asm volatile("" ::: "memory");
        f32x4 g4s[2][2];
#pragma unroll
        for (int bj = 0; bj < 2; ++bj)
#pragma unroll
            for (int n = 0; n < 2; ++n) g4s[bj][n] = *(const f32x4*)(G + col0 + bj * 128 + n * 16);
#pragma unroll
        for (int ai = 0; ai < 2; ++ai)
#pragma unroll
            for (int m = 0; m < 4; ++m) { const int r = ai * 128 + wr * 64 + m * 16 + fr; const float rs = S[r]; const size_t off = (size_t)(u.pm * 256 + r) * DM + col0;
#pragma unroll
                for (int bj = 0; bj < 2; ++bj)
#pragma unroll
                    for (int n = 0; n < 2; ++n) *(f32x4*)(OUT + off + bj * 128 + n * 16) = acc[ai][bj][m][n] * rs * g4s[bj][n]; }
    }
    __device__ __forceinline__ void operator()(pg8::Acc&, const pg8::Unit&, int, int, int, int) const {}
};
__device__ __forceinline__ void phase_ple(Frame& F) {
    pg8::Gemm g{(const bf16*)(F.ws + WS_X2B), (const bf16*)(F.ws + WS_WPG), 1024, 1024};
    EpiPleFinal E{(const bf16*)(F.ws + WS_X2B), (const bf16*)(F.ws + WS_PP), F.in[I_FING], F.out, (unsigned*)(F.ws + WS_XB), (unsigned*)(F.ws + WS_CTL) + CW_PANEL};
    SchedPlain S{F.G, (int)blockIdx.x, 4, 16, 1024, 1024};
    run_gemm(F.lds, g, S, E);
}

namespace att {
typedef float f32x16 __attribute__((ext_vector_type(16)));
typedef short s16x4 __attribute__((ext_vector_type(4)));
typedef short v4i16_t __attribute__((ext_vector_type(4)));
typedef LAS const unsigned char* lptr;
__device__ __forceinline__ int crow(int r, int hi) { return (r & 3) + 8 * (r >> 2) + 4 * hi; }
__device__ __forceinline__ s16x4 vtr(lptr p) { return __builtin_bit_cast(s16x4, __builtin_amdgcn_ds_read_tr16_b64_v4i16((LAS v4i16_t*)p)); }
__device__ __forceinline__ void dma16(const void* g, LAS unsigned char* l) { __builtin_amdgcn_global_load_lds((const unsigned*)g, (LAS unsigned*)l, 16, 0, 0); }
__device__ __forceinline__ float swap_other(float v) { float w = v; asm volatile("" : "+v"(w)); auto rr = __builtin_amdgcn_permlane32_swap(__builtin_bit_cast(unsigned, v), __builtin_bit_cast(unsigned, w), false, false);
    unsigned a = rr[0], b = rr[1]; asm volatile("" : "+v"(a), "+v"(b)); return (threadIdx.x & 32) ? __builtin_bit_cast(float, a) : __builtin_bit_cast(float, b); }
__device__ __forceinline__ float swap_add(float v) { return v + swap_other(v); }
__device__ __forceinline__ float swap_max(float v) { return fmaxf(v, swap_other(v)); }
#define ATT_PACK(P, B) ((u32x4){pg8::cvt_pk_bf16(P[B], P[B + 1]), pg8::cvt_pk_bf16(P[B + 2], P[B + 3]), pg8::cvt_pk_bf16(P[B + 4], P[B + 5]), pg8::cvt_pk_bf16(P[B + 6], P[B + 7])})
__device__ __forceinline__ void pv(f32x16 (&o)[2], lptr vimg, u32x4 pw0, u32x4 pw1, u32x4 pw2, u32x4 pw3) {
    const bf16x8 pa[4] = {__builtin_bit_cast(bf16x8, pw0), __builtin_bit_cast(bf16x8, pw1), __builtin_bit_cast(bf16x8, pw2), __builtin_bit_cast(bf16x8, pw3)};
#pragma unroll
    for (int d0 = 0; d0 < 2; ++d0)
#pragma unroll
        for (int ks = 0; ks < 4; ++ks) { const s16x4 lo = vtr(vimg + d0 * 4096 + ks * 1024), hh = vtr(vimg + d0 * 4096 + ks * 1024 + 512);
            const bf16x8 vb = (bf16x8){lo[0], lo[1], lo[2], lo[3], hh[0], hh[1], hh[2], hh[3]};
            o[d0] = __builtin_amdgcn_mfma_f32_32x32x16_bf16(pa[ks], vb, o[d0], 0, 0, 0); }
}

__device__ __forceinline__ void attn_unit(Frame& F, int b, int h, int qb) {
    const int lane = F.lane, r32 = lane & 31, hi = lane >> 5, wid = F.wave;
    const bf16* Q = (const bf16*)(F.ws + WS_Q); const bf16* K = (const bf16*)(F.ws + WS_K); const bf16* V = (const bf16*)(F.ws + WS_V);
#ifdef DBG_ATT
    bf16* O = (bf16*)(F.ws + WS_WCAT2); constexpr int OP = 512;
#else
    bf16* O = (bf16*)(F.ws + WS_ACAT); constexpr int OP = 1536;
#endif
    const size_t rowbase = (size_t)b * SEQ; const int q0 = qb * 256;
    const bf16* Kh = K + rowbase * AW + h * 64; const bf16* Vh = V + rowbase * AW + h * 64;
    LAS unsigned char* lds = F.lds;
    LAS float* wsf = (LAS float*)(lds + 65536 + wid * 256);
    const bf16* ksrc = Kh + (size_t)lane * AW + wid * 8;
    const bf16* vsrc = Vh + (size_t)(16 * (wid & 3) + (lane >> 2)) * AW + (wid >> 2) * 32 + (lane & 3) * 8;
#define ATT_DMA(t, s) do { dma16(ksrc + (size_t)(t) * 64 * AW, lds + (s) * 8192 + wid * 1024); dma16(vsrc + (size_t)(t) * 64 * AW, lds + 32768 + (s) * 8192 + wid * 1024); } while (0)
    ATT_DMA(0, 0); ATT_DMA(1, 1); ATT_DMA(2, 2);
    const bf16* Qw = Q + (rowbase + q0 + wid * 32 + r32) * AW + h * 64;
    bf16x8 qr[4];
#pragma unroll
    for (int d0 = 0; d0 < 4; ++d0) qr[d0] = *(const bf16x8*)(Qw + d0 * 16 + hi * 8);
    LAS float* kml = (LAS float*)(lds + 100352);
    kml[F.tid] = ((const float*)(F.ws + WS_KMEAN))[(size_t)((b * AH + h) * NBLK) * 64 + F.tid];
    unsigned sel = 0;
    const float sl2 = exp2f(-(float)(h + 1)) * LOG2E;
    float mhat = 0.f; f32x16 o[2], ol; o[0] = f32x16{}; o[1] = f32x16{}; ol = f32x16{};
    const int NT = 4 * (qb + 1), qloc = wid * 32 + r32;
    const lptr vp0 = (lptr)lds + 32768 + ((lane >> 4) & 1) * 32 + (lane & 3) * 8 + (4 * hi + ((lane & 15) >> 2)) * 64;
    const lptr kp0 = (lptr)lds + hi * 1024 + r32 * 16;
    const bf16x8 ones = {0x3F80, 0x3F80, 0x3F80, 0x3F80, 0x3F80, 0x3F80, 0x3F80, 0x3F80};
    constexpr float THR = 8.f;
    if (wid >= 4) __builtin_amdgcn_s_setprio(1);
    for (int t = 0; t < NT; ++t) {
        const int s = t & 3;
        if (t + 2 < NT) asm volatile("s_waitcnt vmcnt(4)" ::: "memory"); else if (t + 1 < NT) asm volatile("s_waitcnt vmcnt(2)" ::: "memory"); else asm volatile("s_waitcnt vmcnt(0)" ::: "memory");
        asm volatile("s_waitcnt lgkmcnt(0)" ::: "memory"); __builtin_amdgcn_s_barrier(); asm volatile("" ::: "memory");
        if (t + 3 < NT) ATT_DMA(t + 3, (t + 3) & 3);
        if (t == 0) {
            if (qb <= 3) sel = (1u << qb) - 1u;
            else {
                float g[8];
#pragma unroll
                for (int kb2 = 0; kb2 < 8; ++kb2) { float a = -INFINITY;
                    if (kb2 < qb) { a = 0.f;
#pragma unroll
                        for (int d0 = 0; d0 < 4; ++d0) { const f32x4 k0 = *(const LAS f32x4*)(kml + kb2 * 64 + d0 * 16 + hi * 8), k1 = *(const LAS f32x4*)(kml + kb2 * 64 + d0 * 16 + hi * 8 + 4);
                            const u32x4 qq = __builtin_bit_cast(u32x4, qr[d0]);
                            a += bflo(qq.x) * k0.x + bfhi(qq.x) * k0.y + bflo(qq.y) * k0.z + bfhi(qq.y) * k0.w + bflo(qq.z) * k1.x + bfhi(qq.z) * k1.y + bflo(qq.w) * k1.z + bfhi(qq.w) * k1.w; }
                        a = swap_add(a); }
                    g[kb2] = a; }
#pragma unroll
                for (int r = 0; r < 3; ++r) { int best = -1; float bv = -INFINITY;
#pragma unroll
                    for (int kb2 = 0; kb2 < 8; ++kb2) if (kb2 < qb && !((sel >> kb2) & 1u) && g[kb2] > bv) { bv = g[kb2]; best = kb2; }
                    if (best >= 0) sel |= 1u << best; }
            }
        }
        const int kb = t >> 2, jb = t & 3; const bool own = (kb == qb);
        if (!(own && (64 * jb > wid * 32 + 31))) {
            const bool lane_on = own || ((sel >> kb) & 1u);
            const float t0 = lane_on ? sl2 * (float)(64 * t + 4 * hi - (q0 + qloc)) - mhat : -INFINITY;
            f32x16 p0, p1;
#pragma unroll
            for (int r = 0; r < 16; ++r) { const float c = (float)((r & 3) + 8 * (r >> 2)); float a0, a1;
                asm("v_add_f32 %0, %1, %2" : "=v"(a0) : "v"(sl2 * c), "v"(t0)); asm("v_add_f32 %0, %1, %2" : "=v"(a1) : "v"(sl2 * (c + 32.f)), "v"(t0)); p0[r] = a0; p1[r] = a1; }
#pragma unroll
            for (int d0 = 0; d0 < 4; ++d0) { const bf16x8 b0 = *(const LAS bf16x8*)(kp0 + s * 8192 + d0 * 2048), b1 = *(const LAS bf16x8*)(kp0 + s * 8192 + d0 * 2048 + 512);
                p0 = __builtin_amdgcn_mfma_f32_32x32x16_bf16(b0, qr[d0], p0, 0, 0, 0); p1 = __builtin_amdgcn_mfma_f32_32x32x16_bf16(b1, qr[d0], p1, 0, 0, 0); }
            if (own && (64 * jb + 63 > wid * 32)) {
#pragma unroll
                for (int r = 0; r < 16; ++r) { const int kv = 64 * jb + crow(r, hi); if (kv > qloc) p0[r] = -INFINITY; if (kv + 32 > qloc) p1[r] = -INFINITY; } }
            int rmi = max(__float_as_int(p0[0]), __float_as_int(p1[0]));
#pragma unroll
            for (int r = 1; r < 16; ++r) rmi = max(max(rmi, __float_as_int(p0[r])), __float_as_int(p1[r]));
            rmi = max(rmi, __builtin_bit_cast(int, swap_other(__builtin_bit_cast(float, rmi))));
            const float rm = __builtin_bit_cast(float, rmi);
            if (__any(rm > THR)) {
                const float dl = fmaxf(rm, 0.f), f = __builtin_amdgcn_exp2f(-dl);
                mhat += dl;
#pragma unroll
                for (int r = 0; r < 16; ++r) { p0[r] -= dl; p1[r] -= dl; }
                if (hi == 0) wsf[r32] = f;
                asm volatile("" ::: "memory");
#pragma unroll
                for (int r = 0; r < 16; ++r) { const float fr = wsf[crow(r, hi)]; o[0][r] *= fr; o[1][r] *= fr; ol[r] *= fr; }
            }
#pragma unroll
            for (int r = 0; r < 16; ++r) { p0[r] = __builtin_amdgcn_exp2f(p0[r]); p1[r] = __builtin_amdgcn_exp2f(p1[r]); }
            const u32x4 pw0 = ATT_PACK(p0, 0), pw1 = ATT_PACK(p0, 8), pw2 = ATT_PACK(p1, 0), pw3 = ATT_PACK(p1, 8);
            pv(o, vp0 + s * 8192, pw0, pw1, pw2, pw3);
            ol = __builtin_amdgcn_mfma_f32_32x32x16_bf16(__builtin_bit_cast(bf16x8, pw0), ones, ol, 0, 0, 0); ol = __builtin_amdgcn_mfma_f32_32x32x16_bf16(__builtin_bit_cast(bf16x8, pw1), ones, ol, 0, 0, 0);
            ol = __builtin_amdgcn_mfma_f32_32x32x16_bf16(__builtin_bit_cast(bf16x8, pw2), ones, ol, 0, 0, 0); ol = __builtin_amdgcn_mfma_f32_32x32x16_bf16(__builtin_bit_cast(bf16x8, pw3), ones, ol, 0, 0, 0);
        }
    }
#undef ATT_DMA
    __builtin_amdgcn_s_setprio(0);
    LAS bf16* stg = (LAS bf16*)(lds + 67584 + wid * 4096);
#pragma unroll
    for (int r = 0; r < 16; ++r) { const int orow = crow(r, hi); const float rl = __builtin_amdgcn_rcpf(ol[r]);
        stg[orow * 64 + r32] = (bf16)f2bf(o[0][r] * rl); stg[orow * 64 + 32 + r32] = (bf16)f2bf(o[1][r] * rl); }
    asm volatile("s_waitcnt lgkmcnt(0)" ::: "memory");
    bf16* Ow = O + (rowbase + q0 + wid * 32) * OP + h * 64;
#pragma unroll
    for (int i = 0; i < 4; ++i) { const int row = i * 8 + (lane >> 3), ch = lane & 7; const u32x4 v = *(const LAS u32x4*)(stg + row * 64 + ch * 8); *(u32x4*)(Ow + (size_t)row * OP + ch * 8) = v; }
    asm volatile("s_waitcnt lgkmcnt(0)" ::: "memory"); __builtin_amdgcn_s_barrier(); asm volatile("" ::: "memory");
}

__device__ __forceinline__ void ssd_state_unit(Frame& F, int b, int j, int nh) {
    const int lane = F.lane, r32 = lane & 31, hi = lane >> 5, wid = F.wave, tid = F.tid, g = j >> 3;
    const bf16* XA = (const bf16*)(F.ws + WS_XBCACT); const float* DT = (const float*)(F.ws + WS_DT); const float* CS = (const float*)(F.ws + WS_CS); bf16* ST = (bf16*)(F.ws + WS_STATES);
    LAS unsigned char* lds = F.lds;
    const int pb = (wid >> 1) & 1, nbl = wid & 1;
    const int vpoff = ((lane >> 4) & 1) * 32 + (lane & 3) * 8 + (4 * hi + ((lane & 15) >> 2)) * 64;
    const int l = tid >> 1, dh = tid & 1;
    f32x16 hst = f32x16{};
#define SST_BDMA(c, buf) do { const size_t rc_ = (size_t)b * SEQ + (c) * 256; _Pragma("unroll") for (int tt = 0; tt < 4; ++tt) \
        dma16(XA + (rc_ + 64 * tt + 16 * (wid & 3) + (lane >> 2)) * CONVD + 1024 + g * 128 + nh * 64 + (wid >> 2) * 32 + (lane & 3) * 8, lds + 65536 + (buf) * 32768 + tt * 8192 + wid * 1024); } while (0)
    u32x4 xw[4]; float dtl, csl_, cse;
#define SST_XLOAD(c) do { const size_t rc_ = (size_t)b * SEQ + (c) * 256; const u32x4* src_ = (const u32x4*)(XA + (rc_ + l) * CONVD + j * 64 + dh * 32); \
        xw[0] = src_[0]; xw[1] = src_[1]; xw[2] = src_[2]; xw[3] = src_[3]; dtl = DT[(rc_ + l) * 16 + j]; csl_ = CS[(rc_ + l) * 16 + j]; cse = CS[(rc_ + 255) * 16 + j]; } while (0)
    SST_BDMA(0, 0); SST_XLOAD(0);
    for (int c = 0; c < NCH; ++c) {
        const int buf = c & 1;
        const float cs_end = cse;
        { const float sc = dtl * __expf(cs_end - csl_);
            LAS unsigned char* dst = lds + buf * 32768 + (l >> 6) * 8192 + dh * 4096 + ((l & 63) >> 4) * 1024 + (l & 15) * 64;
#pragma unroll
            for (int pc = 0; pc < 4; ++pc) { u32x4 w = xw[pc];
                w.x = pk2(bflo(w.x) * sc, bfhi(w.x) * sc); w.y = pk2(bflo(w.y) * sc, bfhi(w.y) * sc); w.z = pk2(bflo(w.z) * sc, bfhi(w.z) * sc); w.w = pk2(bflo(w.w) * sc, bfhi(w.w) * sc);
                *(LAS u32x4*)(dst + pc * 16) = w; } }
        __syncthreads();
        if (c + 1 < NCH) { SST_BDMA(c + 1, buf ^ 1); SST_XLOAD(c + 1); }
        if (wid < 4) {
            bf16* stp = ST + ((size_t)(((b * NCH + c) * SH + j) * 64 + 32 * pb)) * 128 + nh * 64 + 32 * nbl + r32;
#pragma unroll
            for (int r = 0; r < 16; ++r) stp[(size_t)crow(r, hi) * 128] = (bf16)f2bf(hst[r]);
            f32x16 acc = f32x16{};
#pragma unroll
            for (int tt = 0; tt < 4; ++tt)
#pragma unroll
                for (int ks = 0; ks < 4; ++ks) {
                    const lptr xa = (lptr)lds + buf * 32768 + tt * 8192 + pb * 4096 + ks * 1024 + vpoff, ba = (lptr)lds + 65536 + buf * 32768 + tt * 8192 + nbl * 4096 + ks * 1024 + vpoff;
                    const s16x4 alo = vtr(xa), ahi = vtr(xa + 512), blo = vtr(ba), bhi_ = vtr(ba + 512);
                    const bf16x8 av = (bf16x8){alo[0], alo[1], alo[2], alo[3], ahi[0], ahi[1], ahi[2], ahi[3]}, bv = (bf16x8){blo[0], blo[1], blo[2], blo[3], bhi_[0], bhi_[1], bhi_[2], bhi_[3]};
                    acc = __builtin_amdgcn_mfma_f32_32x32x16_bf16(av, bv, acc, 0, 0, 0); }
            const float dec = __expf(cs_end);
#pragma unroll
            for (int r = 0; r < 16; ++r) hst[r] = hst[r] * dec + acc[r];
        }
    }
    __syncthreads();
#undef SST_BDMA
#undef SST_XLOAD
}

__device__ __forceinline__ void ssd_y_group(Frame& F, int b, int c, int j0) {
    const int lane = F.lane, r32 = lane & 31, hi = lane >> 5, wid = F.wave, tid = F.tid, g = j0 >> 3;
    const bf16* XA = (const bf16*)(F.ws + WS_XBCACT); const float* DT = (const float*)(F.ws + WS_DT); const float* CS = (const float*)(F.ws + WS_CS); const bf16* ST = (const bf16*)(F.ws + WS_STATES);
    const bf16* Z = (const bf16*)(F.ws + WS_Z); bf16* O = (bf16*)(F.ws + WS_ACAT); float* SUMSQ = (float*)(F.ws + WS_SUMSQ);
    LAS unsigned char* lds = F.lds;
    const size_t rowc = (size_t)b * SEQ + c * 256;
#define SSY_XDMA(j, buf) do { _Pragma("unroll") for (int tt = 0; tt < 4; ++tt) \
        dma16(XA + (rowc + 64 * tt + 16 * (wid & 3) + (lane >> 2)) * CONVD + (j) * 64 + (wid >> 2) * 32 + (lane & 3) * 8, lds + 65536 + (buf) * 32768 + tt * 8192 + wid * 1024); } while (0)
#define SSY_TAB(j, buf) do { if (tid < 256) { LAS float* tb_ = (LAS float*)(lds + 131072 + (buf) * 2048); const float c_ = CS[(rowc + tid) * 16 + (j)] * LOG2E; tb_[tid] = c_; tb_[256 + tid] = c_ - __builtin_amdgcn_logf(DT[(rowc + tid) * 16 + (j)]); } } while (0)
#pragma unroll
    for (int tt = 0; tt < 4; ++tt) {
        dma16(XA + (rowc + 64 * tt + lane) * CONVD + 1024 + g * 128 + wid * 8, lds + tt * 16384 + wid * 1024);
        dma16(XA + (rowc + 64 * tt + lane) * CONVD + 1024 + g * 128 + (wid + 8) * 8, lds + tt * 16384 + (wid + 8) * 1024);
    }
#define SSY_HDMA(j) do { const bf16* hs_ = ST + ((size_t)(((b * NCH + c) * SH + (j)) * 64 + lane)) * 128; dma16(hs_ + wid * 8, lds + 135168 + wid * 1024); dma16(hs_ + (wid + 8) * 8, lds + 135168 + (wid + 8) * 1024); } while (0)
    SSY_HDMA(j0);
    SSY_XDMA(j0, 0); SSY_XDMA(j0 + 1, 1); SSY_TAB(j0, 0); SSY_TAB(j0 + 1, 1);
    bf16x8 qr[8];
    const int qblk = wid < 4 ? wid : 11 - wid;
    const bf16* Cw = XA + (rowc + qblk * 32 + r32) * CONVD + 1280 + g * 128 + hi * 8;
#pragma unroll
    for (int d0 = 0; d0 < 8; ++d0) qr[d0] = *(const bf16x8*)(Cw + d0 * 16);
    const int lq = qblk * 32 + r32, tq = qblk >> 1;
    const lptr kp0 = (lptr)lds + hi * 1024 + r32 * 16;
#pragma unroll 1
    for (int hh = 0; hh < 4; ++hh) {
        const int j = j0 + hh, buf = hh & 1;
        LAS float* csl = (LAS float*)(lds + 131072 + buf * 2048); LAS float* dtt = csl + 256;
        f32x16 o[2]; o[0] = f32x16{}; o[1] = f32x16{};
        __syncthreads();
        { const lptr hp = (lptr)lds + 135168 + hi * 1024 + r32 * 16;
#pragma unroll
            for (int ks = 0; ks < 8; ++ks) { const bf16x8 h0 = *(const LAS bf16x8*)(hp + ks * 2048), h1 = *(const LAS bf16x8*)(hp + ks * 2048 + 512);
                o[0] = __builtin_amdgcn_mfma_f32_32x32x16_bf16(qr[ks], h0, o[0], 0, 0, 0); o[1] = __builtin_amdgcn_mfma_f32_32x32x16_bf16(qr[ks], h1, o[1], 0, 0, 0); } }
#pragma unroll
        for (int r = 0; r < 16; ++r) { const float e = __builtin_amdgcn_exp2f(csl[qblk * 32 + crow(r, hi)]); o[0][r] *= e; o[1][r] *= e; }
        const float cq = csl[lq];
        u32x4 xvs[4], zvs[4];
#pragma unroll
        for (int i = 0; i < 4; ++i) { const size_t m = rowc + qblk * 32 + i * 8 + (lane >> 3); xvs[i] = *(const u32x4*)(XA + m * CONVD + j * 64 + (lane & 7) * 8); zvs[i] = *(const u32x4*)(Z + m * DM + j * 64 + (lane & 7) * 8); }
        const lptr vp0 = (lptr)lds + 65536 + buf * 32768 + ((lane >> 4) & 1) * 32 + (lane & 3) * 8 + (4 * hi + ((lane & 15) >> 2)) * 64;
        for (int t = 0; t <= tq; ++t) {
            f32x16 p0 = f32x16{}, p1 = f32x16{};
#pragma unroll
            for (int d0 = 0; d0 < 8; ++d0) { const bf16x8 b0 = *(const LAS bf16x8*)(kp0 + t * 16384 + d0 * 2048), b1 = *(const LAS bf16x8*)(kp0 + t * 16384 + d0 * 2048 + 512);
                p0 = __builtin_amdgcn_mfma_f32_32x32x16_bf16(b0, qr[d0], p0, 0, 0, 0); p1 = __builtin_amdgcn_mfma_f32_32x32x16_bf16(b1, qr[d0], p1, 0, 0, 0); }
#pragma unroll
            for (int g4 = 0; g4 < 4; ++g4) { const f32x4 w0 = *(const LAS f32x4*)(dtt + 64 * t + 4 * hi + 8 * g4), w1 = *(const LAS f32x4*)(dtt + 64 * t + 32 + 4 * hi + 8 * g4);
#pragma unroll
                for (int e = 0; e < 4; ++e) { const int r = 4 * g4 + e; p0[r] *= __builtin_amdgcn_exp2f(cq - w0[e]); p1[r] *= __builtin_amdgcn_exp2f(cq - w1[e]); } }
            if (t == tq) {
#pragma unroll
                for (int r = 0; r < 16; ++r) { const int s0 = 64 * t + crow(r, hi); if (s0 > lq) p0[r] = 0.f; if (s0 + 32 > lq) p1[r] = 0.f; } }
            pv(o, vp0 + t * 8192, ATT_PACK(p0, 0), ATT_PACK(p0, 8), ATT_PACK(p1, 0), ATT_PACK(p1, 8));
        }
        __syncthreads();
        if (hh + 1 < 4) SSY_HDMA(j + 1);
        LAS bf16* stg = (LAS bf16*)(lds + 65536 + buf * 32768 + wid * 4096);
#pragma unroll
        for (int r = 0; r < 16; ++r) { const int orow = crow(r, hi); stg[orow * 64 + r32] = (bf16)f2bf(o[0][r]); stg[orow * 64 + 32 + r32] = (bf16)f2bf(o[1][r]); }
        asm volatile("s_waitcnt lgkmcnt(0)" ::: "memory");
        const float dsk = F.in[I_DSKIP][j];
#pragma unroll
        for (int i = 0; i < 4; ++i) { const int row = i * 8 + (lane >> 3), ch = lane & 7; const size_t m = rowc + qblk * 32 + row;
            const u32x4 yv = *(const LAS u32x4*)(stg + row * 64 + ch * 8);
            const u32x4 xv = xvs[i], zv = zvs[i];
            const float y[8] = {bflo(yv.x), bfhi(yv.x), bflo(yv.y), bfhi(yv.y), bflo(yv.z), bfhi(yv.z), bflo(yv.w), bfhi(yv.w)};
            const float x[8] = {bflo(xv.x), bfhi(xv.x), bflo(xv.y), bfhi(xv.y), bflo(xv.z), bfhi(xv.z), bflo(xv.w), bfhi(xv.w)};
            const float z[8] = {bflo(zv.x), bfhi(zv.x), bflo(zv.y), bfhi(zv.y), bflo(zv.z), bfhi(zv.z), bflo(zv.w), bfhi(zv.w)};
            float u[8]; float ss = 0.f;
#pragma unroll
            for (int e = 0; e < 8; ++e) { u[e] = (y[e] + dsk * x[e]) * z[e] * sigmoidf_(z[e]); ss += u[e] * u[e]; }
            ss += dpp_f<0xB1>(ss); ss += dpp_f<0x4E>(ss); ss += dpp_f<0x141>(ss);
            if (ch == 0) SUMSQ[m * 16 + j] = ss;
            u32x4 w; w.x = pk2(u[0], u[1]); w.y = pk2(u[2], u[3]); w.z = pk2(u[4], u[5]); w.w = pk2(u[6], u[7]);
            *(u32x4*)(O + m * 1536 + 512 + j * 64 + ch * 8) = w; }
        asm volatile("s_waitcnt lgkmcnt(0)" ::: "memory"); __builtin_amdgcn_s_barrier(); asm volatile("" ::: "memory");
        if (hh + 2 < 4) { SSY_XDMA(j + 2, buf); SSY_TAB(j + 2, buf); }
    }
#undef SSY_XDMA
#undef SSY_TAB
#undef SSY_HDMA
}
}

#ifndef FAST_ATTN
#define FAST_ATTN 1
#endif
#ifndef FAST_SSD
#define FAST_SSD 1
#endif
__device__ __forceinline__ void phase_attn(Frame& F) {
    const int v = F.vcu;
#ifndef DUP_PART
#define DUP_PART 0
#endif
    if (!(F.live == 0.f && DUP_PART == 2)) att::ssd_state_unit(F, v >> 5, (v >> 1) & 15, v & 1);
    if (!(F.live == 0.f && DUP_PART == 1)) { const int bh = v >> 2, s = v & 3; att::attn_unit(F, bh >> 3, bh & 7, s); att::attn_unit(F, bh >> 3, bh & 7, 7 - s); }
}
__device__ __forceinline__ void phase_ssdy(Frame& F) {
#if FAST_SSD
    { const int u = F.vcu * 4; att::ssd_y_group(F, u >> 7, (u >> 4) & 7, u & 15); }
#endif
}

__global__ void __launch_bounds__(256) attn_naive(const bf16* __restrict__ Q, const bf16* __restrict__ K, const bf16* __restrict__ V, const float* __restrict__ KM, bf16* __restrict__ ACAT) {
    const int blk = blockIdx.x, qb = blk % NBLK, h = (blk / NBLK) % AH, b = blk / (NBLK * AH);
    const int t = qb * 256 + threadIdx.x; const size_t row = (size_t)b * SEQ + t;
    float q[64];
#pragma unroll
    for (int d = 0; d < 64; d += 2) { const unsigned w = *(const unsigned*)(Q + row * AW + h * 64 + d); q[d] = bflo(w); q[d + 1] = bfhi(w); }
    unsigned sel = 0;
    if (qb <= 3) sel = (1u << qb) - 1u;
    else {
        float g[8];
#pragma unroll
        for (int kb = 0; kb < 8; ++kb) { float a = 0.f; if (kb < qb) {
#pragma unroll
                for (int d = 0; d < 64; ++d) a += q[d] * KM[(size_t)((b * AH + h) * NBLK + kb) * 64 + d]; } else a = -INFINITY; g[kb] = a; }
#pragma unroll
        for (int r = 0; r < 3; ++r) { int best = -1; float bv = -INFINITY;
#pragma unroll
            for (int kb = 0; kb < 8; ++kb) if (kb < qb && !((sel >> kb) & 1u) && g[kb] > bv) { bv = g[kb]; best = kb; }
            if (best >= 0) sel |= 1u << best; }
    }
    const float sl2 = exp2f(-(float)(h + 1)) * LOG2E;
    float mx = -1e30f, l = 0.f; float o[64];
#pragma unroll
    for (int d = 0; d < 64; ++d) o[d] = 0.f;
    for (int kb = 0; kb <= qb; ++kb) {
        const bool act = (kb == qb) || ((sel >> kb) & 1u);
        for (int j = 0; j < 256; ++j) {
            const int tk = kb * 256 + j; const size_t krow = (size_t)b * SEQ + tk;
            float s = 0.f;
#pragma unroll
            for (int d = 0; d < 64; d += 2) { const unsigned w = *(const unsigned*)(K + krow * AW + h * 64 + d); s += q[d] * bflo(w) + q[d + 1] * bfhi(w); }
            s -= sl2 * (float)(t - tk);
            const bool ok = act && (tk <= t);
            if (ok) {
                const float mn = fmaxf(mx, s), f = exp2f(mx - mn), p = exp2f(s - mn);
                l = l * f + p;
#pragma unroll
                for (int d = 0; d < 64; d += 2) { const unsigned w = *(const unsigned*)(V + krow * AW + h * 64 + d); o[d] = o[d] * f + p * bflo(w); o[d + 1] = o[d + 1] * f + p * bfhi(w); }
                mx = mn;
            }
        }
    }
    const float rl = 1.f / l;
#pragma unroll
    for (int d = 0; d < 64; d += 2) *(unsigned*)(ACAT + row * 1536 + h * 64 + d) = pk2(o[d] * rl, o[d + 1] * rl);
}

__global__ void __launch_bounds__(64) ssd_naive(const bf16* __restrict__ XA, const float* __restrict__ DT, const bf16* __restrict__ Z, const float* __restrict__ ALOG, const float* __restrict__ DSKIP,
                                                bf16* __restrict__ ACAT, float* __restrict__ SUMSQ) {
    const int b = blockIdx.x / SH, j = blockIdx.x % SH, p = threadIdx.x, g = j / 8;
    const float a = -__expf(ALOG[j]), dsk = DSKIP[j];
    float hst[128];
#pragma unroll
    for (int n = 0; n < 128; ++n) hst[n] = 0.f;
    for (int t = 0; t < SEQ; ++t) {
        const size_t row = (size_t)b * SEQ + t;
        const float dt = DT[row * 16 + j], dA = __expf(dt * a);
        const float x = bf2f(XA[row * CONVD + j * 64 + p]), dtx = dt * x;
        const bf16* Bp = XA + row * CONVD + 1024 + g * 128; const bf16* Cp = XA + row * CONVD + 1280 + g * 128;
        float y = 0.f;
#pragma unroll
        for (int n = 0; n < 128; n += 2) { const unsigned bw = *(const unsigned*)(Bp + n), cw = *(const unsigned*)(Cp + n);
            hst[n] = hst[n] * dA + dtx * bflo(bw); y += bflo(cw) * hst[n];
            hst[n + 1] = hst[n + 1] * dA + dtx * bfhi(bw); y += bfhi(cw) * hst[n + 1]; }
        y += dsk * x;
        const float zz = bf2f(Z[row * DM + j * 64 + p]);
        const float u = y * zz * sigmoidf_(zz);
        ACAT[row * 1536 + 512 + j * 64 + p] = (bf16)f2bf(u);
        const float ss = wave_sum(u * u);
        if (p == 0) SUMSQ[row * 16 + j] = ss;
    }
}


#ifdef DBG_ATT
__global__ void dbg_cmp(const bf16* __restrict__ A, const bf16* __restrict__ Bf, float* acc) {
    float d2 = 0.f, n2 = 0.f;
    for (size_t i = (size_t)blockIdx.x * blockDim.x + threadIdx.x; i < (size_t)M * 512; i += (size_t)gridDim.x * blockDim.x) {
        const size_t row = i / 512; const int col = (int)(i % 512), h = col / 64, qb = (int)((row % SEQ) / 256);
        bool on = true;
        if (DBG_ATT == 1) on = qb == 0; else if (DBG_ATT == 2) on = qb >= 1 && qb <= 3; else if (DBG_ATT == 3) on = qb >= 4; else if (DBG_ATT >= 10) on = (h == DBG_ATT - 10);
        if (!on) continue;
        const float a = bf2f(A[row * 1536 + col]), b = bf2f(Bf[row * 512 + col]);
        d2 += (a - b) * (a - b); n2 += a * a;
    }
    d2 = wave_sum(d2); n2 = wave_sum(n2);
    if ((threadIdx.x & 63) == 0) { atomicAdd(acc, d2); atomicAdd(acc + 1, n2); }
}
__global__ void dbg_apply(float* out, const float* acc) {
    const float m = sqrtf(acc[0] / fmaxf(acc[1], 1e-30f));
    for (size_t i = (size_t)blockIdx.x * blockDim.x + threadIdx.x; i < (size_t)M * DM; i += (size_t)gridDim.x * blockDim.x) out[i] *= (1.f + m);
}
#endif
enum { PH_PROLOGUE = 0, PH_PROJ, PH_CONV, PH_ATTN, PH_SSDY, PH_MERGE, PH_X1, PH_ROUTE1, PH_ROUTE2, PH_UP, PH_PLE, PH_COUNT };

__global__ void __launch_bounds__(NWAVES * 64, 2) mk_fwd(Args args) {
    extern __shared__ __attribute__((aligned(16))) unsigned char lds[];
    Frame F;
    F.lds = (LAS unsigned char*)lds;
    F.tid = threadIdx.x; F.lane = F.tid & 63; F.wave = __builtin_amdgcn_readfirstlane(F.tid >> 6);
    F.G = gridDim.x; { const int bx = blockIdx.x; F.vcu = (F.G % 8 == 0) ? (bx % 8) * (F.G / 8) + bx / 8 : bx; }
    F.in = args.in; F.out = args.out; F.ws = args.ws; F.pscale = 1.f; F.live = 1.f;
    volatile LAS unsigned* MISC = (volatile LAS unsigned*)(F.lds + MISC_OFF);
    if (F.tid < 32) MISC[F.tid] = 0u;
    __syncthreads();
    XcdBarrier bar = xcd_barrier_post((unsigned*)(args.ws + WS_CTL) + CW_BAR + args.li * XCD_BAR_WORDS, MISC + 8);
    const int lo = args.ph_lo, hi = args.ph_hi;
#define IN(k) (lo <= (k) && (k) < hi)
#ifdef PROBE_T
    unsigned long long ts[PH_COUNT + 1];
#define STAMP(k) ts[k] = __builtin_amdgcn_s_memrealtime()
#else
#define STAMP(k) do {} while (0)
#endif
#define SEAM(k) do { if (IN(k) && IN((k) + 1)) xcd_barrier(bar); STAMP((k) + 1); } while (0)
#ifndef DUPMASK
#define DUPMASK 0
#endif
#define DUP(k, call) do { if ((DUPMASK >> (k)) & 1) { xcd_barrier(bar); F.live = 0.f; call; F.live = 1.f; } } while (0)
    STAMP(0);
    if (IN(PH_PROLOGUE)) { phase_prologue(F); DUP(PH_PROLOGUE, phase_prologue(F)); } SEAM(PH_PROLOGUE);
    if (IN(PH_PROJ)) { phase_proj(F); DUP(PH_PROJ, phase_proj(F)); } SEAM(PH_PROJ);
    if (IN(PH_CONV)) { phase_conv(F); DUP(PH_CONV, phase_conv(F)); } SEAM(PH_CONV);
    if (IN(PH_ATTN)) { phase_attn(F); DUP(PH_ATTN, phase_attn(F)); } SEAM(PH_ATTN);
    if (IN(PH_SSDY)) { phase_ssdy(F); DUP(PH_SSDY, phase_ssdy(F)); phase_norm(F); } SEAM(PH_SSDY);
    if (IN(PH_MERGE)) { phase_merge(F); DUP(PH_MERGE, phase_merge(F)); } SEAM(PH_MERGE);
    if (IN(PH_X1)) { phase_x1(F); DUP(PH_X1, phase_x1(F)); } SEAM(PH_X1);
    if (IN(PH_ROUTE1)) { phase_route1(F); DUP(PH_ROUTE1, phase_route1(F)); } SEAM(PH_ROUTE1);
    if (IN(PH_ROUTE2)) { phase_route2(F); DUP(PH_ROUTE2, phase_route2(F)); } SEAM(PH_ROUTE2);
    if (IN(PH_UP)) { phase_up(F); } SEAM(PH_UP);
    if (IN(PH_PLE)) { phase_ple(F); DUP(PH_PLE, phase_ple(F)); }
#undef IN
#undef SEAM
}

extern "C" void kernel_launch(void* const* d_in, const int* in_sizes, int n_in, void* d_out, int out_size, void* d_ws, size_t ws_size, hipStream_t stream) {
    static int grid = 0;
    if (grid == 0) {
        if (n_in != 24 || out_size != M * DM || ws_size < WS_END) { fprintf(stderr, "kernel_launch: unexpected shapes n_in %d out %d ws %zu\n", n_in, out_size, ws_size); grid = -1; return; }
        int dev = 0, cus = 0, per_cu = 0;
        if (hipGetDevice(&dev) != hipSuccess || hipDeviceGetAttribute(&cus, hipDeviceAttributeMultiprocessorCount, dev) != hipSuccess) { grid = -1; return; }
        if (hipFuncSetAttribute((const void*)mk_fwd, hipFuncAttributeMaxDynamicSharedMemorySize, LDS_BYTES) != hipSuccess) { fprintf(stderr, "kernel_launch: hipFuncSetAttribute failed\n"); grid = -1; return; }
        if (hipOccupancyMaxActiveBlocksPerMultiprocessor(&per_cu, (const void*)mk_fwd, NWAVES * 64, LDS_BYTES) != hipSuccess || per_cu < 1) { fprintf(stderr, "kernel_launch: occupancy query says %d\n", per_cu); grid = -1; return; }
        (void)hipGetLastError();
        grid = cus;
        if (grid != 256) { fprintf(stderr, "kernel_launch: built for 256 CUs, device has %d\n", cus); grid = -1; return; }
    }
    if (grid < 0) return;
    hipMemsetAsync((char*)d_ws + WS_CTL, 0, CTL_ZERO_BYTES, stream);
    Args a{};
    for (int i = 0; i < 24; ++i) a.in[i] = (const float*)d_in[i];
    a.out = (float*)d_out; a.ws = (unsigned char*)d_ws;
    unsigned char* ws = (unsigned char*)d_ws;
    int li = 0;
    auto frame = [&](int lo, int hi) { a.ph_lo = lo; a.ph_hi = hi; a.li = li++; hipLaunchKernelGGL(mk_fwd, dim3(grid), dim3(NWAVES * 64), LDS_BYTES, stream, a); };
#ifdef DBG_ATT
    frame(PH_PROLOGUE, PH_SSDY);
    hipLaunchKernelGGL(attn_naive, dim3(NBATCH * AH * NBLK), dim3(256), 0, stream, (const bf16*)(ws + WS_Q), (const bf16*)(ws + WS_K), (const bf16*)(ws + WS_V), (const float*)(ws + WS_KMEAN), (bf16*)(ws + WS_ACAT));
    hipLaunchKernelGGL(ssd_naive, dim3(NBATCH * SH), dim3(64), 0, stream, (const bf16*)(ws + WS_XBCACT), (const float*)(ws + WS_DT), (const bf16*)(ws + WS_Z), (const float*)d_in[I_ALOG], (const float*)d_in[I_DSKIP],
                       (bf16*)(ws + WS_ACAT), (float*)(ws + WS_SUMSQ));
    hipLaunchKernelGGL(dbg_cmp, dim3(1024), dim3(256), 0, stream, (const bf16*)(ws + WS_ACAT), (const bf16*)(ws + WS_WCAT2), (float*)(ws + WS_CTL) + 64);
    frame(PH_SSDY, PH_COUNT);
    hipLaunchKernelGGL(dbg_apply, dim3(1024), dim3(256), 0, stream, (float*)d_out, (const float*)(ws + WS_CTL) + 64);
#elif FAST_ATTN && FAST_SSD
    frame(PH_PROLOGUE, PH_COUNT);
#else
    frame(PH_PROLOGUE, PH_SSDY);
#if !FAST_ATTN
    hipLaunchKernelGGL(attn_naive, dim3(NBATCH * AH * NBLK), dim3(256), 0, stream, (const bf16*)(ws + WS_Q), (const bf16*)(ws + WS_K), (const bf16*)(ws + WS_V), (const float*)(ws + WS_KMEAN), (bf16*)(ws + WS_ACAT));
#endif
#if !FAST_SSD
    hipLaunchKernelGGL(ssd_naive, dim3(NBATCH * SH), dim3(64), 0, stream, (const bf16*)(ws + WS_XBCACT), (const float*)(ws + WS_DT), (const bf16*)(ws + WS_Z), (const float*)d_in[I_ALOG], (const float*)d_in[I_DSKIP],
                       (bf16*)(ws + WS_ACAT), (float*)(ws + WS_SUMSQ));
#endif
    frame(PH_SSDY, PH_COUNT);
#endif
}
```

```cpp
#include <hip/hip_runtime.h>
#include <cstdio>
#include <cstdint>

#define LAS __attribute__((address_space(3)))
#define GAS __attribute__((address_space(1)))
typedef unsigned short bf16;
typedef short bf16x8 __attribute__((ext_vector_type(8)));
typedef float f32x4 __attribute__((ext_vector_type(4)));
typedef float f32x2 __attribute__((ext_vector_type(2)));
typedef unsigned u32x4 __attribute__((ext_vector_type(4)));
typedef unsigned u32x2 __attribute__((ext_vector_type(2)));

constexpr int M = 16384, DM = 1024, SEQ = 2048, NBATCH = 8;
constexpr int AH = 8, AD = 64, AW = 512, MBLK = 256, NBLK = 8;
constexpr int SH = 16, SPD = 64, SN = 128, CONVD = 1536, NCH = 8;
constexpr int NE = 16, FF = 512, NCLS = 24;
constexpr int PLE = 256;
constexpr int IN_DIM = 6160, OFF_DT = 4096, OFF_GA = 4112;
constexpr float EPS = 1e-6f;
constexpr float LOG2E = 1.4426950408889634f;
constexpr float C2 = 0.125f * LOG2E;
constexpr int MAXRT = 88;

constexpr size_t MiB = 1u << 20;
constexpr size_t WS_CTL = 0, CTL_ZERO_BYTES = 128 * 1024;
constexpr size_t WS_BCAT = 1 * MiB;
constexpr size_t WS_WOUT = 4 * MiB;
constexpr size_t WS_WPG = 6 * MiB;
constexpr size_t WS_DTRAW = 8 * MiB;
constexpr size_t WS_SSQP = 8 * MiB;
constexpr size_t WS_DT = 9 * MiB;
constexpr size_t WS_CS = 10 * MiB;
constexpr size_t WS_SUMSQ = 11 * MiB;
constexpr size_t WS_KMEAN = 12 * MiB;
constexpr size_t WS_CLS = 12 * MiB + 512 * 1024;
constexpr size_t WS_WTS = 12 * MiB + 768 * 1024;
constexpr size_t WS_HIST = 13 * MiB;
constexpr size_t WS_TILES = 13 * MiB + 256 * 1024;
constexpr size_t WS_PERM = 13 * MiB + 512 * 1024;
constexpr size_t WS_WRT = 13 * MiB + 768 * 1024;
constexpr size_t WS_WPOS = 14 * MiB;
constexpr size_t WS_XB = 15 * MiB;
constexpr size_t WS_RNORM = 15 * MiB + 512 * 1024;
constexpr size_t WS_Q = 16 * MiB, WS_K = 32 * MiB, WS_V = 48 * MiB;
constexpr size_t WS_X1B = 96 * MiB;
constexpr int X1P = 1536;
constexpr size_t WS_Z = 64 * MiB;
constexpr size_t WS_MERGED = 64 * MiB;
constexpr size_t WS_X2B = 64 * MiB;
constexpr size_t WS_XBC = 96 * MiB;
constexpr size_t WS_ACAT = 96 * MiB;
constexpr size_t WS_XS = 96 * MiB;
constexpr size_t WS_ACAT2 = 144 * MiB;
constexpr int AP2 = 1536;
constexpr size_t WS_XBCACT = 144 * MiB;
constexpr size_t WS_WGU = 16 * MiB;
constexpr size_t WS_WD = 48 * MiB;
constexpr size_t WS_PP = 192 * MiB;
constexpr size_t WS_WCAT2 = 224 * MiB;
constexpr size_t WS_STATES = 192 * MiB;
constexpr size_t WS_WPPT = 247 * MiB + 512 * 1024;
constexpr size_t WS_PB = 248 * MiB;
constexpr size_t WS_END = 256 * MiB;

constexpr int CW_BAR = 1024;
constexpr int CW_QKV = 4608;
constexpr int CW_XT = 6144;
constexpr int CW_PANEL = 8192;
constexpr int CW_MOE = 12288;

#define RLX_AGENT __ATOMIC_RELAXED, __HIP_MEMORY_SCOPE_AGENT
#define LDS_WAIT() asm volatile("s_waitcnt lgkmcnt(0)" ::: "memory")
#define VM_WAIT() asm volatile("s_waitcnt vmcnt(0)" ::: "memory")
__device__ __forceinline__ unsigned f2bf(float f) { unsigned u = __builtin_bit_cast(unsigned, f); return (u + 0x7fffu + ((u >> 16) & 1u)) >> 16; }
__device__ __forceinline__ unsigned pk2(float lo, float hi) { return f2bf(lo) | (f2bf(hi) << 16); }
__device__ __forceinline__ float bf2f(unsigned b) { return __builtin_bit_cast(float, b << 16); }
__device__ __forceinline__ float bflo(unsigned w) { return __builtin_bit_cast(float, w << 16); }
__device__ __forceinline__ float bfhi(unsigned w) { return __builtin_bit_cast(float, w & 0xffff0000u); }
__device__ __forceinline__ float sigmoidf_(float x) { return __builtin_amdgcn_rcpf(1.f + __builtin_amdgcn_exp2f(-x * LOG2E)); }
template <int CTRL> __device__ __forceinline__ float dpp_f(float v) { return __builtin_bit_cast(float, __builtin_amdgcn_update_dpp(0, __builtin_bit_cast(int, v), CTRL, 0xf, 0xf, true)); }
__device__ __forceinline__ float other32(float v) { float w = v; asm volatile("" : "+v"(w)); auto rr = __builtin_amdgcn_permlane32_swap(__builtin_bit_cast(unsigned, v), __builtin_bit_cast(unsigned, w), false, false);
    unsigned a = rr[0], b = rr[1]; asm volatile("" : "+v"(a), "+v"(b)); return (threadIdx.x & 32) ? __builtin_bit_cast(float, a) : __builtin_bit_cast(float, b); }
__device__ __forceinline__ float other16(float v) { float w = v; asm volatile("" : "+v"(w)); auto rr = __builtin_amdgcn_permlane16_swap(__builtin_bit_cast(unsigned, v), __builtin_bit_cast(unsigned, w), false, false);
    unsigned a = rr[0], b = rr[1]; asm volatile("" : "+v"(a), "+v"(b)); return (threadIdx.x & 16) ? __builtin_bit_cast(float, a) : __builtin_bit_cast(float, b); }
__device__ __forceinline__ float wave_sum(float v) {
    v += dpp_f<0xB1>(v); v += dpp_f<0x4E>(v); v += dpp_f<0x141>(v); v += dpp_f<0x140>(v);
    v += other16(v); v += other32(v);
    return v;
}

#define XB_TMO      128
#define XB_XCNT(j)  (256  + 64 * (j))
#define XB_XSUB(j)  (1280 + 64 * (j))
#define XB_XGEN(j)  (2304 + 64 * (j))
#define XB_TOP      3328
#define XB_TOPGEN   3392
#define XCD_BAR_WORDS 3456
#define XB_SPIN_CAP (1u << 20)
__device__ __forceinline__ unsigned xb_ld(unsigned* p)              { return __hip_atomic_load(p, __ATOMIC_RELAXED, __HIP_MEMORY_SCOPE_AGENT); }
__device__ __forceinline__ unsigned xb_add(unsigned* p, unsigned v) { return __hip_atomic_fetch_add(p, v, __ATOMIC_RELAXED, __HIP_MEMORY_SCOPE_AGENT); }
__device__ __forceinline__ unsigned xb_xcc_id() { return (unsigned)__builtin_amdgcn_s_getreg((3 << 11) | 20) & 0xFu; }
#define XB_SPIN(cond, bar) do { unsigned _sp = 0; while (cond) { __builtin_amdgcn_s_sleep(1); \
    if ((++_sp & 255u) == 0u) { if (xb_ld(&(bar)[XB_TMO])) break; if (_sp > XB_SPIN_CAP) { atomicAdd(&(bar)[XB_TMO], 1u); break; } } } } while (0)
struct XcdBarrier { unsigned* bar; unsigned x; volatile LAS unsigned* st; };
__device__ __forceinline__ XcdBarrier xcd_barrier_post(unsigned* bar, volatile LAS unsigned* st) {
    XcdBarrier b; b.bar = bar; b.x = xb_xcc_id(); b.st = st;
    if (threadIdx.x == 0) (void)xb_add(&bar[XB_XCNT(b.x)], 1u);
    return b;
}
__device__ __forceinline__ void xcd_barrier_complete(unsigned* bar, unsigned x, unsigned& nloc, unsigned& nx) {
    const unsigned G = gridDim.x * gridDim.y * gridDim.z;
    unsigned sum, cnt, mine, sp = 0u;
    for (;;) {
        sum = 0u; cnt = 0u; mine = 0u;
#pragma unroll
        for (unsigned j = 0; j < 16; ++j) { const unsigned c = xb_ld(&bar[XB_XCNT(j)]); sum += c; cnt += (c > 0u) ? 1u : 0u; mine = (j == x) ? c : mine; }
        if (sum == G) break;
        __builtin_amdgcn_s_sleep(1);
        if ((++sp & 255u) == 0u) { if (xb_ld(&bar[XB_TMO])) break; if (sp > XB_SPIN_CAP) { atomicAdd(&bar[XB_TMO], 1u); break; } }
    }
    nloc = mine > 0u ? mine : 1u; nx = cnt > 0u ? cnt : 1u;
}
__device__ __forceinline__ void xcd_barrier_core(const XcdBarrier& b, bool local = false) {
    if (threadIdx.x == 64) { __builtin_amdgcn_fence(__ATOMIC_ACQUIRE, "agent"); asm volatile("s_waitcnt vmcnt(0)" ::: "memory"); }
    if (threadIdx.x == 0) {
        unsigned* bar = b.bar;
        __builtin_amdgcn_s_waitcnt(0);
        unsigned nloc = b.st[0], nx = b.st[1];
        if (nloc == 0u) { xcd_barrier_complete(bar, b.x, nloc, nx); b.st[0] = nloc; b.st[1] = nx; }
        const unsigned old = xb_add(&bar[XB_XSUB(b.x)], 1u);
        const unsigned gen = old / nloc;
        if (old + 1u == (gen + 1u) * nloc && local) {
            xb_add(&bar[XB_XGEN(b.x)], 1u);
            asm volatile("s_waitcnt vmcnt(0)" ::: "memory");
        } else if (old + 1u == (gen + 1u) * nloc) {
            __builtin_amdgcn_fence(__ATOMIC_RELEASE, "agent");
            asm volatile("s_waitcnt vmcnt(0)" ::: "memory");
            const unsigned og = xb_add(&bar[XB_TOP], 1u);
            const unsigned tg = og / nx;
            if (og + 1u == (tg + 1u) * nx) xb_add(&bar[XB_TOPGEN], 1u);
            else XB_SPIN(xb_ld(&bar[XB_TOPGEN]) == tg, bar);
            xb_add(&bar[XB_XGEN(b.x)], 1u);
            asm volatile("s_waitcnt vmcnt(0)" ::: "memory");
        } else {
            XB_SPIN(xb_ld(&bar[XB_XGEN(b.x)]) == gen, bar);
            asm volatile("s_waitcnt vmcnt(0)" ::: "memory");
        }
    }
}
__device__ __forceinline__ void xcd_barrier(const XcdBarrier& b, bool local = false) {
    asm volatile("s_waitcnt vmcnt(0)" ::: "memory");
    __syncthreads();
    xcd_barrier_core(b, local);
    __syncthreads();
}

namespace pg8 {
constexpr int BM = 256, BK = 64, HALF = 128, HTB = HALF * BK * 2, STAGE_BYTES = 8 * HTB, NXCD = 8, WGM = 8;
__host__ __device__ __forceinline__ int lds_byte(int r, int c) { const int st = (r >> 4) * 2 + (c >> 5), rr = r & 15, cc = c & 31, ob = rr * 64 + cc * 2; return st * 1024 + (ob ^ (((ob >> 9) & 1) << 5)); }
__host__ __device__ __forceinline__ void stage_rc(int b, int& R, int& C) { const int st = b / 1024, sb = b % 1024, swz = sb ^ (((sb >> 9) & 1) << 5); R = (st >> 1) * 16 + swz / 64; C = (st & 1) * 32 + (swz % 64) / 2; }
__host__ __device__ __forceinline__ int perm32(int rho) { const int n = rho >> 4, i = rho & 15; return 8 * (i >> 2) + 4 * n + (i & 3); }

struct Unit { int pm, pn, aux, nt; size_t offA, offB; int sel; };
struct Gemm { const bf16* A; const bf16* Bt; int lda, ldb; };

__device__ __forceinline__ void tile_of(int L, int nM, int nN, int& pm, int& pn) {
    const int nwg = nM * nN; int wgid = L;
    { const int q = nwg / NXCD, r = nwg % NXCD, xcd = wgid % NXCD, off = wgid / NXCD; wgid = (xcd < r ? xcd * (q + 1) : r * (q + 1) + (xcd - r) * q) + off; }
    const int nig = WGM * nN, gid = wgid / nig, fm = gid * WGM, gsz = (nM - fm) < WGM ? (nM - fm) : WGM;
    pm = fm + ((wgid % nig) % gsz); pn = (wgid % nig) / gsz;
}
__device__ __forceinline__ unsigned cvt_pk_bf16(float lo, float hi) { unsigned r; asm volatile("v_cvt_pk_bf16_f32 %0, %1, %2" : "=v"(r) : "v"(lo), "v"(hi)); return r; }

typedef f32x4 Acc[2][2][4][2];

template <class Epi, class Sched>
__device__ __forceinline__ void gemm_simple(LAS unsigned char* lds, const Gemm g, const Sched& S, const Epi& E) {
    const int tid = threadIdx.x, wid = __builtin_amdgcn_readfirstlane(tid >> 6), lane = tid & 63, wr = wid >> 2, wc = wid & 3, fr = lane & 15, fq = lane >> 4;
    Unit cur; Acc acc;
#pragma unroll
    for (int a = 0; a < 2; ++a)
#pragma unroll
        for (int b = 0; b < 2; ++b)
#pragma unroll
            for (int m = 0; m < 4; ++m)
#pragma unroll
                for (int n = 0; n < 2; ++n) acc[a][b][m][n] = (f32x4){0.f, 0.f, 0.f, 0.f};
    for (int ui = 0; S.next(ui, cur); ++ui) {
        const char* cA = (const char*)g.A + cur.offA; const char* cB = (const char*)g.Bt + cur.offB;
        for (int kt = 0; kt < cur.nt * 2; ++kt) {
#pragma unroll
            for (int ai = 0; ai < 2; ++ai) {
                bf16x8 af[4];
#pragma unroll
                for (int m = 0; m < 4; ++m) af[m] = *(const bf16x8*)(cA + ((size_t)(ai * HALF + wr * 64 + m * 16 + fr) * g.lda + kt * 32 + fq * 8) * 2);
#pragma unroll
                for (int bj = 0; bj < 2; ++bj)
#pragma unroll
                    for (int n = 0; n < 2; ++n) {
                        const int rr = n * 16 + fr, br = bj * HALF + wc * 32 + (Epi::PERM ? perm32(rr) : rr);
                        const bf16x8 bfr = *(const bf16x8*)(cB + ((size_t)br * g.ldb + kt * 32 + fq * 8) * 2);
#pragma unroll
                        for (int m = 0; m < 4; ++m) acc[ai][bj][m][n] = __builtin_amdgcn_mfma_f32_16x16x32_bf16(bfr, af[m], acc[ai][bj][m][n], 0, 0, 0);
                    }
            }
        }
        if constexpr (Epi::AFTER_DRAIN) { __syncthreads(); E.fused(acc, cur, wr, wc, fr, fq, lds, wid, lane); } else E(acc, cur, wr, wc, fr, fq);
        if (!E.keep(cur)) {
#pragma unroll
            for (int a = 0; a < 2; ++a)
#pragma unroll
                for (int b = 0; b < 2; ++b)
#pragma unroll
                    for (int m = 0; m < 4; ++m)
#pragma unroll
                        for (int n = 0; n < 2; ++n) acc[a][b][m][n] = (f32x4){0.f, 0.f, 0.f, 0.f};
        }
    }
}

template <class Epi, class Sched, bool ALIGN_EPI = true, bool SP2 = true>
__device__ __forceinline__ void gemm_phase(LAS unsigned char* lds, const Gemm g, const Sched& S, const Epi& E) {
    const int tid = threadIdx.x, wid = __builtin_amdgcn_readfirstlane(tid >> 6), lane = tid & 63, wr = wid >> 2, wc = wid & 3, fr = lane & 15, fq = lane >> 4;
    unsigned voffA[2], voffB[2];
#pragma unroll
    for (int i = 0; i < 2; ++i) { int R, C; stage_rc(tid * 16 + i * 8192, R, C); const int Rb = Epi::PERM ? ((R & ~31) + perm32(R & 31)) : R;
        voffA[i] = (unsigned)(R * g.lda + C) * 2u; voffB[i] = (unsigned)(Rb * g.ldb + C) * 2u; }
    const size_t kstep = (size_t)(BK * 2);
    const size_t hstepA = (size_t)HALF * g.lda * 2, hstepB = (size_t)HALF * g.ldb * 2;
    const unsigned ldsw = (unsigned)wid * 1024u;
    const int aoff = lds_byte(wr * 64 + fr, fq * 8), boff = lds_byte(wc * 32 + fr, fq * 8);
#define PG8_SA(b, h) (((b) * 2 + (h)) * HTB)
#define PG8_SB(b, h) ((4 + (b) * 2 + (h)) * HTB)
#define PG8_STAGE(bufoff, gbase, voff) do { _Pragma("unroll") for (int _i = 0; _i < 2; ++_i) \
        __builtin_amdgcn_global_load_lds((const unsigned*)((const char*)(gbase) + (voff)[_i]), (LAS unsigned*)(lds + (bufoff) + ldsw + _i * 8192), 16, 0, 0); } while (0)
#define PG8_LDA(dst, b, h) do { _Pragma("unroll") for (int m = 0; m < 4; ++m) _Pragma("unroll") for (int k = 0; k < 2; ++k) dst[m][k] = *(const LAS bf16x8*)(lds + PG8_SA(b, h) + aoff + m * 2048 + k * 1024); } while (0)
#define PG8_LDB(dst, b, h) do { _Pragma("unroll") for (int n = 0; n < 2; ++n) _Pragma("unroll") for (int k = 0; k < 2; ++k) dst[n][k] = *(const LAS bf16x8*)(lds + PG8_SB(b, h) + boff + n * 2048 + k * 1024); } while (0)
#define PG8_MMA(ai, bj, At, Bt) do { __builtin_amdgcn_s_setprio(1); _Pragma("unroll") for (int m = 0; m < 4; ++m) _Pragma("unroll") for (int n = 0; n < 2; ++n) _Pragma("unroll") for (int k = 0; k < 2; ++k) \
        acc[ai][bj][m][n] = __builtin_amdgcn_mfma_f32_16x16x32_bf16(Bt[n][k], At[m][k], acc[ai][bj][m][n], 0, 0, 0); __builtin_amdgcn_s_setprio(0); } while (0)
#define PG8_WAIT_V(n) asm volatile("s_waitcnt vmcnt(" #n ")" ::: "memory")
#define PG8_WAIT_L(n) asm volatile("s_waitcnt lgkmcnt(" #n ")" ::: "memory")
#define PG8_BAR __builtin_amdgcn_s_barrier()
#define PG8_SCHED __builtin_amdgcn_sched_barrier(0)
    Unit cur, nxt; int ui = 0;
    if (!S.next(0, cur)) return;
    Acc acc;
#pragma unroll
    for (int a = 0; a < 2; ++a)
#pragma unroll
        for (int b = 0; b < 2; ++b)
#pragma unroll
            for (int m = 0; m < 4; ++m)
#pragma unroll
                for (int n = 0; n < 2; ++n) acc[a][b][m][n] = (f32x4){0.f, 0.f, 0.f, 0.f};
    bf16x8 At[4][2], B0[2][2], B1[2][2];
    const char* cA = (const char*)g.A + cur.offA; const char* cB = (const char*)g.Bt + cur.offB;
    if constexpr (SP2) {
        PG8_STAGE(PG8_SB(0, 0), cB, voffB); PG8_STAGE(PG8_SB(0, 1), cB + hstepB, voffB); PG8_STAGE(PG8_SA(0, 0), cA, voffA); PG8_STAGE(PG8_SA(0, 1), cA + hstepA, voffA);
        if (wr == 1) PG8_BAR;
        PG8_WAIT_V(2); PG8_BAR;
        PG8_STAGE(PG8_SB(1, 0), cB + kstep, voffB); PG8_STAGE(PG8_SA(1, 0), cA + kstep, voffA); PG8_STAGE(PG8_SB(1, 1), cB + hstepB + kstep, voffB);
        PG8_WAIT_V(6); PG8_BAR;
    } else {
        PG8_STAGE(PG8_SB(0, 0), cB, voffB); PG8_STAGE(PG8_SA(0, 0), cA, voffA); PG8_STAGE(PG8_SB(0, 1), cB + hstepB, voffB); PG8_STAGE(PG8_SA(0, 1), cA + hstepA, voffA);
        if (wr == 1) PG8_BAR;
        PG8_WAIT_V(4); PG8_BAR;
        PG8_STAGE(PG8_SB(1, 0), cB + kstep, voffB); PG8_STAGE(PG8_SA(1, 0), cA + kstep, voffA); PG8_STAGE(PG8_SB(1, 1), cB + hstepB + kstep, voffB);
        PG8_WAIT_V(6); PG8_BAR;
    }
    for (;;) {
        const bool has_next = S.next(ui + 1, nxt);
        const char* nA = has_next ? (const char*)g.A + nxt.offA : cA; const char* nB = has_next ? (const char*)g.Bt + nxt.offB : cB;
        const int nt = cur.nt;
        for (int t = 0; t < nt; t += 2) {
            const bool last = (t == nt - 2);
            const char* a1 = cA + (size_t)(t + 1) * kstep;
            const char* a2 = last ? nA : cA + (size_t)(t + 2) * kstep; const char* b2 = last ? nB : cB + (size_t)(t + 2) * kstep;
            const char* a3 = a2 + kstep; const char* b3 = b2 + kstep;
            if constexpr (SP2) {
            PG8_LDB(B0, 0, 0); PG8_LDB(B1, 0, 1); PG8_SCHED; PG8_LDA(At, 0, 0); PG8_STAGE(PG8_SA(1, 1), a1 + hstepA, voffA);
            PG8_WAIT_V(8); PG8_WAIT_L(0); PG8_BAR; PG8_MMA(0, 0, At, B0); PG8_MMA(0, 1, At, B1); PG8_BAR; PG8_SCHED;
            PG8_LDA(At, 0, 1); PG8_STAGE(PG8_SB(0, 0), b2, voffB); PG8_STAGE(PG8_SB(0, 1), b2 + hstepB, voffB); PG8_STAGE(PG8_SA(0, 0), a2, voffA);
            PG8_WAIT_V(8); PG8_WAIT_L(0); PG8_BAR; PG8_MMA(1, 0, At, B0); PG8_MMA(1, 1, At, B1); PG8_BAR; PG8_SCHED;
            PG8_LDB(B0, 1, 0); PG8_LDB(B1, 1, 1); PG8_SCHED; PG8_LDA(At, 1, 0); PG8_STAGE(PG8_SA(0, 1), a2 + hstepA, voffA);
            PG8_WAIT_V(8); PG8_WAIT_L(0); PG8_BAR; PG8_MMA(0, 0, At, B0); PG8_MMA(0, 1, At, B1); PG8_BAR; PG8_SCHED;
            PG8_LDA(At, 1, 1); PG8_STAGE(PG8_SB(1, 0), b3, voffB); PG8_STAGE(PG8_SB(1, 1), b3 + hstepB, voffB); PG8_STAGE(PG8_SA(1, 0), a3, voffA);
            PG8_WAIT_V(8); PG8_WAIT_L(0); PG8_BAR; PG8_MMA(1, 0, At, B0); PG8_MMA(1, 1, At, B1); PG8_BAR; PG8_SCHED;
            } else {
            PG8_LDB(B0, 0, 0); PG8_SCHED; PG8_LDA(At, 0, 0); PG8_STAGE(PG8_SA(1, 1), a1 + hstepA, voffA);
            PG8_WAIT_L(8); PG8_BAR; PG8_WAIT_L(0); PG8_MMA(0, 0, At, B0); PG8_BAR; PG8_SCHED;
            PG8_LDB(B1, 0, 1); PG8_STAGE(PG8_SB(0, 0), b2, voffB);
            PG8_BAR; PG8_WAIT_L(0); PG8_MMA(0, 1, At, B1); PG8_BAR;
            PG8_LDA(At, 0, 1); PG8_STAGE(PG8_SA(0, 0), a2, voffA);
            PG8_BAR; PG8_WAIT_L(0); PG8_MMA(1, 0, At, B0); PG8_BAR; PG8_SCHED;
            PG8_STAGE(PG8_SB(0, 1), b2 + hstepB, voffB);
            PG8_WAIT_V(6); PG8_BAR; PG8_MMA(1, 1, At, B1); PG8_BAR;
            PG8_LDB(B0, 1, 0); PG8_SCHED; PG8_LDA(At, 1, 0); PG8_STAGE(PG8_SA(0, 1), a2 + hstepA, voffA);
            PG8_WAIT_L(8); PG8_BAR; PG8_WAIT_L(0); PG8_MMA(0, 0, At, B0); PG8_BAR; PG8_SCHED;
            PG8_LDB(B1, 1, 1); PG8_STAGE(PG8_SB(1, 0), b3, voffB);
            PG8_BAR; PG8_WAIT_L(0); PG8_MMA(0, 1, At, B1); PG8_BAR;
            PG8_LDA(At, 1, 1); PG8_STAGE(PG8_SA(1, 0), a3, voffA);
            PG8_BAR; PG8_WAIT_L(0); PG8_MMA(1, 0, At, B0); PG8_BAR; PG8_SCHED;
            PG8_STAGE(PG8_SB(1, 1), b3 + hstepB, voffB);
            PG8_WAIT_V(6); PG8_BAR; PG8_MMA(1, 1, At, B1); PG8_BAR;
            }
        }
        if constexpr (ALIGN_EPI) { if (wr == 0) PG8_BAR; }
        if constexpr (!Epi::AFTER_DRAIN) E(acc, cur, wr, wc, fr, fq);
        if (!has_next) break;
        if (!E.keep(cur)) {
#pragma unroll
            for (int a = 0; a < 2; ++a)
#pragma unroll
                for (int b = 0; b < 2; ++b)
#pragma unroll
                    for (int m = 0; m < 4; ++m)
#pragma unroll
                        for (int n = 0; n < 2; ++n) acc[a][b][m][n] = (f32x4){0.f, 0.f, 0.f, 0.f};
        }
        cur = nxt; cA = nA; cB = nB; ++ui;
        if constexpr (ALIGN_EPI) { if (wr == 1) PG8_BAR; }
    }
    PG8_WAIT_V(0);
    if constexpr (!ALIGN_EPI) { if (wr == 0) PG8_BAR; }
    PG8_BAR;
    if constexpr (Epi::AFTER_DRAIN) E.fused(acc, cur, wr, wc, fr, fq, lds, wid, lane);
#undef PG8_SA
#undef PG8_SB
#undef PG8_STAGE
#undef PG8_LDA
#undef PG8_LDB
#undef PG8_MMA
#undef PG8_WAIT_V
#undef PG8_WAIT_L
#undef PG8_BAR
#undef PG8_SCHED
}
struct Gemm2 { const bf16* A0; const bf16* B0; int lda0, ldb0; const bf16* A1; const bf16* B1; int lda1, ldb1; const int* gather; };
template <class Epi, class Sched>
__device__ __forceinline__ void gemm_phase2(LAS unsigned char* lds, const Gemm2 g, const Sched& S, const Epi& E) {
    const int tid = threadIdx.x, wid = __builtin_amdgcn_readfirstlane(tid >> 6), lane = tid & 63, wr = wid >> 2, wc = wid & 3, fr = lane & 15, fq = lane >> 4;
    int RA[2], RB[2], CC[2];
#pragma unroll
    for (int i = 0; i < 2; ++i) { int R, C; stage_rc(tid * 16 + i * 8192, R, C); RA[i] = R; RB[i] = Epi::PERM ? ((R & ~31) + perm32(R & 31)) : R; CC[i] = C; }
    const size_t kstep = (size_t)(BK * 2);
    const unsigned ldsw = (unsigned)wid * 1024u;
    const int aoff = lds_byte(wr * 64 + fr, fq * 8), boff = lds_byte(wc * 32 + fr, fq * 8);
#define PG8_SA(b, h) (((b) * 2 + (h)) * HTB)
#define PG8_SB(b, h) ((4 + (b) * 2 + (h)) * HTB)
#define PG8_STAGE2(bufoff, gbase, v0, v1) do { \
        __builtin_amdgcn_global_load_lds((const unsigned*)((const char*)(gbase) + (v0)), (LAS unsigned*)(lds + (bufoff) + ldsw), 16, 0, 0); \
        __builtin_amdgcn_global_load_lds((const unsigned*)((const char*)(gbase) + (v1)), (LAS unsigned*)(lds + (bufoff) + ldsw + 8192), 16, 0, 0); } while (0)
#define PG8_LDA(dst, b, h) do { _Pragma("unroll") for (int m = 0; m < 4; ++m) _Pragma("unroll") for (int k = 0; k < 2; ++k) dst[m][k] = *(const LAS bf16x8*)(lds + PG8_SA(b, h) + aoff + m * 2048 + k * 1024); } while (0)
#define PG8_LDB(dst, b, h) do { _Pragma("unroll") for (int n = 0; n < 2; ++n) _Pragma("unroll") for (int k = 0; k < 2; ++k) dst[n][k] = *(const LAS bf16x8*)(lds + PG8_SB(b, h) + boff + n * 2048 + k * 1024); } while (0)
#define PG8_MMA(ai, bj, At, Bt) do { __builtin_amdgcn_s_setprio(1); _Pragma("unroll") for (int m = 0; m < 4; ++m) _Pragma("unroll") for (int n = 0; n < 2; ++n) _Pragma("unroll") for (int k = 0; k < 2; ++k) \
        acc[ai][bj][m][n] = __builtin_amdgcn_mfma_f32_16x16x32_bf16(Bt[n][k], At[m][k], acc[ai][bj][m][n], 0, 0, 0); __builtin_amdgcn_s_setprio(0); } while (0)
#define PG8_WAIT_V(n) asm volatile("s_waitcnt vmcnt(" #n ")" ::: "memory")
#define PG8_WAIT_L(n) asm volatile("s_waitcnt lgkmcnt(" #n ")" ::: "memory")
#define PG8_BAR __builtin_amdgcn_s_barrier()
#define PG8_SCHED __builtin_amdgcn_sched_barrier(0)
#define PG8_OPS(u, pA, pB, vA0, vA1, vA0h, vA1h, vB0, vB1, hA, hB) do { const int lda_ = (u).sel ? g.lda1 : g.lda0, ldb_ = (u).sel ? g.ldb1 : g.ldb0; \
        pA = (const char*)((u).sel ? g.A1 : g.A0) + (u).offA; pB = (const char*)((u).sel ? g.B1 : g.B0) + (u).offB; \
        vB0 = (unsigned)(RB[0] * ldb_ + CC[0]) * 2u; vB1 = (unsigned)(RB[1] * ldb_ + CC[1]) * 2u; hB = (size_t)HALF * ldb_ * 2; \
        if ((u).sel == 0 && g.gather) { const int* gp_ = g.gather + (u).pm * 256; int t0 = gp_[RA[0]], t1 = gp_[RA[1]], t2 = gp_[RA[0] + 128], t3 = gp_[RA[1] + 128]; \
            t0 = t0 < 0 ? 0 : t0; t1 = t1 < 0 ? 0 : t1; t2 = t2 < 0 ? 0 : t2; t3 = t3 < 0 ? 0 : t3; \
            vA0 = (unsigned)(t0 * lda_ + CC[0]) * 2u; vA1 = (unsigned)(t1 * lda_ + CC[1]) * 2u; vA0h = (unsigned)(t2 * lda_ + CC[0]) * 2u; vA1h = (unsigned)(t3 * lda_ + CC[1]) * 2u; hA = 0; } \
        else { vA0 = (unsigned)(RA[0] * lda_ + CC[0]) * 2u; vA1 = (unsigned)(RA[1] * lda_ + CC[1]) * 2u; vA0h = vA0; vA1h = vA1; hA = (size_t)HALF * lda_ * 2; } } while (0)
    Unit cur, nxt; int ui = 0, pend = -1;
    if (!S.next(0, cur)) return;
    Acc acc;
#pragma unroll
    for (int a = 0; a < 2; ++a)
#pragma unroll
        for (int b = 0; b < 2; ++b)
#pragma unroll
            for (int m = 0; m < 4; ++m)
#pragma unroll
                for (int n = 0; n < 2; ++n) acc[a][b][m][n] = (f32x4){0.f, 0.f, 0.f, 0.f};
    bf16x8 At[4][2], B0[2][2], B1[2][2];
    const char *cA, *cB; unsigned cvA0, cvA1, cvA0h, cvA1h, cvB0, cvB1; size_t chA, chB;
    PG8_OPS(cur, cA, cB, cvA0, cvA1, cvA0h, cvA1h, cvB0, cvB1, chA, chB);
    S.a_ready(cur);
    PG8_STAGE2(PG8_SB(0, 0), cB, cvB0, cvB1); PG8_STAGE2(PG8_SB(0, 1), cB + chB, cvB0, cvB1); PG8_STAGE2(PG8_SA(0, 0), cA, cvA0, cvA1); PG8_STAGE2(PG8_SA(0, 1), cA + chA, cvA0h, cvA1h);
    if (wr == 1) PG8_BAR;
    PG8_WAIT_V(2); PG8_BAR;
    PG8_STAGE2(PG8_SB(1, 0), cB + kstep, cvB0, cvB1); PG8_STAGE2(PG8_SA(1, 0), cA + kstep, cvA0, cvA1); PG8_STAGE2(PG8_SB(1, 1), cB + chB + kstep, cvB0, cvB1);
    PG8_WAIT_V(6); PG8_BAR;
    for (;;) {
        const bool has_next = S.next(ui + 1, nxt);
        const char *nA = cA, *nB = cB; unsigned nvA0 = cvA0, nvA1 = cvA1, nvA0h = cvA0h, nvA1h = cvA1h, nvB0 = cvB0, nvB1 = cvB1; size_t nhA = chA, nhB = chB;
        if (has_next) PG8_OPS(nxt, nA, nB, nvA0, nvA1, nvA0h, nvA1h, nvB0, nvB1, nhA, nhB);
        const int nt = cur.nt;
        for (int t = 0; t < nt; t += 2) {
            const bool last = (t == nt - 2);
            const char* a1 = cA + (size_t)(t + 1) * kstep;
            const char* a2 = last ? nA : cA + (size_t)(t + 2) * kstep; const char* b2 = last ? nB : cB + (size_t)(t + 2) * kstep;
            const char* a3 = a2 + kstep; const char* b3 = b2 + kstep;
            const unsigned sA0 = last ? nvA0 : cvA0, sA1 = last ? nvA1 : cvA1, sA0h = last ? nvA0h : cvA0h, sA1h = last ? nvA1h : cvA1h, sB0 = last ? nvB0 : cvB0, sB1 = last ? nvB1 : cvB1;
            const size_t hA2 = last ? nhA : chA, hB2 = last ? nhB : chB;
            if (last && has_next) S.a_ready(nxt);
            PG8_LDB(B0, 0, 0); PG8_LDB(B1, 0, 1); PG8_SCHED; PG8_LDA(At, 0, 0); PG8_STAGE2(PG8_SA(1, 1), a1 + chA, cvA0h, cvA1h);
            PG8_WAIT_V(8); PG8_WAIT_L(0); PG8_BAR; PG8_MMA(0, 0, At, B0); PG8_MMA(0, 1, At, B1); PG8_BAR; PG8_SCHED;
            PG8_LDA(At, 0, 1); PG8_STAGE2(PG8_SB(0, 0), b2, sB0, sB1); PG8_STAGE2(PG8_SB(0, 1), b2 + hB2, sB0, sB1); PG8_STAGE2(PG8_SA(0, 0), a2, sA0, sA1);
            PG8_WAIT_V(8);
            if (pend >= 0) { E.publish(pend, fr, fq); pend = -1; }
            PG8_WAIT_L(0); PG8_BAR; PG8_MMA(1, 0, At, B0); PG8_MMA(1, 1, At, B1); PG8_BAR; PG8_SCHED;
            PG8_LDB(B0, 1, 0); PG8_LDB(B1, 1, 1); PG8_SCHED; PG8_LDA(At, 1, 0); PG8_STAGE2(PG8_SA(0, 1), a2 + hA2, sA0h, sA1h);
            PG8_WAIT_V(8); PG8_WAIT_L(0); PG8_BAR; PG8_MMA(0, 0, At, B0); PG8_MMA(0, 1, At, B1); PG8_BAR; PG8_SCHED;
            PG8_LDA(At, 1, 1); PG8_STAGE2(PG8_SB(1, 0), b3, sB0, sB1); PG8_STAGE2(PG8_SB(1, 1), b3 + hB2, sB0, sB1); PG8_STAGE2(PG8_SA(1, 0), a3, sA0, sA1);
            PG8_WAIT_V(8); PG8_WAIT_L(0); PG8_BAR; PG8_MMA(1, 0, At, B0); PG8_MMA(1, 1, At, B1); PG8_BAR; PG8_SCHED;
        }
        if (wr == 0) PG8_BAR;
        E(acc, cur, wr, wc, fr, fq);
        if (E.defer(cur)) pend = cur.pm;
        if (!has_next) break;
        if (!E.keep(cur)) {
#pragma unroll
            for (int a = 0; a < 2; ++a)
#pragma unroll
                for (int b = 0; b < 2; ++b)
#pragma unroll
                    for (int m = 0; m < 4; ++m)
#pragma unroll
                        for (int n = 0; n < 2; ++n) acc[a][b][m][n] = (f32x4){0.f, 0.f, 0.f, 0.f};
        }
        cur = nxt; cA = nA; cB = nB; cvA0 = nvA0; cvA1 = nvA1; cvA0h = nvA0h; cvA1h = nvA1h; cvB0 = nvB0; cvB1 = nvB1; chA = nhA; chB = nhB; ++ui;
        if (wr == 1) PG8_BAR;
    }
    PG8_WAIT_V(0);
    if (pend >= 0) E.publish(pend, fr, fq);
    PG8_BAR;
#undef PG8_SA
#undef PG8_SB
#undef PG8_STAGE2
#undef PG8_LDA
#undef PG8_LDB
#undef PG8_MMA
#undef PG8_WAIT_V
#undef PG8_WAIT_L
#undef PG8_BAR
#undef PG8_SCHED
#undef PG8_OPS
}
}

#ifndef USE_FAST_GEMM
#define USE_FAST_GEMM 1
#endif
template <class Epi, class Sched>
__device__ __forceinline__ void run_gemm(LAS unsigned char* lds, const pg8::Gemm g, const Sched& S, const Epi& E) {
#if USE_FAST_GEMM
    pg8::gemm_phase<Epi, Sched, !Epi::AFTER_DRAIN, true>(lds, g, S, E);
#else
    pg8::gemm_simple<Epi, Sched>(lds, g, S, E);
#endif
}

constexpr int NWAVES = 8;
constexpr int RING_BYTES = 131072;
constexpr int LDS_BYTES = 163840;
constexpr int MISC_OFF = LDS_BYTES - 128;

struct Args {
    const float* in[24]; float* out; unsigned char* ws; int ph_lo, ph_hi, li, pad;
};
enum { I_X = 0, I_P, I_MIXG, I_WIN, I_CONVW, I_CONVB, I_DTB, I_ALOG, I_DSKIP, I_SSDG, I_WOA, I_WOB, I_WOUT, I_FFNG, I_WRG, I_BRG, I_WRE, I_BRE, I_WGATE, I_WUP, I_WDOWN, I_WPP, I_WPG, I_FING };

struct Frame {
    LAS unsigned char* lds;
    int tid, lane, wave, vcu, G;
    const float* const* in; float* out; unsigned char* ws; float pscale, live;
};

__device__ __forceinline__ void transpose_item(const float* W, int ldsrc, int k0, int c0, bf16* WT, int ldt, int r0, int kd0, LAS float* scr, int lane, const float* ks = nullptr, float cs = 1.f) {
    float wv[32];
#pragma unroll
    for (int i = 0; i < 32; ++i) wv[i] = __builtin_nontemporal_load(W + (size_t)(k0 + 2 * i + (lane >> 5)) * ldsrc + c0 + (lane & 31));
    if (cs != 1.f) {
#pragma unroll
        for (int i = 0; i < 32; ++i) wv[i] *= cs; }
    if (ks) {
#pragma unroll
        for (int i = 0; i < 32; ++i) wv[i] *= ks[k0 + 2 * i + (lane >> 5)]; }
#pragma unroll
    for (int i = 0; i < 32; ++i) scr[(2 * i + (lane >> 5)) * 33 + (lane & 31)] = wv[i];
    LDS_WAIT(); asm volatile("" ::: "memory");
    const int c = lane & 7;
#pragma unroll
    for (int j = 0; j < 4; ++j) { const int n = (lane >> 3) + 8 * j; const LAS float* s = scr + (8 * c) * 33 + n;
        u32x4 o; o.x = pk2(s[0 * 33], s[1 * 33]); o.y = pk2(s[2 * 33], s[3 * 33]); o.z = pk2(s[4 * 33], s[5 * 33]); o.w = pk2(s[6 * 33], s[7 * 33]);
        *(GAS u32x4*)(WT + (size_t)(r0 + n) * ldt + kd0 + k0 + 8 * c) = o; }
    LDS_WAIT(); asm volatile("" ::: "memory");
}

__device__ __forceinline__ void phase_prologue(Frame& F) {
    const int gw = F.vcu * NWAVES + F.wave, NGW = F.G * NWAVES;
    LAS float* scr = (LAS float*)(F.lds + F.wave * 8704);
    bf16* WCAT2 = (bf16*)(F.ws + WS_WCAT2); bf16* BCAT = (bf16*)(F.ws + WS_BCAT); bf16* WOUT = (bf16*)(F.ws + WS_WOUT); bf16* WPG = (bf16*)(F.ws + WS_WPG);
    constexpr int I0 = 16 * 128, I1 = 16 * 64, I2 = 4 * 32, I3 = 8 * 32, I4 = 16 * 32, I5 = 16 * 32, I6 = 16 * 32, NIT = I0 + I1 + I2 + I3 + I4 + I5 + I6;
    float wreg[32];
#pragma unroll
    for (int q = 0; q < 32; ++q) { const int i = F.tid + q * (NWAVES * 64); wreg[q] = F.in[I_WIN][(size_t)(i >> 4) * IN_DIM + OFF_DT + (i & 15)]; }
    for (int it = gw; it < NIT; it += NGW) {
        int r = it;
        if (r < I0) { transpose_item(F.in[I_WIN], IN_DIM, 64 * (r / 128), 32 * (r % 128), WCAT2, 1280, 32 * (r % 128), 0, scr, F.lane, nullptr, (r % 128) < 16 ? C2 : 1.f); continue; } r -= I0;
        if (r < I1) { transpose_item(F.in[I_WIN], IN_DIM, 64 * (r / 64), OFF_GA + 32 * (r % 64), WCAT2, 1280, 4096 + 32 * (r % 64), 0, scr, F.lane); continue; } r -= I1;
        if (r < I2) { transpose_item(F.in[I_WPP], DM, 64 * (r / 32), 32 * (r % 32), (bf16*)(F.ws + WS_WPPT), 256, 32 * (r % 32), 0, scr, F.lane); continue; } r -= I2;
        if (r < I3) { transpose_item(F.in[I_WOA], DM, 64 * (r / 32), 32 * (r % 32), BCAT, 1536, 32 * (r % 32), 0, scr, F.lane); continue; } r -= I3;
        if (r < I4) { transpose_item(F.in[I_WOB], DM, 64 * (r / 32), 32 * (r % 32), BCAT, 1536, 32 * (r % 32), 512, scr, F.lane, F.in[I_SSDG]); continue; } r -= I4;
        if (r < I5) { transpose_item(F.in[I_WOUT], DM, 64 * (r / 32), 32 * (r % 32), WOUT, 1024, 32 * (r % 32), 0, scr, F.lane); continue; } r -= I5;
        transpose_item(F.in[I_WPG], DM, 64 * (r / 32), 32 * (r % 32), WPG, 1024, 32 * (r % 32), 0, scr, F.lane);
    }
    { bf16* WRT = (bf16*)(F.ws + WS_WRT); const int gt = F.vcu * (NWAVES * 64) + F.tid;
      if (gt < 32 * 1024) { const int c = gt >> 10, k = gt & 1023; float v = c < 4 ? F.in[I_WRG][(size_t)k * 4 + c] : (c < 20 ? F.in[I_WRE][(size_t)k * 16 + c - 4] : 0.f); WRT[gt] = (bf16)f2bf(v * F.in[I_FFNG][k]); } }
    LAS bf16* WH = (LAS bf16*)(F.lds + 8 * 8704); LAS bf16* WL = WH + 16 * 1032;
#pragma unroll
    for (int q = 0; q < 32; ++q) { const int i = F.tid + q * (NWAVES * 64), k = i >> 4, c = i & 15; const float w = wreg[q];
        const unsigned h = f2bf(w); WH[c * 1032 + k] = (bf16)h; WL[c * 1032 + k] = (bf16)f2bf(w - __builtin_bit_cast(float, h << 16)); }
    LAS bf16* XL = (LAS bf16*)F.lds;
    __syncthreads();
    bf16* ACAT2 = (bf16*)(F.ws + WS_ACAT2); float* DTRAW = (float*)(F.ws + WS_DTRAW);
    const float* X = F.in[I_X]; const float* P = F.in[I_P]; const float* G = F.in[I_MIXG];
    for (int base = gw, trip = 0; base < M; base += 4 * NGW, ++trip) {
        f32x4 v[4][4]; float rs[4];
#pragma unroll
        for (int i = 0; i < 4; ++i) { const GAS f32x4* xr = (const GAS f32x4*)(X + (size_t)(base + i * NGW) * DM) + F.lane;
#pragma unroll
            for (int j = 0; j < 4; ++j) v[i][j] = __builtin_nontemporal_load(xr + 64 * j); }
        const f32x4 pv0 = *((const GAS f32x4*)(P + (size_t)(base + 0 * NGW) * PLE) + F.lane), pv1 = *((const GAS f32x4*)(P + (size_t)(base + 1 * NGW) * PLE) + F.lane),
                    pv2 = *((const GAS f32x4*)(P + (size_t)(base + 2 * NGW) * PLE) + F.lane), pv3 = *((const GAS f32x4*)(P + (size_t)(base + 3 * NGW) * PLE) + F.lane);
        f32x4 gg[4];
#pragma unroll
        for (int j = 0; j < 4; ++j) gg[j] = *((const GAS f32x4*)G + F.lane + 64 * j);
#pragma unroll
        for (int i = 0; i < 4; ++i) { float s = 0.f;
#pragma unroll
            for (int j = 0; j < 4; ++j) s += (v[i][j].x * v[i][j].x + v[i][j].y * v[i][j].y) + (v[i][j].z * v[i][j].z + v[i][j].w * v[i][j].w);
            rs[i] = 1.0f / sqrtf(wave_sum(s) * (1.f / DM) + EPS); }
        if (trip) { asm volatile("s_waitcnt lgkmcnt(0)" ::: "memory"); __builtin_amdgcn_s_barrier(); asm volatile("" ::: "memory"); }
#pragma unroll
        for (int i = 0; i < 4; ++i) { GAS unsigned long long* o8 = (GAS unsigned long long*)(ACAT2 + (size_t)(base + i * NGW) * AP2) + F.lane;
            LAS unsigned long long* l8 = (LAS unsigned long long*)(XL + (F.wave * 4 + i) * 1032) + F.lane;
#pragma unroll
            for (int j = 0; j < 4; ++j) { v[i][j] = v[i][j] * rs[i] * gg[j]; const unsigned long long pk = (unsigned long long)pk2(v[i][j].x, v[i][j].y) | ((unsigned long long)pk2(v[i][j].z, v[i][j].w) << 32); o8[64 * j] = pk; l8[64 * j] = pk; } }
        *((GAS unsigned long long*)((bf16*)(F.ws + WS_PB) + (size_t)(base + 0 * NGW) * 256) + F.lane) = (unsigned long long)pk2(pv0.x, pv0.y) | ((unsigned long long)pk2(pv0.z, pv0.w) << 32);
        *((GAS unsigned long long*)((bf16*)(F.ws + WS_PB) + (size_t)(base + 1 * NGW) * 256) + F.lane) = (unsigned long long)pk2(pv1.x, pv1.y) | ((unsigned long long)pk2(pv1.z, pv1.w) << 32);
        *((GAS unsigned long long*)((bf16*)(F.ws + WS_PB) + (size_t)(base + 2 * NGW) * 256) + F.lane) = (unsigned long long)pk2(pv2.x, pv2.y) | ((unsigned long long)pk2(pv2.z, pv2.w) << 32);
        *((GAS unsigned long long*)((bf16*)(F.ws + WS_PB) + (size_t)(base + 3 * NGW) * 256) + F.lane) = (unsigned long long)pk2(pv3.x, pv3.y) | ((unsigned long long)pk2(pv3.z, pv3.w) << 32);
        asm volatile("s_waitcnt lgkmcnt(0)" ::: "memory"); __builtin_amdgcn_s_barrier(); asm volatile("" ::: "memory");
        if (F.wave < 2) {
            const int fr = F.lane & 15, fq = F.lane >> 4;
            const LAS bf16* ap = XL + (16 * F.wave + fr) * 1032 + fq * 8; const LAS bf16* bh = WH + fr * 1032 + fq * 8; const LAS bf16* bl = WL + fr * 1032 + fq * 8;
            f32x4 acc = {0.f, 0.f, 0.f, 0.f};
#pragma unroll 8
            for (int ks = 0; ks < 32; ++ks) { const bf16x8 a = *(const LAS bf16x8*)(ap + ks * 32);
                acc = __builtin_amdgcn_mfma_f32_16x16x32_bf16(a, *(const LAS bf16x8*)(bh + ks * 32), acc, 0, 0, 0); acc = __builtin_amdgcn_mfma_f32_16x16x32_bf16(a, *(const LAS bf16x8*)(bl + ks * 32), acc, 0, 0, 0); }
#pragma unroll
            for (int j = 0; j < 4; ++j) DTRAW[(size_t)(F.vcu * NWAVES + 4 * F.wave + fq + (j + 4 * trip) * NGW) * 16 + fr] = acc[j];
        }
    }
    asm volatile("s_waitcnt lgkmcnt(0)" ::: "memory"); __builtin_amdgcn_s_barrier(); asm volatile("" ::: "memory");
}

struct EpiProj {
    static constexpr bool PERM = true, AFTER_DRAIN = false;
    bf16 *Q, *K, *V, *Z, *XBC, *GA, *GB, *PP;
    __device__ __forceinline__ bool keep(const pg8::Unit&) const { return false; }
    __device__ __forceinline__ void operator()(pg8::Acc& acc, const pg8::Unit& u, int wr, int wc, int fr, int fq) const {
        const int pn = u.pn; bf16* base; int ldc, colt; bool gate = false;
        if (pn < 2) { base = Q; ldc = 512; colt = pn * 256; }
        else if (pn < 4) { base = K; ldc = 512; colt = (pn - 2) * 256; }
        else if (pn < 6) { base = V; ldc = 512; colt = (pn - 4) * 256; }
        else if (pn < 10) { base = Z; ldc = 1024; colt = (pn - 6) * 256; }
        else if (pn < 16) { base = XBC; ldc = 1536; colt = (pn - 10) * 256; }
        else if (pn < 20) { base = GA; ldc = 1024; colt = (pn - 16) * 256; gate = true; }
        else if (pn < 24) { base = GB; ldc = 1024; colt = (pn - 20) * 256; gate = true; }
        else { base = PP; ldc = 1024; colt = (pn - 24) * 256; }
        char* bp = (char*)base;
        const unsigned off0 = (unsigned)((u.pm * 256 + wr * 64 + fr) * ldc + colt + wc * 32 + 8 * fq) * 2u, mstep = 32u * (unsigned)ldc, astep = 256u * (unsigned)ldc;
        if (gate) {
#pragma unroll
            for (int ai = 0; ai < 2; ++ai)
#pragma unroll
                for (int m = 0; m < 4; ++m) { const unsigned o = off0 + ai * astep + m * mstep;
#pragma unroll
                    for (int bj = 0; bj < 2; ++bj) { f32x4 v0 = acc[ai][bj][m][0], v1 = acc[ai][bj][m][1];
                        unsigned w0 = 0u, w1 = 0u;
#pragma unroll
                        for (int j = 0; j < 4; ++j) { w0 = __builtin_amdgcn_cvt_pk_u8_f32(fmaxf(__builtin_floorf(sigmoidf_(v0[j]) * 255.f + 0.5f), 1.f), j, w0); w1 = __builtin_amdgcn_cvt_pk_u8_f32(fmaxf(__builtin_floorf(sigmoidf_(v1[j]) * 255.f + 0.5f), 1.f), j, w1); }
                        { char* q = bp + (size_t)((o >> 1) + bj * 128); asm volatile("" : "+v"(q)); *(u32x2*)q = (u32x2){w0, w1}; } } }
        } else {
#pragma unroll
            for (int ai = 0; ai < 2; ++ai)
#pragma unroll
                for (int m = 0; m < 4; ++m) { const unsigned o = off0 + ai * astep + m * mstep;
#pragma unroll
                    for (int bj = 0; bj < 2; ++bj) { f32x4 v0 = acc[ai][bj][m][0], v1 = acc[ai][bj][m][1];
                        u32x4 w; w.x = pg8::cvt_pk_bf16(v0[0], v0[1]); w.y = pg8::cvt_pk_bf16(v0[2], v0[3]); w.z = pg8::cvt_pk_bf16(v1[0], v1[1]); w.w = pg8::cvt_pk_bf16(v1[2], v1[3]);
                        { char* q = bp + (size_t)(o + bj * 256); asm volatile("" : "+v"(q)); *(u32x4*)q = w; } } }
        }
    }
};
struct SchedProj {
    int G, c;
    __device__ __forceinline__ bool next(int i, pg8::Unit& u) const {
        const int L = i * G + c; constexpr int NP = 64 * 24, NQ = 0;
        if (L >= NP + NQ) return false;
        int pm, pn;
        if (L < NP) { pg8::tile_of(L, 64, 24, pm, pn); pn = pn >= 8 ? pn - 8 : pn + 16;
            u.pm = pm; u.pn = pn; u.aux = 0; u.sel = 0; u.nt = 16; u.offA = (size_t)pm * 256 * AP2 * 2; u.offB = (size_t)pn * 256 * 1280 * 2; }
        else { pg8::tile_of(L - NP, 64, 4, pm, pn); u.pm = pm; u.pn = 24 + pn; u.aux = 0; u.nt = 4; u.offA = (size_t)pm * 256 * AP2 * 2 + 1024 * 2; u.offB = (size_t)(6144 + pn * 256) * 1280 * 2 + 1024 * 2; }
        return true;
    }
};
__device__ __forceinline__ void phase_proj(Frame& F) {
    pg8::Gemm g{(const bf16*)(F.ws + WS_ACAT2), (const bf16*)(F.ws + WS_WCAT2), AP2, 1280};
    EpiProj E{(bf16*)(F.ws + WS_Q), (bf16*)(F.ws + WS_K), (bf16*)(F.ws + WS_V), (bf16*)(F.ws + WS_Z), (bf16*)(F.ws + WS_XBC), (bf16*)F.out, (bf16*)((unsigned char*)F.out + (size_t)M * DM), (bf16*)(F.ws + WS_PP)};
    SchedProj S{F.G, (int)blockIdx.x};
    run_gemm(F.lds, g, S, E);
}

__device__ __forceinline__ void phase_conv(Frame& F) {
    const int gt = F.vcu * (NWAVES * 64) + F.tid, NGT = F.G * NWAVES * 64;
    const bf16* XBC = (const bf16*)(F.ws + WS_XBC); bf16* XA = (bf16*)(F.ws + WS_XBCACT);
    const float* CW = F.in[I_CONVW]; const float* CB = F.in[I_CONVB];
    const int gwc = F.vcu * NWAVES + F.wave; const bool grid2k = (F.G * NWAVES == 2048);
    for (int it = grid2k ? (((gwc & 3) == 3) ? (CONVD / 8) * (M / 32) : (gwc - (gwc >> 2)) * 64 + F.lane) : gt; it < (CONVD / 8) * (M / 32); it += NGT) {
        const int c0 = (it % (CONVD / 8)) * 8, m0 = (it / (CONVD / 8)) * 32; const bool first = (m0 % SEQ) == 0;
        float w[4][8], bs[8], win[3][8];
#pragma unroll
        for (int k = 0; k < 4; ++k) { const f32x4 w0 = *(const GAS f32x4*)(CW + k * CONVD + c0), w1 = *(const GAS f32x4*)(CW + k * CONVD + c0 + 4);
            w[k][0] = w0.x; w[k][1] = w0.y; w[k][2] = w0.z; w[k][3] = w0.w; w[k][4] = w1.x; w[k][5] = w1.y; w[k][6] = w1.z; w[k][7] = w1.w; }
        { const f32x4 b0 = *(const GAS f32x4*)(CB + c0), b1 = *(const GAS f32x4*)(CB + c0 + 4); bs[0] = b0.x; bs[1] = b0.y; bs[2] = b0.z; bs[3] = b0.w; bs[4] = b1.x; bs[5] = b1.y; bs[6] = b1.z; bs[7] = b1.w; }
#pragma unroll
        for (int k = 0; k < 3; ++k) { u32x4 r = {0u, 0u, 0u, 0u}; if (!first) r = *(const GAS u32x4*)(XBC + (size_t)(m0 - 3 + k) * CONVD + c0);
            win[k][0] = bflo(r.x); win[k][1] = bfhi(r.x); win[k][2] = bflo(r.y); win[k][3] = bfhi(r.y); win[k][4] = bflo(r.z); win[k][5] = bfhi(r.z); win[k][6] = bflo(r.w); win[k][7] = bfhi(r.w); }
#pragma unroll 1
        for (int tb = 0; tb < 4; ++tb) {
            u32x4 rr[8];
#pragma unroll
            for (int k = 0; k < 8; ++k) rr[k] = *(const GAS u32x4*)(XBC + (size_t)(m0 + tb * 8 + k) * CONVD + c0);
#pragma unroll
            for (int k = 0; k < 8; ++k) { const u32x4 r = rr[k];
                const float x[8] = {bflo(r.x), bfhi(r.x), bflo(r.y), bfhi(r.y), bflo(r.z), bfhi(r.z), bflo(r.w), bfhi(r.w)};
                float a[8];
#pragma unroll
                for (int j = 0; j < 8; ++j) { a[j] = bs[j] + w[0][j] * win[0][j] + w[1][j] * win[1][j] + w[2][j] * win[2][j] + w[3][j] * x[j]; a[j] = a[j] * sigmoidf_(a[j]);
                    win[0][j] = win[1][j]; win[1][j] = win[2][j]; win[2][j] = x[j]; }
                u32x4 o; o.x = pk2(a[0], a[1]); o.y = pk2(a[2], a[3]); o.z = pk2(a[4], a[5]); o.w = pk2(a[6], a[7]);
                *(GAS u32x4*)(XA + (size_t)(m0 + tb * 8 + k) * CONVD + c0) = o; }
        }
    }
    {
        constexpr int CONV_WAVES = (CONVD / 8) * (M / 32) / 64;
        const int gw0 = F.vcu * NWAVES + F.wave, NGW0 = F.G * NWAVES;
        const bool spare = (NGW0 == 2048);
        const int gw = spare ? (((gw0 & 3) == 3) ? (gw0 >> 2) : -1) : gw0, NGW = spare ? 512 : NGW0;
        const float* DTRAW = (const float*)(F.ws + WS_DTRAW); float* DT = (float*)(F.ws + WS_DT); float* CS = (float*)(F.ws + WS_CS);
        for (int it0 = gw < 0 ? (M / 256) * SH : gw; it0 < (M / 256) * SH; it0 += NGW) {
            const int it = spare ? ((it0 & 511) >> 6) * 128 + (it0 & 63) + 64 * (it0 >> 9) : it0;
            const int ch = it / SH, j = it % SH; const float bias = F.in[I_DTB][j], a = -__expf(F.in[I_ALOG][j]);
            float dt[4], cs[4]; float run = 0.f;
#pragma unroll
            for (int e = 0; e < 4; ++e) { const float x = DTRAW[(size_t)(ch * 256 + 4 * F.lane + e) * 16 + j] + bias; dt[e] = x > 20.f ? x : log1pf(__expf(x)); run += dt[e] * a; cs[e] = run; }
            float inc = run;
#pragma unroll
            for (int o = 1; o < 64; o <<= 1) { const float t = __shfl_up(inc, o); if (F.lane >= o) inc += t; }
            const float excl = inc - run;
#pragma unroll
            for (int e = 0; e < 4; ++e) { const size_t idx = (size_t)(ch * 256 + 4 * F.lane + e) * 16 + j; DT[idx] = dt[e]; CS[idx] = cs[e] + excl; }
        }
        const bf16* Kb = (const bf16*)(F.ws + WS_K); float* KM = (float*)(F.ws + WS_KMEAN);
        for (int it = gw < 0 ? NBATCH * AH * NBLK : gw; it < NBATCH * AH * NBLK; it += NGW) {
            const int b = it / (AH * NBLK), h = (it / NBLK) % AH, kb = it % NBLK;
            const int rg = F.lane >> 3, chk = F.lane & 7;
            const bf16* kp = Kb + (size_t)(b * SEQ + kb * 256 + rg) * AW + h * 64 + chk * 8;
            float a[8] = {0.f, 0.f, 0.f, 0.f, 0.f, 0.f, 0.f, 0.f};
            u32x4 kw[32];
#pragma unroll
            for (int r = 0; r < 32; ++r) kw[r] = *(const GAS u32x4*)(kp + (size_t)r * 8 * AW);
#pragma unroll
            for (int r = 0; r < 32; ++r) { const u32x4 w = kw[r];
                a[0] += bflo(w.x); a[1] += bfhi(w.x); a[2] += bflo(w.y); a[3] += bfhi(w.y); a[4] += bflo(w.z); a[5] += bfhi(w.z); a[6] += bflo(w.w); a[7] += bfhi(w.w); }
#pragma unroll
            for (int e = 0; e < 8; ++e) { a[e] += __shfl_xor(a[e], 8); a[e] += __shfl_xor(a[e], 16); a[e] += __shfl_xor(a[e], 32); }
            if (rg == 0) { f32x4 o0 = {a[0], a[1], a[2], a[3]}, o1 = {a[4], a[5], a[6], a[7]}; o0 = o0 * (1.f / 256.f); o1 = o1 * (1.f / 256.f);
                *(GAS f32x4*)(KM + (size_t)it * 64 + chk * 8) = o0; *(GAS f32x4*)(KM + (size_t)it * 64 + chk * 8 + 4) = o1; }
        }
    }
}

__device__ __forceinline__ void conv_item(Frame& F, int part, int j, int ldsoff) {
    const int NGW = F.G * NWAVES; int r = F.vcu * NWAVES + (j & 7) + (part + 2 * (j >> 3)) * NGW;
    LAS float* scr = (LAS float*)(F.lds + ldsoff + F.wave * 8704);
    bf16* WGU = (bf16*)(F.ws + WS_WGU); bf16* WD = (bf16*)(F.ws + WS_WD);
    constexpr int IG = NE * 16 * 16, ID = NE * 8 * 32;
    if (r >= 2 * IG + ID) return;
    if (r < 2 * IG) { const int up = r >= IG; if (up) r -= IG; const int e = r / 256, kb = (r % 256) / 16, nb = r % 16;
        const float* W = F.in[up ? I_WUP : I_WGATE] + (size_t)e * DM * FF;
        const int j0 = 32 * nb, row0 = e * 1024 + 256 * (j0 / 128) + (j0 % 128) + (up ? 128 : 0);
        transpose_item(W, FF, 64 * kb, j0, WGU, 1024, row0, 0, scr, F.lane, F.in[I_FFNG]); }
    else { r -= 2 * IG; const int e = r / 256, kb = (r % 256) / 32, nb = r % 32;
        const float* W = F.in[I_WDOWN] + (size_t)e * FF * DM;
        transpose_item(W, DM, 64 * kb, 32 * nb, WD, 512, e * 1024 + 32 * nb, 0, scr, F.lane); }
}

struct EpiMerge {
    static constexpr bool PERM = true, AFTER_DRAIN = false;
    const unsigned char *GA, *GB; bf16* OUT; const LAS float* RN;
    __device__ __forceinline__ bool keep(const pg8::Unit& u) const { return u.aux < 2; }
    __device__ __forceinline__ void operator()(pg8::Acc& acc, const pg8::Unit& u, int wr, int wc, int fr, int fq) const {
        const int row0 = u.pm * 256 + wr * 64 + fr, col0 = u.pn * 256 + wc * 32 + 8 * fq;
#pragma unroll
        for (int ai = 0; ai < 2; ++ai)
#pragma unroll
            for (int m = 0; m < 4; ++m) { const int row = row0 + ai * 128 + m * 16; const size_t off = (size_t)row * DM + col0;
                const f32x2 rn = *(const LAS f32x2*)(RN + 2 * (row - u.pm * 256));
                if (u.aux == 1) { const float f = rn.x / rn.y;
#pragma unroll
                    for (int bj = 0; bj < 2; ++bj) { acc[ai][bj][m][0] = acc[ai][bj][m][0] * f; acc[ai][bj][m][1] = acc[ai][bj][m][1] * f; }
                } else if (u.aux == 0) {
                    const u32x2 gb0 = *(const u32x2*)(GB + off), gb1 = *(const u32x2*)(GB + off + 128), ga0 = *(const u32x2*)(GA + off), ga1 = *(const u32x2*)(GA + off + 128);
                    const float r0 = rn.x;
#pragma unroll
                    for (int bj = 0; bj < 2; ++bj) { const u32x2 g = bj ? gb1 : gb0, h = bj ? ga1 : ga0;
                        const float b[8] = {(float)(g.x & 255u), (float)((g.x >> 8) & 255u), (float)((g.x >> 16) & 255u), (float)(g.x >> 24), (float)(g.y & 255u), (float)((g.y >> 8) & 255u), (float)((g.y >> 16) & 255u), (float)(g.y >> 24)};
                        const float a[8] = {(float)(h.x & 255u), (float)((h.x >> 8) & 255u), (float)((h.x >> 16) & 255u), (float)(h.x >> 24), (float)(h.y & 255u), (float)((h.y >> 8) & 255u), (float)((h.y >> 16) & 255u), (float)(h.y >> 24)};
#pragma unroll
                        for (int j = 0; j < 4; ++j) { acc[ai][bj][m][0][j] *= a[j] * __builtin_amdgcn_rcpf(fmaxf(b[j] * r0, 1e-30f)); acc[ai][bj][m][1][j] *= a[4 + j] * __builtin_amdgcn_rcpf(fmaxf(b[4 + j] * r0, 1e-30f)); } }
                } else {
                    const u32x2 gb0 = *(const u32x2*)(GB + off), gb1 = *(const u32x2*)(GB + off + 128);
                    const float r1 = rn.y * (1.f / 255.f);
#pragma unroll
                    for (int bj = 0; bj < 2; ++bj) { const u32x2 g = bj ? gb1 : gb0;
                        const float b[8] = {(float)(g.x & 255u), (float)((g.x >> 8) & 255u), (float)((g.x >> 16) & 255u), (float)(g.x >> 24), (float)(g.y & 255u), (float)((g.y >> 8) & 255u), (float)((g.y >> 16) & 255u), (float)(g.y >> 24)};
                        const f32x4 v0 = acc[ai][bj][m][0] * r1, v1 = acc[ai][bj][m][1] * r1;
                        u32x4 w; w.x = pg8::cvt_pk_bf16(v0[0] * b[0], v0[1] * b[1]); w.y = pg8::cvt_pk_bf16(v0[2] * b[2], v0[3] * b[3]);
                        w.z = pg8::cvt_pk_bf16(v1[0] * b[4], v1[1] * b[5]); w.w = pg8::cvt_pk_bf16(v1[2] * b[6], v1[3] * b[7]);
                        *(u32x4*)(OUT + off + bj * 128) = w; }
                }
            }
    }
};
struct SchedMerge {
    int G, c;
    __device__ __forceinline__ bool next(int i, pg8::Unit& u) const {
        const int T = (i / 3) * G + c; if (T >= 256) return false;
        int pm, pn; pg8::tile_of(T, 64, 4, pm, pn); const int sub = i % 3;
        u.pm = pm; u.pn = pn; u.aux = sub; u.nt = 8;
        u.offA = (size_t)pm * 256 * 1536 * 2 + sub * 512 * 2; u.offB = (size_t)pn * 256 * 1536 * 2 + sub * 512 * 2;
        return true;
    }
};
__device__ __forceinline__ void phase_merge(Frame& F) {
    LAS float* rnt = (LAS float*)(F.lds + 140 * 1024);
    { int pm0, pn0; pg8::tile_of((int)blockIdx.x, 64, 4, pm0, pn0);
      if (F.tid < 256) { const f32x4* sp = (const f32x4*)((const float*)(F.ws + WS_SUMSQ) + (size_t)(pm0 * 256 + F.tid) * 16); const f32x4 a = sp[0], b = sp[1], c = sp[2], d = sp[3];
        rnt[2 * F.tid] = 1.0f / sqrtf(((a.x + a.y + a.z + a.w) + (b.x + b.y + b.z + b.w)) * (1.f / 512.f) + EPS); rnt[2 * F.tid + 1] = 1.0f / sqrtf(((c.x + c.y + c.z + c.w) + (d.x + d.y + d.z + d.w)) * (1.f / 512.f) + EPS); } }
    __syncthreads();
    pg8::Gemm g{(const bf16*)(F.ws + WS_ACAT), (const bf16*)(F.ws + WS_BCAT), 1536, 1536};
    EpiMerge E{(const unsigned char*)F.out, (const unsigned char*)F.out + (size_t)M * DM, (bf16*)(F.ws + WS_MERGED), rnt};
    SchedMerge S{F.G, (int)blockIdx.x};
    run_gemm(F.lds, g, S, E);
}

struct SchedPlain {
    int G, c, nN, nt, lda, ldb;
    __device__ __forceinline__ bool next(int i, pg8::Unit& u) const {
        const int L = i * G + c; if (L >= 64 * nN) return false;
        int pm, pn; pg8::tile_of(L, 64, nN, pm, pn);
        u.pm = pm; u.pn = pn; u.aux = 0; u.nt = nt; u.offA = (size_t)pm * 256 * lda * 2; u.offB = (size_t)pn * 256 * ldb * 2; return true;
    }
};
struct EpiX1 {
    static constexpr bool PERM = true, AFTER_DRAIN = false;
    const float* X; bf16* X1B; float* SSQP;
    __device__ __forceinline__ bool keep(const pg8::Unit&) const { return false; }
    __device__ __forceinline__ void operator()(pg8::Acc& acc, const pg8::Unit& u, int wr, int wc, int fr, int fq) const {
        const int row0 = u.pm * 256 + wr * 64 + fr, col0 = u.pn * 256 + wc * 32 + 8 * fq;
#pragma unroll
        for (int ai = 0; ai < 2; ++ai) {
            f32x4 xq[4][2][2];
#pragma unroll
            for (int m = 0; m < 4; ++m) { const size_t off = (size_t)(row0 + ai * 128 + m * 16) * DM + col0;
                xq[m][0][0] = __builtin_nontemporal_load((const f32x4*)(X + off)); xq[m][0][1] = __builtin_nontemporal_load((const f32x4*)(X + off + 4));
                xq[m][1][0] = __builtin_nontemporal_load((const f32x4*)(X + off + 128)); xq[m][1][1] = __builtin_nontemporal_load((const f32x4*)(X + off + 132)); }
#pragma unroll
            for (int m = 0; m < 4; ++m) { const int row = row0 + ai * 128 + m * 16; const size_t off = (size_t)row * DM + col0; float ssq = 0.f;
#pragma unroll
                for (int bj = 0; bj < 2; ++bj) { const f32x4 v0 = xq[m][bj][0] + acc[ai][bj][m][0], v1 = xq[m][bj][1] + acc[ai][bj][m][1];
                    ssq += (v0[0] * v0[0] + v0[1] * v0[1]) + (v0[2] * v0[2] + v0[3] * v0[3]) + (v1[0] * v1[0] + v1[1] * v1[1]) + (v1[2] * v1[2] + v1[3] * v1[3]);
                    u32x4 w; w.x = pg8::cvt_pk_bf16(v0[0], v0[1]); w.y = pg8::cvt_pk_bf16(v0[2], v0[3]); w.z = pg8::cvt_pk_bf16(v1[0], v1[1]); w.w = pg8::cvt_pk_bf16(v1[2], v1[3]);
                    *(u32x4*)(X1B + (size_t)row * X1P + col0 + bj * 128) = w; }
                ssq += other16(ssq); ssq += other32(ssq);
                if (fq == 0) SSQP[(size_t)row * 16 + u.pn * 4 + wc] = ssq; } }
    }
};
__device__ __forceinline__ void phase_x1(Frame& F) {
    pg8::Gemm g{(const bf16*)(F.ws + WS_MERGED), (const bf16*)(F.ws + WS_WOUT), 1024, 1024};
    EpiX1 E{F.in[I_X], (bf16*)(F.ws + WS_X1B), (float*)(F.ws + WS_SSQP)};
    SchedPlain S{F.G, (int)blockIdx.x, 4, 16, 1024, 1024};
    run_gemm(F.lds, g, S, E);
}

__device__ __forceinline__ void cls_experts(int cls, int& ea, int& eb) { const int g = cls / 6, p = cls % 6; const int a = p < 3 ? 0 : (p < 5 ? 1 : 2), b = p < 3 ? p + 1 : (p < 5 ? p - 1 : 3); ea = g * 4 + a; eb = g * 4 + b; }
__device__ __forceinline__ void qkv_region_free(Frame& F) {
    unsigned* c = (unsigned*)(F.ws + WS_CTL) + CW_QKV; unsigned sp = 0;
    while ((unsigned)__builtin_amdgcn_readfirstlane((int)xb_ld(c)) < (unsigned)F.G) { __builtin_amdgcn_s_sleep(1); if (++sp > XB_SPIN_CAP) break; }
}
__device__ __forceinline__ void phase_route1(Frame& F, bool gate) {
    LAS float* lgt = (LAS float*)F.lds; LAS int* hist = (LAS int*)(F.lds + 64 * 33 * 4); LAS int* flag = hist + 32;
    const int blk = F.vcu, lane = F.lane, fr = lane & 15, fq = lane >> 4;
    if (F.tid < NCLS) hist[F.tid] = 0;
    if (F.tid == 32) *flag = 0;
    __syncthreads();
    if (F.wave >= 4) {
        if (gate) qkv_region_free(F);
#pragma unroll 1
        for (int q = 0; q < 4; ++q) conv_item(F, 0, (F.wave - 4) * 4 + q, 16384);
        __syncthreads();
        if (F.tid < NCLS) ((int*)(F.ws + WS_HIST))[blk * NCLS + F.tid] = hist[F.tid];
        return;
    }
    const int rf = F.wave;
    const bf16* Ap = (const bf16*)(F.ws + WS_X1B) + (size_t)(blk * 64 + rf * 16 + fr) * X1P + fq * 8;
    const bf16* Bp = (const bf16*)(F.ws + WS_WRT) + (size_t)fr * DM + fq * 8;
    f32x4 acc0 = {0.f, 0.f, 0.f, 0.f}, acc1 = acc0;
#pragma unroll 8
    for (int ks = 0; ks < 32; ++ks) { const bf16x8 a = *(const bf16x8*)(Ap + ks * 32), b0 = *(const bf16x8*)(Bp + ks * 32), b1 = *(const bf16x8*)(Bp + 16 * DM + ks * 32);
        acc0 = __builtin_amdgcn_mfma_f32_16x16x32_bf16(a, b0, acc0, 0, 0, 0); acc1 = __builtin_amdgcn_mfma_f32_16x16x32_bf16(a, b1, acc1, 0, 0, 0); }
#pragma unroll
    for (int j = 0; j < 4; ++j) { lgt[(rf * 16 + 4 * fq + j) * 33 + fr] = acc0[j]; lgt[(rf * 16 + 4 * fq + j) * 33 + 16 + fr] = acc1[j]; }
    asm volatile("s_waitcnt lgkmcnt(0)" ::: "memory");
    if (lane == 0) __hip_atomic_fetch_add(flag, 1, __ATOMIC_RELAXED, __HIP_MEMORY_SCOPE_WORKGROUP);
    if (F.wave == 0) { unsigned sp = 0; while (__hip_atomic_load(flag, __ATOMIC_RELAXED, __HIP_MEMORY_SCOPE_WORKGROUP) < 4) { __builtin_amdgcn_s_sleep(1); if (++sp > (1u << 22)) break; } asm volatile("s_waitcnt lgkmcnt(0)" ::: "memory"); }
    int* CLS = (int*)(F.ws + WS_CLS); float* WTS = (float*)(F.ws + WS_WTS); const float* SSQP = (const float*)(F.ws + WS_SSQP);
    if (F.tid < 64) {
        const int m = blk * 64 + F.tid;
        const f32x4* sp = (const f32x4*)(SSQP + (size_t)m * 16); const f32x4 sa = sp[0], sb = sp[1], sc = sp[2], sd = sp[3];
        const float ssq = ((sa.x + sa.y + sa.z + sa.w) + (sb.x + sb.y + sb.z + sb.w)) + ((sc.x + sc.y + sc.z + sc.w) + (sd.x + sd.y + sd.z + sd.w));
        const float r = 1.0f / sqrtf(ssq * (1.f / DM) + EPS);
        float lg[20];
#pragma unroll
        for (int c = 0; c < 20; ++c) lg[c] = lgt[F.tid * 33 + c] * r + (c < 4 ? F.in[I_BRG][c] : F.in[I_BRE][c - 4]);
        int gs = 0;
#pragma unroll
        for (int c = 1; c < 4; ++c) if (lg[c] > lg[gs]) gs = c;
        float den = 0.f;
#pragma unroll
        for (int c = 0; c < 4; ++c) den += __expf(lg[c] - lg[gs]);
        const float gpw = 1.f / den;
        float el[4];
#pragma unroll
        for (int c = 0; c < 4; ++c) { float v0 = lg[4 + c];
#pragma unroll
            for (int g4 = 1; g4 < 4; ++g4) v0 = (gs == g4) ? lg[4 + g4 * 4 + c] : v0;
            el[c] = v0; }
        int i0 = 0;
#pragma unroll
        for (int c = 1; c < 4; ++c) if (el[c] > el[i0]) i0 = c;
        int i1 = (i0 == 0) ? 1 : 0;
#pragma unroll
        for (int c = 0; c < 4; ++c) if (c != i0 && el[c] > el[i1]) i1 = c;
        const float e1 = __expf(el[i1] - el[i0]), w0 = gpw / (1.f + e1), w1 = gpw * e1 / (1.f + e1);
        const int a = i0 < i1 ? i0 : i1, b = i0 < i1 ? i1 : i0; const float wa = i0 < i1 ? w0 : w1, wb = i0 < i1 ? w1 : w0;
        const int pair = (a == 0) ? (b - 1) : (a == 1 ? (b + 1) : 5);
        const int cls = gs * 6 + pair;
        CLS[m] = cls; *(f32x4*)(WTS + 4 * (size_t)m) = (f32x4){wa, wb, r, 0.f};
        atomicAdd((int*)hist + cls, 1);
    }
    if (gate) qkv_region_free(F);
    conv_item(F, 0, 16 + 2 * F.wave, 16384); conv_item(F, 0, 17 + 2 * F.wave, 16384);
    __syncthreads();
    if (F.tid < NCLS) ((int*)(F.ws + WS_HIST))[blk * NCLS + F.tid] = hist[F.tid];
}

__device__ __forceinline__ void phase_route2(Frame& F) {
    if (F.wave != 0) {
#pragma unroll 1
        for (int j = F.wave - 1; j < 24; j += 7) conv_item(F, 1, j, 32768);
        return;
    }
#define R2_SYNC() asm volatile("s_waitcnt lgkmcnt(0)" ::: "memory")
    LAS int* tot = (LAS int*)F.lds; LAS int* pre = tot + 32; LAS int* base = pre + 32; LAS int* lcls = base + 32; LAS int* lpos = lcls + 64;
    const int* HIST = (const int*)(F.ws + WS_HIST); const int blk = F.vcu, lane = F.lane;
    LAS int* hl = (LAS int*)(F.lds + 4096);
    { u32x4 hv[24];
#pragma unroll
      for (int i = 0; i < 24; ++i) hv[i] = ((const u32x4*)HIST)[lane + 64 * i];
#pragma unroll
      for (int i = 0; i < 24; ++i) ((LAS u32x4*)hl)[lane + 64 * i] = hv[i]; }
    const int* CLS = (const int*)(F.ws + WS_CLS);
    const int mycls = CLS[blk * 64 + lane];
    R2_SYNC();
    if (lane < NCLS) { int t = 0, p = 0; for (int b = 0; b < 256; ++b) { const int h = hl[b * NCLS + lane]; if (b < blk) p += h; t += h; } tot[lane] = t; pre[lane] = p; }
    R2_SYNC();
    if (lane == 0) { int acc = 0; for (int c = 0; c < NCLS; ++c) { base[c] = acc; acc += ((tot[c] + 255) >> 8) << 8; } base[NCLS] = acc; }
    lcls[lane] = mycls;
    R2_SYNC();
    { const int c = mycls; int rank = 0; for (int j = 0; j < lane; ++j) rank += (lcls[j] == c) ? 1 : 0; lpos[lane] = base[c] + pre[c] + rank; }
    R2_SYNC();
    int* PERM = (int*)(F.ws + WS_PERM); float* WPOS = (float*)(F.ws + WS_WPOS); const float* WTS = (const float*)(F.ws + WS_WTS);
    { const int m = blk * 64 + lane, pos = lpos[lane]; PERM[pos] = m; *(f32x4*)(WPOS + 4 * (size_t)pos) = *(const f32x4*)(WTS + 4 * (size_t)m); }
    if (blk == 0) {
        int* TILES = (int*)(F.ws + WS_TILES);
        if (lane == 0) { TILES[0] = base[NCLS] >> 8; }
        if (lane < NCLS) { const int c = lane; for (int t = base[c] >> 8; t < (base[c + 1] >> 8); ++t) TILES[1 + t] = c; }
        for (int c = 0; c < NCLS; ++c) { const int lo = base[c] + tot[c], hi = base[c + 1]; for (int p = lo + lane; p < hi; p += 64) { PERM[p] = -1; *(f32x4*)(WPOS + 4 * (size_t)p) = (f32x4){0.f, 0.f, 0.f, 0.f}; } }
    }
#undef R2_SYNC
}

struct SchedMoeUp {
    int G, c; const int* TILES;
    __device__ __forceinline__ bool next(int i, pg8::Unit& u) const {
        const int nrt = TILES[0], L = i * G + c; if (L >= nrt * 8) return false;
        const int pm = L >> 3, pn = L & 7; int ea, eb; cls_experts(TILES[1 + pm], ea, eb); const int e = (pn < 4) ? ea : eb;
        u.pm = pm; u.pn = pn; u.aux = 0; u.nt = 16; u.sel = 0; u.offA = 0; u.offB = (size_t)(e * 1024 + 256 * (pn & 3)) * 1024 * 2; return true;
    }
    __device__ __forceinline__ void a_ready(const pg8::Unit&) const {}
};
struct SchedMoeDown {
    int G, c; const int* TILES; unsigned* cnt;
    __device__ __forceinline__ bool next(int i, pg8::Unit& u) const {
        const int nrt = TILES[0], n_up = nrt * 8, n_dn = nrt * 4;
        const int iu = c < n_up ? (n_up - c + G - 1) / G : 0;
        const int D = (iu + (i >> 1)) * G + c - n_up, sub = i & 1;
        if (D >= n_dn) {
            const int rem = n_up + n_dn - c - iu * G, jd = rem > 0 ? (rem + G - 1) / G : 0, q = (iu + jd) * G + c - n_up - n_dn, ip = i - 2 * jd;
            const int spare = ((n_up + n_dn + G - 1) / G) * G - (n_up + n_dn), per = spare >= 128 ? 2 : (spare > 0 ? (256 + spare - 1) / spare : 4), pu = q * per + ip;
            if (ip >= per || pu >= 256) return false;
            u.pm = pu >> 2; u.pn = pu & 3; u.aux = 3; u.nt = 4; u.sel = 0; u.offA = (size_t)(pu >> 2) * 256 * 256 * 2; u.offB = (size_t)(pu & 3) * 256 * 256 * 2; return true; }
        const int pm = D >> 2, pn = D & 3; int ea, eb; cls_experts(TILES[1 + pm], ea, eb); const int e = sub ? eb : ea;
        u.pm = pm; u.pn = pn; u.aux = 1 + sub; u.nt = 8; u.sel = 1; u.offA = (size_t)pm * 256 * 1024 * 2 + (sub ? 512 * 2 : 0); u.offB = (size_t)(e * 1024 + pn * 256) * 512 * 2; return true;
    }
    __device__ __forceinline__ void a_ready(const pg8::Unit& u) const {
        if (u.aux != 1) return;
        if (threadIdx.x < 64) { unsigned sp = 0;
            while ((unsigned)__builtin_amdgcn_readfirstlane(__hip_atomic_load(cnt + 64 * u.pm, __ATOMIC_RELAXED, __HIP_MEMORY_SCOPE_AGENT)) < 64u) { __builtin_amdgcn_s_sleep(2); if (++sp > (1u << 16)) break; }
            asm volatile("s_waitcnt vmcnt(0)" ::: "memory"); }
        asm volatile("" ::: "memory"); __builtin_amdgcn_s_barrier(); asm volatile("" ::: "memory");
    }
};
struct EpiMoe {
    static constexpr bool PERM = true, AFTER_DRAIN = false;
    const float* WPOS; bf16* HID; const int* PERMT; const bf16* X1B; bf16* X2B; unsigned* cnt; bf16* PPo;
    __device__ __forceinline__ bool keep(const pg8::Unit& u) const { return u.aux == 1; }
    __device__ __forceinline__ bool defer(const pg8::Unit& u) const { return u.aux == 0; }
    __device__ __forceinline__ void publish(int pm, int fr, int fq) const { if (fr == 0 && fq == 0) (void)__hip_atomic_fetch_add(cnt + 64 * pm, 1u, __ATOMIC_RELAXED, __HIP_MEMORY_SCOPE_AGENT); }
    __device__ __forceinline__ void operator()(pg8::Acc& acc, const pg8::Unit& u, int wr, int wc, int fr, int fq) const {
        if (u.aux == 1) return;
        if (u.aux == 3) {
            const int row0 = u.pm * 256 + wr * 64 + fr, col0 = u.pn * 256 + wc * 32 + 8 * fq;
#pragma unroll
            for (int ai = 0; ai < 2; ++ai)
#pragma unroll
                for (int m = 0; m < 4; ++m) { bf16* rowp = PPo + (size_t)(row0 + ai * 128 + m * 16) * 1024 + col0;
#pragma unroll
                    for (int bj = 0; bj < 2; ++bj) { const f32x4 v0 = acc[ai][bj][m][0], v1 = acc[ai][bj][m][1];
                        u32x4 w; w.x = pg8::cvt_pk_bf16(v0[0], v0[1]); w.y = pg8::cvt_pk_bf16(v0[2], v0[3]); w.z = pg8::cvt_pk_bf16(v1[0], v1[1]); w.w = pg8::cvt_pk_bf16(v1[2], v1[3]);
                        *(u32x4*)(rowp + bj * 128) = w; } }
            return;
        }
        if (u.aux == 0) {
            const int row0 = u.pm * 256 + wr * 64 + fr, col0 = u.pn * 128 + wc * 32 + 8 * fq, half = u.pn >> 2;
            const __amdgpu_buffer_rsrc_t rs = __builtin_amdgcn_make_buffer_rsrc((void*)HID, 0, MAXRT * 256 * 1024 * 2, 0x00020000);
            f32x4 wvs[2][4];
#pragma unroll
            for (int ai = 0; ai < 2; ++ai)
#pragma unroll
                for (int m = 0; m < 4; ++m) wvs[ai][m] = *(const f32x4*)(WPOS + 4 * (size_t)(row0 + ai * 128 + m * 16));
#pragma unroll
            for (int ai = 0; ai < 2; ++ai)
#pragma unroll
                for (int m = 0; m < 4; ++m) { const int pos = row0 + ai * 128 + m * 16; const f32x4 wv = wvs[ai][m]; const float w = half ? wv.y : wv.x, r = wv.z;
                    float h[8];
#pragma unroll
                    for (int n = 0; n < 2; ++n)
#pragma unroll
                        for (int j = 0; j < 4; ++j) { const float gt = r * acc[ai][0][m][n][j], up = r * acc[ai][1][m][n][j]; h[4 * n + j] = w * gt * sigmoidf_(gt) * up; }
                    u32x4 o; o.x = pg8::cvt_pk_bf16(h[0], h[1]); o.y = pg8::cvt_pk_bf16(h[2], h[3]); o.z = pg8::cvt_pk_bf16(h[4], h[5]); o.w = pg8::cvt_pk_bf16(h[6], h[7]);
                    __builtin_amdgcn_raw_buffer_store_b128(o, rs, (int)(((size_t)pos * 1024 + col0) * 2), 0, 16); }
            return;
        }
        const int row0 = u.pm * 256 + wr * 64 + fr, col0 = u.pn * 256 + wc * 32 + 8 * fq;
        int toks[2][4];
#pragma unroll
        for (int ai = 0; ai < 2; ++ai)
#pragma unroll
            for (int m = 0; m < 4; ++m) toks[ai][m] = PERMT[row0 + ai * 128 + m * 16];
#pragma unroll
        for (int ai = 0; ai < 2; ++ai)
#pragma unroll
            for (int m = 0; m < 4; ++m) { const int tok = toks[ai][m]; if (tok < 0) continue; const size_t off = (size_t)tok * DM + col0;
                const size_t offx = (size_t)tok * X1P + col0; const u32x4 xws[2] = {*(const u32x4*)(X1B + offx), *(const u32x4*)(X1B + offx + 128)};
#pragma unroll
                for (int bj = 0; bj < 2; ++bj) { const u32x4 xw = xws[bj]; const f32x4 a0 = acc[ai][bj][m][0], a1 = acc[ai][bj][m][1];
                    u32x4 w; w.x = pg8::cvt_pk_bf16(bflo(xw.x) + a0[0], bfhi(xw.x) + a0[1]); w.y = pg8::cvt_pk_bf16(bflo(xw.y) + a0[2], bfhi(xw.y) + a0[3]);
                    w.z = pg8::cvt_pk_bf16(bflo(xw.z) + a1[0], bfhi(xw.z) + a1[1]); w.w = pg8::cvt_pk_bf16(bflo(xw.w) + a1[2], bfhi(xw.w) + a1[3]);
                    *(u32x4*)(X2B + off + bj * 128) = w; } }
    }
};
__device__ __forceinline__ void phase_up(Frame& F) {
    unsigned* cnt = (unsigned*)(F.ws + WS_CTL) + CW_MOE;
    pg8::Gemm2 g{(const bf16*)(F.ws + WS_X1B), (const bf16*)(F.ws + WS_WGU), X1P, 1024, (const bf16*)F.out, (const bf16*)(F.ws + WS_WD), 1024, 512, (const int*)(F.ws + WS_PERM)};
    EpiMoe E{(const float*)(F.ws + WS_WPOS), (bf16*)F.out, (const int*)(F.ws + WS_PERM), (const bf16*)(F.ws + WS_X1B), (bf16*)(F.ws + WS_X2B), cnt, (bf16*)(F.ws + WS_PP)};
    SchedMoeUp SU{F.G, (int)blockIdx.x, (const int*)(F.ws + WS_TILES)};
    pg8::gemm_phase2(F.lds, g, SU, E);
    SchedMoeDown SD{F.G, (int)blockIdx.x, (const int*)(F.ws + WS_TILES), cnt};
    pg8::Gemm2 g2{(const bf16*)(F.ws + WS_PB), (const bf16*)(F.ws + WS_WPPT), 256, 256, (const bf16*)F.out, (const bf16*)(F.ws + WS_WD), 1024, 512, nullptr};
    pg8::gemm_phase2(F.lds, g2, SD, E);
}

struct EpiPleFinal {
    static constexpr bool PERM = false, AFTER_DRAIN = true;
    const bf16* X2B; const bf16* PP; const float* G; float* OUT; unsigned* xb; unsigned* cnt;
    __device__ __forceinline__ bool keep(const pg8::Unit&) const { return false; }
    __device__ __forceinline__ void fused(pg8::Acc& acc, const pg8::Unit& u, int wr, int wc, int fr, int fq, LAS unsigned char* lds, int wid, int lane) const {
        LAS float* P = (LAS float*)lds; LAS float* S = (LAS float*)(lds + 8192);
        const int row0 = u.pm * 256 + wr * 64 + fr, col0 = u.pn * 256 + wc * 32 + 4 * fq;
#pragma unroll
        for (int ai = 0; ai < 2; ++ai)
#pragma unroll
            for (int m = 0; m < 4; ++m) { const size_t off = (size_t)(row0 + ai * 128 + m * 16) * DM + col0; float s = 0.f;
                u32x2 xvs[2][2], pps[2][2];
#pragma unroll
                for (int bj = 0; bj < 2; ++bj)
#pragma unroll
                    for (int n = 0; n < 2; ++n) { xvs[bj][n] = *(const u32x2*)(X2B + off + bj * 128 + n * 16); pps[bj][n] = *(const u32x2*)(PP + off + bj * 128 + n * 16); }
#pragma unroll
                for (int bj = 0; bj < 2; ++bj)
#pragma unroll
                    for (int n = 0; n < 2; ++n) { const u32x2 xv = xvs[bj][n], pp = pps[bj][n]; const f32x4 a = acc[ai][bj][m][n];
                        f32x4 o; o[0] = bflo(xv.x) + sigmoidf_(a[0]) * bflo(pp.x); o[1] = bfhi(xv.x) + sigmoidf_(a[1]) * bfhi(pp.x); o[2] = bflo(xv.y) + sigmoidf_(a[2]) * bflo(pp.y); o[3] = bfhi(xv.y) + sigmoidf_(a[3]) * bfhi(pp.y);
                        acc[ai][bj][m][n] = o; s += (o[0] * o[0] + o[1] * o[1]) + (o[2] * o[2] + o[3] * o[3]); }
                s += other16(s); s += other32(s);
                if (fq == 0) P[(ai * 128 + wr * 64 + m * 16 + fr) * 4 + wc] = s; }
        asm volatile("s_waitcnt lgkmcnt(0)" ::: "memory"); __builtin_amdgcn_s_barrier(); asm volatile("" ::: "memory");
        const int row = wid * 32 + (lane & 31);
        if (lane < 32) { const f32x4 p4 = *(const LAS f32x4*)(P + row * 4); const float t = (p4.x + p4.y) + (p4.z + p4.w);
            __hip_atomic_store(xb + (size_t)(u.pm * 256 + row) * 4 + u.pn, __builtin_bit_cast(unsigned, t), __ATOMIC_RELAXED, __HIP_MEMORY_SCOPE_AGENT); }
        asm volatile("s_waitcnt vmcnt(0)" ::: "memory");
        if (lane == 0) __hip_atomic_fetch_add(cnt + 64 * u.pm, 1u, __ATOMIC_RELAXED, __HIP_MEMORY_SCOPE_AGENT);
        if (wid == 0) {
            unsigned sp = 0;
            while ((unsigned)__builtin_amdgcn_readfirstlane(__hip_atomic_load(cnt + 64 * u.pm, __ATOMIC_RELAXED, __HIP_MEMORY_SCOPE_AGENT)) < 32u) { __builtin_amdgcn_s_sleep(2); if (++sp > (1u << 22)) break; }
        }
        asm volatile("s_waitcnt vmcnt(0) lgkmcnt(0)" ::: "memory"); __builtin_amdgcn_s_barrier(); asm volatile("" ::: "memory");
        if (lane < 32) { float q = 0.f;
#pragma unroll
            for (int t = 0; t < 4; ++t) q += __builtin_bit_cast(float, __hip_atomic_load(xb + (size_t)(u.pm * 256 + row) * 4 + t, __ATOMIC_RELAXED, __HIP_MEMORY_SCOPE_AGENT));
            S[row] = 1.0f / sqrtf(q * (1.f / DM) + EPS); }
        asm volatile("s_waitcnt lgkmcnt(0)" ::: "memory"); __builtin_amdgcn_s_barrier(); asm volatile("" ::: "memory");
        f32x4 g4s[2][2];
#pragma unroll
        for (int bj = 0; bj < 2; ++bj)
#pragma unroll
            for (int n = 0; n < 2; ++n) g4s[bj][n] = *(const f32x4*)(G + col0 + bj * 128 + n * 16);
#pragma unroll
        for (int ai = 0; ai < 2; ++ai)
#pragma unroll
            for (int m = 0; m < 4; ++m) { const int r = ai * 128 + wr * 64 + m * 16 + fr; const float rs = S[r]; const size_t off = (size_t)(u.pm * 256 + r) * DM + col0;
#pragma unroll
                for (int bj = 0; bj < 2; ++bj)
#pragma unroll
                    for (int n = 0; n < 2; ++n) __builtin_nontemporal_store(acc[ai][bj][m][n] * rs * g4s[bj][n], (f32x4*)(OUT + off + bj * 128 + n * 16)); }
    }
    __device__ __forceinline__ void operator()(pg8::Acc&, const pg8::Unit&, int, int, int, int) const {}
};
__device__ __forceinline__ void phase_ple(Frame& F) {
    pg8::Gemm g{(const bf16*)(F.ws + WS_X2B), (const bf16*)(F.ws + WS_WPG), 1024, 1024};
    EpiPleFinal E{(const bf16*)(F.ws + WS_X2B), (const bf16*)(F.ws + WS_PP), F.in[I_FING], F.out, (unsigned*)(F.ws + WS_XB), (unsigned*)(F.ws + WS_CTL) + CW_PANEL};
    SchedPlain S{F.G, (int)blockIdx.x, 4, 16, 1024, 1024};
    run_gemm(F.lds, g, S, E);
}

namespace att {
typedef float f32x16 __attribute__((ext_vector_type(16)));
typedef short s16x4 __attribute__((ext_vector_type(4)));
typedef short v4i16_t __attribute__((ext_vector_type(4)));
typedef LAS const unsigned char* lptr;
__device__ __forceinline__ int crow(int r, int hi) { return (r & 3) + 8 * (r >> 2) + 4 * hi; }
__device__ __forceinline__ s16x4 vtr(lptr p) { return __builtin_bit_cast(s16x4, __builtin_amdgcn_ds_read_tr16_b64_v4i16((LAS v4i16_t*)p)); }
__device__ __forceinline__ void dma16(const void* g, LAS unsigned char* l) { __builtin_amdgcn_global_load_lds((const unsigned*)g, (LAS unsigned*)l, 16, 0, 0); }
__device__ __forceinline__ void dma16a(const void* g, LAS unsigned char* l) {
    const unsigned base = __builtin_amdgcn_readfirstlane((unsigned)(size_t)l); unsigned sv;
    asm volatile("s_mov_b32 %0, m0\n\ts_mov_b32 m0, %2\n\ts_nop 0\n\tglobal_load_lds_dwordx4 %1, off\n\ts_mov_b32 m0, %0" : "=&s"(sv) : "v"(g), "s"(base) : "memory"); }
__device__ __forceinline__ void ssd_y_prefetch(Frame& F, int b, int c, int j0) {
    const int lane = F.lane, wid = F.wave, g = j0 >> 3; const bf16* XA = (const bf16*)(F.ws + WS_XBCACT); LAS unsigned char* lds = F.lds; const size_t rowc = (size_t)b * SEQ + c * 256;
#pragma unroll
    for (int tt = 0; tt < 4; ++tt) {
        dma16a(XA + (rowc + 64 * tt + lane) * CONVD + 1024 + g * 128 + wid * 8, lds + tt * 16384 + wid * 1024);
        dma16a(XA + (rowc + 64 * tt + lane) * CONVD + 1024 + g * 128 + (wid + 8) * 8, lds + tt * 16384 + (wid + 8) * 1024); }
#pragma unroll
    for (int q = 0; q < 2; ++q)
#pragma unroll
        for (int tt = 0; tt < 4; ++tt) dma16a(XA + (rowc + 64 * tt + 16 * (wid & 3) + (lane >> 2)) * CONVD + (j0 + q) * 64 + (wid >> 2) * 32 + (lane & 3) * 8, lds + 65536 + q * 32768 + tt * 8192 + wid * 1024);
}
__device__ __forceinline__ float swap_other(float v) { float w = v; asm volatile("" : "+v"(w)); auto rr = __builtin_amdgcn_permlane32_swap(__builtin_bit_cast(unsigned, v), __builtin_bit_cast(unsigned, w), false, false);
    unsigned a = rr[0], b = rr[1]; asm volatile("" : "+v"(a), "+v"(b)); return (threadIdx.x & 32) ? __builtin_bit_cast(float, a) : __builtin_bit_cast(float, b); }
__device__ __forceinline__ float swap_add(float v) { return v + swap_other(v); }
__device__ __forceinline__ float swap_max(float v) { return fmaxf(v, swap_other(v)); }
#define ATT_PACK(P, B) ((u32x4){pg8::cvt_pk_bf16(P[B], P[B + 1]), pg8::cvt_pk_bf16(P[B + 2], P[B + 3]), pg8::cvt_pk_bf16(P[B + 4], P[B + 5]), pg8::cvt_pk_bf16(P[B + 6], P[B + 7])})
__device__ __forceinline__ void pv(f32x16 (&o)[2], lptr vimg, u32x4 pw0, u32x4 pw1, u32x4 pw2, u32x4 pw3) {
    const bf16x8 pa[4] = {__builtin_bit_cast(bf16x8, pw0), __builtin_bit_cast(bf16x8, pw1), __builtin_bit_cast(bf16x8, pw2), __builtin_bit_cast(bf16x8, pw3)};
#pragma unroll
    for (int d0 = 0; d0 < 2; ++d0)
#pragma unroll
        for (int ks = 0; ks < 4; ++ks) { const s16x4 lo = vtr(vimg + d0 * 4096 + ks * 1024), hh = vtr(vimg + d0 * 4096 + ks * 1024 + 512);
            const bf16x8 vb = (bf16x8){lo[0], lo[1], lo[2], lo[3], hh[0], hh[1], hh[2], hh[3]};
            o[d0] = __builtin_amdgcn_mfma_f32_32x32x16_bf16(pa[ks], vb, o[d0], 0, 0, 0); }
}

__device__ __forceinline__ void attn_unit(Frame& F, int b, int h, int qb) {
    const int lane = F.lane, r32 = lane & 31, hi = lane >> 5, wid = F.wave;
    const bf16* Q = (const bf16*)(F.ws + WS_Q); const bf16* K = (const bf16*)(F.ws + WS_K); const bf16* V = (const bf16*)(F.ws + WS_V);
#ifdef DBG_ATT
    bf16* O = (bf16*)(F.ws + WS_WCAT2); constexpr int OP = 512;
#else
    bf16* O = (bf16*)(F.ws + WS_ACAT); constexpr int OP = 1536;
#endif
    const size_t rowbase = (size_t)b * SEQ; const int q0 = qb * 256;
    const bf16* Kh = K + rowbase * AW + h * 64; const bf16* Vh = V + rowbase * AW + h * 64;
    LAS unsigned char* lds = F.lds;
    LAS float* wsf = (LAS float*)(lds + 65536 + wid * 256);
    const bf16* ksrc = Kh + (size_t)lane * AW + wid * 8;
    const bf16* vsrc = Vh + (size_t)(16 * (wid & 3) + (lane >> 2)) * AW + (wid >> 2) * 32 + (lane & 3) * 8;
#define ATT_DMA(t, s) do { dma16(ksrc + (size_t)(t) * 64 * AW, lds + (s) * 8192 + wid * 1024); dma16(vsrc + (size_t)(t) * 64 * AW, lds + 32768 + (s) * 8192 + wid * 1024); } while (0)
    ATT_DMA(0, 0); ATT_DMA(1, 1); ATT_DMA(2, 2);
    const bf16* Qw = Q + (rowbase + q0 + wid * 32 + r32) * AW + h * 64;
    bf16x8 qr[4];
#pragma unroll
    for (int d0 = 0; d0 < 4; ++d0) qr[d0] = *(const bf16x8*)(Qw + d0 * 16 + hi * 8);
    LAS float* kml = (LAS float*)(lds + 100352);
    kml[F.tid] = ((const float*)(F.ws + WS_KMEAN))[(size_t)((b * AH + h) * NBLK) * 64 + F.tid];
    unsigned sel = 0;
    const float sl2 = exp2f(-(float)(h + 1)) * LOG2E;
    float mhat = 0.f; f32x16 o[2], ol; o[0] = f32x16{}; o[1] = f32x16{}; ol = f32x16{};
    const int NT = 4 * (qb + 1), qloc = wid * 32 + r32;
    const lptr vp0 = (lptr)lds + 32768 + ((lane >> 4) & 1) * 32 + (lane & 3) * 8 + (4 * hi + ((lane & 15) >> 2)) * 64;
    const lptr kp0 = (lptr)lds + hi * 1024 + r32 * 16;
    const bf16x8 ones = {0x3F80, 0x3F80, 0x3F80, 0x3F80, 0x3F80, 0x3F80, 0x3F80, 0x3F80};
    constexpr float THR = 8.f;
    if (wid >= 4) __builtin_amdgcn_s_setprio(1);
    for (int t = 0; t < NT; ++t) {
        const int s = t & 3;
        if (t + 2 < NT) asm volatile("s_waitcnt vmcnt(4)" ::: "memory"); else if (t + 1 < NT) asm volatile("s_waitcnt vmcnt(2)" ::: "memory"); else asm volatile("s_waitcnt vmcnt(0)" ::: "memory");
        asm volatile("s_waitcnt lgkmcnt(0)" ::: "memory"); __builtin_amdgcn_s_barrier(); asm volatile("" ::: "memory");
        if (t + 3 < NT) ATT_DMA(t + 3, (t + 3) & 3);
        if (t == 0) {
            if (qb <= 3) sel = (1u << qb) - 1u;
            else {
                float g[8];
#pragma unroll
                for (int kb2 = 0; kb2 < 8; ++kb2) { float a = -INFINITY;
                    if (kb2 < qb) { a = 0.f;
#pragma unroll
                        for (int d0 = 0; d0 < 4; ++d0) { const f32x4 k0 = *(const LAS f32x4*)(kml + kb2 * 64 + d0 * 16 + hi * 8), k1 = *(const LAS f32x4*)(kml + kb2 * 64 + d0 * 16 + hi * 8 + 4);
                            const u32x4 qq = __builtin_bit_cast(u32x4, qr[d0]);
                            a += bflo(qq.x) * k0.x + bfhi(qq.x) * k0.y + bflo(qq.y) * k0.z + bfhi(qq.y) * k0.w + bflo(qq.z) * k1.x + bfhi(qq.z) * k1.y + bflo(qq.w) * k1.z + bfhi(qq.w) * k1.w; }
                        a = swap_add(a); }
                    g[kb2] = a; }
#pragma unroll
                for (int r = 0; r < 3; ++r) { int best = -1; float bv = -INFINITY;
#pragma unroll
                    for (int kb2 = 0; kb2 < 8; ++kb2) if (kb2 < qb && !((sel >> kb2) & 1u) && g[kb2] > bv) { bv = g[kb2]; best = kb2; }
                    if (best >= 0) sel |= 1u << best; }
            }
        }
        const int kb = t >> 2, jb = t & 3; const bool own = (kb == qb);
        if (!(own && (64 * jb > wid * 32 + 31))) {
            const bool lane_on = own || ((sel >> kb) & 1u);
            const float t0 = lane_on ? sl2 * (float)(64 * t + 4 * hi - (q0 + qloc)) - mhat : -INFINITY;
            f32x16 p0, p1;
#pragma unroll
            for (int r = 0; r < 16; ++r) { const float c = (float)((r & 3) + 8 * (r >> 2)); float a0, a1;
                asm("v_add_f32 %0, %1, %2" : "=v"(a0) : "v"(sl2 * c), "v"(t0)); asm("v_add_f32 %0, %1, %2" : "=v"(a1) : "v"(sl2 * (c + 32.f)), "v"(t0)); p0[r] = a0; p1[r] = a1; }
#pragma unroll
            for (int d0 = 0; d0 < 4; ++d0) { const bf16x8 b0 = *(const LAS bf16x8*)(kp0 + s * 8192 + d0 * 2048), b1 = *(const LAS bf16x8*)(kp0 + s * 8192 + d0 * 2048 + 512);
                p0 = __builtin_amdgcn_mfma_f32_32x32x16_bf16(b0, qr[d0], p0, 0, 0, 0); p1 = __builtin_amdgcn_mfma_f32_32x32x16_bf16(b1, qr[d0], p1, 0, 0, 0); }
            if (own && (64 * jb + 63 > wid * 32)) {
#pragma unroll
                for (int r = 0; r < 16; ++r) { const int kv = 64 * jb + crow(r, hi); if (kv > qloc) p0[r] = -INFINITY; if (kv + 32 > qloc) p1[r] = -INFINITY; } }
            int rmi = max(__float_as_int(p0[0]), __float_as_int(p1[0]));
#pragma unroll
            for (int r = 1; r < 16; ++r) rmi = max(max(rmi, __float_as_int(p0[r])), __float_as_int(p1[r]));
            rmi = max(rmi, __builtin_bit_cast(int, swap_other(__builtin_bit_cast(float, rmi))));
            const float rm = __builtin_bit_cast(float, rmi);
            if (__any(rm > THR)) {
                const float dl = fmaxf(rm, 0.f), f = __builtin_amdgcn_exp2f(-dl);
                mhat += dl;
#pragma unroll
                for (int r = 0; r < 16; ++r) { p0[r] -= dl; p1[r] -= dl; }
                if (hi == 0) wsf[r32] = f;
                asm volatile("" ::: "memory");
#pragma unroll
                for (int r = 0; r < 16; ++r) { const float fr = wsf[crow(r, hi)]; o[0][r] *= fr; o[1][r] *= fr; ol[r] *= fr; }
            }
#pragma unroll
            for (int r = 0; r < 16; ++r) { p0[r] = __builtin_amdgcn_exp2f(p0[r]); p1[r] = __builtin_amdgcn_exp2f(p1[r]); }
            const u32x4 pw0 = ATT_PACK(p0, 0), pw1 = ATT_PACK(p0, 8), pw2 = ATT_PACK(p1, 0), pw3 = ATT_PACK(p1, 8);
            pv(o, vp0 + s * 8192, pw0, pw1, pw2, pw3);
            ol = __builtin_amdgcn_mfma_f32_32x32x16_bf16(__builtin_bit_cast(bf16x8, pw0), ones, ol, 0, 0, 0); ol = __builtin_amdgcn_mfma_f32_32x32x16_bf16(__builtin_bit_cast(bf16x8, pw1), ones, ol, 0, 0, 0);
            ol = __builtin_amdgcn_mfma_f32_32x32x16_bf16(__builtin_bit_cast(bf16x8, pw2), ones, ol, 0, 0, 0); ol = __builtin_amdgcn_mfma_f32_32x32x16_bf16(__builtin_bit_cast(bf16x8, pw3), ones, ol, 0, 0, 0);
        }
    }
#undef ATT_DMA
    __builtin_amdgcn_s_setprio(0);
    LAS bf16* stg = (LAS bf16*)(lds + 67584 + wid * 4096);
#pragma unroll
    for (int r = 0; r < 16; ++r) { const int orow = crow(r, hi); const float rl = __builtin_amdgcn_rcpf(ol[r]);
        stg[orow * 64 + r32] = (bf16)f2bf(o[0][r] * rl); stg[orow * 64 + 32 + r32] = (bf16)f2bf(o[1][r] * rl); }
    asm volatile("s_waitcnt lgkmcnt(0)" ::: "memory");
    bf16* Ow = O + (rowbase + q0 + wid * 32) * OP + h * 64;
#pragma unroll
    for (int i = 0; i < 4; ++i) { const int row = i * 8 + (lane >> 3), ch = lane & 7; const u32x4 v = *(const LAS u32x4*)(stg + row * 64 + ch * 8); *(u32x4*)(Ow + (size_t)row * OP + ch * 8) = v; }
    asm volatile("s_waitcnt lgkmcnt(0)" ::: "memory"); __builtin_amdgcn_s_barrier(); asm volatile("" ::: "memory");
}

__device__ __forceinline__ void ssd_state_unit(Frame& F, int b, int j, int nh) {
    const int lane = F.lane, r32 = lane & 31, hi = lane >> 5, wid = F.wave, tid = F.tid, g = j >> 3;
    const bf16* XA = (const bf16*)(F.ws + WS_XBCACT); const float* DT = (const float*)(F.ws + WS_DT); const float* CS = (const float*)(F.ws + WS_CS); bf16* ST = (bf16*)(F.ws + WS_STATES);
    LAS unsigned char* lds = F.lds;
    const int pb = (wid >> 1) & 1, nbl = wid & 1;
    const int vpoff = ((lane >> 4) & 1) * 32 + (lane & 3) * 8 + (4 * hi + ((lane & 15) >> 2)) * 64;
    const int l = tid >> 1, dh = tid & 1;
    f32x16 hst = f32x16{};
#define SST_BDMA(c, buf) do { const size_t rc_ = (size_t)b * SEQ + (c) * 256; _Pragma("unroll") for (int tt = 0; tt < 4; ++tt) \
        dma16(XA + (rc_ + 64 * tt + 16 * (wid & 3) + (lane >> 2)) * CONVD + 1024 + g * 128 + nh * 64 + (wid >> 2) * 32 + (lane & 3) * 8, lds + 65536 + (buf) * 32768 + tt * 8192 + wid * 1024); } while (0)
    u32x4 xw[4]; float dtl, csl_, cse;
#define SST_XLOAD(c) do { const size_t rc_ = (size_t)b * SEQ + (c) * 256; const u32x4* src_ = (const u32x4*)(XA + (rc_ + l) * CONVD + j * 64 + dh * 32); \
        xw[0] = src_[0]; xw[1] = src_[1]; xw[2] = src_[2]; xw[3] = src_[3]; dtl = DT[(rc_ + l) * 16 + j]; csl_ = CS[(rc_ + l) * 16 + j]; cse = CS[(rc_ + 255) * 16 + j]; } while (0)
    SST_BDMA(0, 0); SST_XLOAD(0);
    for (int c = 0; c < NCH; ++c) {
        const int buf = c & 1;
        const float cs_end = cse;
        { const float sc = dtl * __expf(cs_end - csl_);
            LAS unsigned char* dst = lds + buf * 32768 + (l >> 6) * 8192 + dh * 4096 + ((l & 63) >> 4) * 1024 + (l & 15) * 64;
#pragma unroll
            for (int pc = 0; pc < 4; ++pc) { u32x4 w = xw[pc];
                w.x = pk2(bflo(w.x) * sc, bfhi(w.x) * sc); w.y = pk2(bflo(w.y) * sc, bfhi(w.y) * sc); w.z = pk2(bflo(w.z) * sc, bfhi(w.z) * sc); w.w = pk2(bflo(w.w) * sc, bfhi(w.w) * sc);
                *(LAS u32x4*)(dst + pc * 16) = w; } }
        __syncthreads();
        if (c + 1 < NCH) { SST_BDMA(c + 1, buf ^ 1); SST_XLOAD(c + 1); }
        if (wid < 4) {
            LAS bf16* sst = (LAS bf16*)(lds + 131072 + wid * 2048);
#pragma unroll
            for (int r = 0; r < 16; ++r) sst[crow(r, hi) * 32 + r32] = (bf16)f2bf(hst[r]);
            asm volatile("s_waitcnt lgkmcnt(0)" ::: "memory");
            bf16* stp = ST + ((size_t)(((b * NCH + c) * SH + j) * 64 + 32 * pb)) * 128 + nh * 64 + 32 * nbl;
#pragma unroll
            for (int q = 0; q < 2; ++q) { const int row = q * 16 + (lane >> 2), ch = lane & 3; *(u32x4*)(stp + (size_t)row * 128 + ch * 8) = *(const LAS u32x4*)(sst + row * 32 + ch * 8); }
            asm volatile("s_waitcnt lgkmcnt(0)" ::: "memory");
            f32x16 acc = f32x16{};
#pragma unroll
            for (int tt = 0; tt < 4; ++tt)
#pragma unroll
                for (int ks = 0; ks < 4; ++ks) {
                    const lptr xa = (lptr)lds + buf * 32768 + tt * 8192 + pb * 4096 + ks * 1024 + vpoff, ba = (lptr)lds + 65536 + buf * 32768 + tt * 8192 + nbl * 4096 + ks * 1024 + vpoff;
                    const s16x4 alo = vtr(xa), ahi = vtr(xa + 512), blo = vtr(ba), bhi_ = vtr(ba + 512);
                    const bf16x8 av = (bf16x8){alo[0], alo[1], alo[2], alo[3], ahi[0], ahi[1], ahi[2], ahi[3]}, bv = (bf16x8){blo[0], blo[1], blo[2], blo[3], bhi_[0], bhi_[1], bhi_[2], bhi_[3]};
                    acc = __builtin_amdgcn_mfma_f32_32x32x16_bf16(av, bv, acc, 0, 0, 0); }
            const float dec = __expf(cs_end);
#pragma unroll
            for (int r = 0; r < 16; ++r) hst[r] = hst[r] * dec + acc[r];
        }
    }
    __syncthreads();
#undef SST_BDMA
#undef SST_XLOAD
}

__device__ __forceinline__ void ssd_y_group(Frame& F, int b, int c, int j0) {
    const int lane = F.lane, r32 = lane & 31, hi = lane >> 5, wid = F.wave, tid = F.tid, g = j0 >> 3;
    const bf16* XA = (const bf16*)(F.ws + WS_XBCACT); const float* DT = (const float*)(F.ws + WS_DT); const float* CS = (const float*)(F.ws + WS_CS); const bf16* ST = (const bf16*)(F.ws + WS_STATES);
    const bf16* Z = (const bf16*)(F.ws + WS_Z); bf16* O = (bf16*)(F.ws + WS_ACAT); float* SUMSQ = (float*)(F.ws + WS_SUMSQ);
    LAS unsigned char* lds = F.lds;
    const size_t rowc = (size_t)b * SEQ + c * 256;
#define SSY_XDMA(j, buf) do { _Pragma("unroll") for (int tt = 0; tt < 4; ++tt) \
        dma16a(XA + (rowc + 64 * tt + 16 * (wid & 3) + (lane >> 2)) * CONVD + (j) * 64 + (wid >> 2) * 32 + (lane & 3) * 8, lds + 65536 + (buf) * 32768 + tt * 8192 + wid * 1024); } while (0)
#define SSY_TAB(j, buf) do { if (tid < 256) { LAS float* tb_ = (LAS float*)(lds + 131072 + (buf) * 2048); const float c_ = CS[(rowc + tid) * 16 + (j)] * LOG2E; tb_[tid] = c_; tb_[256 + tid] = c_ - __builtin_amdgcn_logf(DT[(rowc + tid) * 16 + (j)]); } } while (0)
#define SSY_HDMA(j) do { const bf16* hs_ = ST + ((size_t)(((b * NCH + c) * SH + (j)) * 64 + lane)) * 128; dma16a(hs_ + wid * 8, lds + 135168 + wid * 1024); dma16a(hs_ + (wid + 8) * 8, lds + 135168 + (wid + 8) * 1024); } while (0)
    SSY_HDMA(j0);
    SSY_TAB(j0, 0); SSY_TAB(j0 + 1, 1);
    bf16x8 qr[8];
    const int qblk = wid < 4 ? wid : 11 - wid;
    const bf16* Cw = XA + (rowc + qblk * 32 + r32) * CONVD + 1280 + g * 128 + hi * 8;
#pragma unroll
    for (int d0 = 0; d0 < 8; ++d0) qr[d0] = *(const bf16x8*)(Cw + d0 * 16);
    const int lq = qblk * 32 + r32, tq = qblk >> 1;
    const lptr kp0 = (lptr)lds + hi * 1024 + r32 * 16;
#pragma unroll 1
    for (int hh = 0; hh < 4; ++hh) {
        const int j = j0 + hh, buf = hh & 1;
        LAS float* csl = (LAS float*)(lds + 131072 + buf * 2048); LAS float* dtt = csl + 256;
        f32x16 o[2]; o[0] = f32x16{}; o[1] = f32x16{};
        asm volatile("s_waitcnt vmcnt(0) lgkmcnt(0)" ::: "memory"); __builtin_amdgcn_s_barrier(); asm volatile("" ::: "memory");
        { const lptr hp = (lptr)lds + 135168 + hi * 1024 + r32 * 16;
#pragma unroll
            for (int ks = 0; ks < 8; ++ks) { const bf16x8 h0 = *(const LAS bf16x8*)(hp + ks * 2048), h1 = *(const LAS bf16x8*)(hp + ks * 2048 + 512);
                o[0] = __builtin_amdgcn_mfma_f32_32x32x16_bf16(qr[ks], h0, o[0], 0, 0, 0); o[1] = __builtin_amdgcn_mfma_f32_32x32x16_bf16(qr[ks], h1, o[1], 0, 0, 0); } }
#pragma unroll
        for (int r = 0; r < 16; ++r) { const float e = __builtin_amdgcn_exp2f(csl[qblk * 32 + crow(r, hi)]); o[0][r] *= e; o[1][r] *= e; }
        const float cq = csl[lq];
        u32x4 xvs[4], zvs[4];
#pragma unroll
        for (int i = 0; i < 4; ++i) { const size_t m = rowc + qblk * 32 + i * 8 + (lane >> 3); xvs[i] = *(const u32x4*)(XA + m * CONVD + j * 64 + (lane & 7) * 8); zvs[i] = *(const u32x4*)(Z + m * DM + j * 64 + (lane & 7) * 8); }
        const lptr vp0 = (lptr)lds + 65536 + buf * 32768 + ((lane >> 4) & 1) * 32 + (lane & 3) * 8 + (4 * hi + ((lane & 15) >> 2)) * 64;
        for (int t = 0; t <= tq; ++t) {
            f32x16 p0 = f32x16{}, p1 = f32x16{};
#pragma unroll
            for (int d0 = 0; d0 < 8; ++d0) { const bf16x8 b0 = *(const LAS bf16x8*)(kp0 + t * 16384 + d0 * 2048), b1 = *(const LAS bf16x8*)(kp0 + t * 16384 + d0 * 2048 + 512);
                p0 = __builtin_amdgcn_mfma_f32_32x32x16_bf16(b0, qr[d0], p0, 0, 0, 0); p1 = __builtin_amdgcn_mfma_f32_32x32x16_bf16(b1, qr[d0], p1, 0, 0, 0); }
#pragma unroll
            for (int g4 = 0; g4 < 4; ++g4) { const f32x4 w0 = *(const LAS f32x4*)(dtt + 64 * t + 4 * hi + 8 * g4), w1 = *(const LAS f32x4*)(dtt + 64 * t + 32 + 4 * hi + 8 * g4);
#pragma unroll
                for (int e = 0; e < 4; ++e) { const int r = 4 * g4 + e; p0[r] *= __builtin_amdgcn_exp2f(cq - w0[e]); p1[r] *= __builtin_amdgcn_exp2f(cq - w1[e]); } }
            if (t == tq) {
#pragma unroll
                for (int r = 0; r < 16; ++r) { const int s0 = 64 * t + crow(r, hi); if (s0 > lq) p0[r] = 0.f; if (s0 + 32 > lq) p1[r] = 0.f; } }
            pv(o, vp0 + t * 8192, ATT_PACK(p0, 0), ATT_PACK(p0, 8), ATT_PACK(p1, 0), ATT_PACK(p1, 8));
        }
        __syncthreads();
        if (hh + 1 < 4) SSY_HDMA(j + 1);
        LAS bf16* stg = (LAS bf16*)(lds + 65536 + buf * 32768 + wid * 4096);
#pragma unroll
        for (int r = 0; r < 16; ++r) { const int orow = crow(r, hi); stg[orow * 64 + r32] = (bf16)f2bf(o[0][r]); stg[orow * 64 + 32 + r32] = (bf16)f2bf(o[1][r]); }
        asm volatile("s_waitcnt lgkmcnt(0)" ::: "memory");
        const float dsk = F.in[I_DSKIP][j];
#pragma unroll
        for (int i = 0; i < 4; ++i) { const int row = i * 8 + (lane >> 3), ch = lane & 7; const size_t m = rowc + qblk * 32 + row;
            const u32x4 yv = *(const LAS u32x4*)(stg + row * 64 + ch * 8);
            const u32x4 xv = xvs[i], zv = zvs[i];
            const float y[8] = {bflo(yv.x), bfhi(yv.x), bflo(yv.y), bfhi(yv.y), bflo(yv.z), bfhi(yv.z), bflo(yv.w), bfhi(yv.w)};
            const float x[8] = {bflo(xv.x), bfhi(xv.x), bflo(xv.y), bfhi(xv.y), bflo(xv.z), bfhi(xv.z), bflo(xv.w), bfhi(xv.w)};
            const float z[8] = {bflo(zv.x), bfhi(zv.x), bflo(zv.y), bfhi(zv.y), bflo(zv.z), bfhi(zv.z), bflo(zv.w), bfhi(zv.w)};
            float u[8]; float ss = 0.f;
#pragma unroll
            for (int e = 0; e < 8; ++e) { u[e] = (y[e] + dsk * x[e]) * z[e] * sigmoidf_(z[e]); ss += u[e] * u[e]; }
            ss += dpp_f<0xB1>(ss); ss += dpp_f<0x4E>(ss); ss += dpp_f<0x141>(ss);
            if (ch == 0) SUMSQ[m * 16 + j] = ss;
            u32x4 w; w.x = pk2(u[0], u[1]); w.y = pk2(u[2], u[3]); w.z = pk2(u[4], u[5]); w.w = pk2(u[6], u[7]);
            *(u32x4*)(O + m * 1536 + 512 + j * 64 + ch * 8) = w; }
        asm volatile("s_waitcnt lgkmcnt(0)" ::: "memory"); __builtin_amdgcn_s_barrier(); asm volatile("" ::: "memory");
        if (hh + 2 < 4) { SSY_XDMA(j + 2, buf); SSY_TAB(j + 2, buf); }
    }
#undef SSY_XDMA
#undef SSY_TAB
#undef SSY_HDMA
}
}

#ifndef FAST_ATTN
#define FAST_ATTN 1
#endif
#ifndef FAST_SSD
#define FAST_SSD 1
#endif
__device__ __forceinline__ void phase_attn(Frame& F) {
    const int v = F.vcu;
#ifndef DUP_PART
#define DUP_PART 0
#endif
    if (!(F.live == 0.f && DUP_PART == 2)) att::ssd_state_unit(F, v >> 5, (v >> 1) & 15, v & 1);
    if (!(F.live == 0.f && DUP_PART == 1)) { const int bh = v >> 2, s = v & 3; att::attn_unit(F, bh >> 3, bh & 7, s); att::attn_unit(F, bh >> 3, bh & 7, 7 - s); }
}
__device__ __forceinline__ void phase_ssdy(Frame& F) {
#if FAST_SSD
    { const int u = F.vcu * 4; att::ssd_y_group(F, u >> 7, (u >> 4) & 7, u & 15); }
#endif
}

__global__ void __launch_bounds__(256) attn_naive(const bf16* __restrict__ Q, const bf16* __restrict__ K, const bf16* __restrict__ V, const float* __restrict__ KM, bf16* __restrict__ ACAT) {
    const int blk = blockIdx.x, qb = blk % NBLK, h = (blk / NBLK) % AH, b = blk / (NBLK * AH);
    const int t = qb * 256 + threadIdx.x; const size_t row = (size_t)b * SEQ + t;
    float q[64];
#pragma unroll
    for (int d = 0; d < 64; d += 2) { const unsigned w = *(const unsigned*)(Q + row * AW + h * 64 + d); q[d] = bflo(w); q[d + 1] = bfhi(w); }
    unsigned sel = 0;
    if (qb <= 3) sel = (1u << qb) - 1u;
    else {
        float g[8];
#pragma unroll
        for (int kb = 0; kb < 8; ++kb) { float a = 0.f; if (kb < qb) {
#pragma unroll
                for (int d = 0; d < 64; ++d) a += q[d] * KM[(size_t)((b * AH + h) * NBLK + kb) * 64 + d]; } else a = -INFINITY; g[kb] = a; }
#pragma unroll
        for (int r = 0; r < 3; ++r) { int best = -1; float bv = -INFINITY;
#pragma unroll
            for (int kb = 0; kb < 8; ++kb) if (kb < qb && !((sel >> kb) & 1u) && g[kb] > bv) { bv = g[kb]; best = kb; }
            if (best >= 0) sel |= 1u << best; }
    }
    const float sl2 = exp2f(-(float)(h + 1)) * LOG2E;
    float mx = -1e30f, l = 0.f; float o[64];
#pragma unroll
    for (int d = 0; d < 64; ++d) o[d] = 0.f;
    for (int kb = 0; kb <= qb; ++kb) {
        const bool act = (kb == qb) || ((sel >> kb) & 1u);
        for (int j = 0; j < 256; ++j) {
            const int tk = kb * 256 + j; const size_t krow = (size_t)b * SEQ + tk;
            float s = 0.f;
#pragma unroll
            for (int d = 0; d < 64; d += 2) { const unsigned w = *(const unsigned*)(K + krow * AW + h * 64 + d); s += q[d] * bflo(w) + q[d + 1] * bfhi(w); }
            s -= sl2 * (float)(t - tk);
            const bool ok = act && (tk <= t);
            if (ok) {
                const float mn = fmaxf(mx, s), f = exp2f(mx - mn), p = exp2f(s - mn);
                l = l * f + p;
#pragma unroll
                for (int d = 0; d < 64; d += 2) { const unsigned w = *(const unsigned*)(V + krow * AW + h * 64 + d); o[d] = o[d] * f + p * bflo(w); o[d + 1] = o[d + 1] * f + p * bfhi(w); }
                mx = mn;
            }
        }
    }
    const float rl = 1.f / l;
#pragma unroll
    for (int d = 0; d < 64; d += 2) *(unsigned*)(ACAT + row * 1536 + h * 64 + d) = pk2(o[d] * rl, o[d + 1] * rl);
}

__global__ void __launch_bounds__(64) ssd_naive(const bf16* __restrict__ XA, const float* __restrict__ DT, const bf16* __restrict__ Z, const float* __restrict__ ALOG, const float* __restrict__ DSKIP,
                                                bf16* __restrict__ ACAT, float* __restrict__ SUMSQ) {
    const int b = blockIdx.x / SH, j = blockIdx.x % SH, p = threadIdx.x, g = j / 8;
    const float a = -__expf(ALOG[j]), dsk = DSKIP[j];
    float hst[128];
#pragma unroll
    for (int n = 0; n < 128; ++n) hst[n] = 0.f;
    for (int t = 0; t < SEQ; ++t) {
        const size_t row = (size_t)b * SEQ + t;
        const float dt = DT[row * 16 + j], dA = __expf(dt * a);
        const float x = bf2f(XA[row * CONVD + j * 64 + p]), dtx = dt * x;
        const bf16* Bp = XA + row * CONVD + 1024 + g * 128; const bf16* Cp = XA + row * CONVD + 1280 + g * 128;
        float y = 0.f;
#pragma unroll
        for (int n = 0; n < 128; n += 2) { const unsigned bw = *(const unsigned*)(Bp + n), cw = *(const unsigned*)(Cp + n);
            hst[n] = hst[n] * dA + dtx * bflo(bw); y += bflo(cw) * hst[n];
            hst[n + 1] = hst[n + 1] * dA + dtx * bfhi(bw); y += bfhi(cw) * hst[n + 1]; }
        y += dsk * x;
        const float zz = bf2f(Z[row * DM + j * 64 + p]);
        const float u = y * zz * sigmoidf_(zz);
        ACAT[row * 1536 + 512 + j * 64 + p] = (bf16)f2bf(u);
        const float ss = wave_sum(u * u);
        if (p == 0) SUMSQ[row * 16 + j] = ss;
    }
}


#ifdef DBG_ATT
__global__ void dbg_cmp(const bf16* __restrict__ A, const bf16* __restrict__ Bf, float* acc) {
    float d2 = 0.f, n2 = 0.f;
    for (size_t i = (size_t)blockIdx.x * blockDim.x + threadIdx.x; i < (size_t)M * 512; i += (size_t)gridDim.x * blockDim.x) {
        const size_t row = i / 512; const int col = (int)(i % 512), h = col / 64, qb = (int)((row % SEQ) / 256);
        bool on = true;
        if (DBG_ATT == 1) on = qb == 0; else if (DBG_ATT == 2) on = qb >= 1 && qb <= 3; else if (DBG_ATT == 3) on = qb >= 4; else if (DBG_ATT >= 10) on = (h == DBG_ATT - 10);
        if (!on) continue;
        const float a = bf2f(A[row * 1536 + col]), b = bf2f(Bf[row * 512 + col]);
        d2 += (a - b) * (a - b); n2 += a * a;
    }
    d2 = wave_sum(d2); n2 = wave_sum(n2);
    if ((threadIdx.x & 63) == 0) { atomicAdd(acc, d2); atomicAdd(acc + 1, n2); }
}
__global__ void dbg_apply(float* out, const float* acc) {
    const float m = sqrtf(acc[0] / fmaxf(acc[1], 1e-30f));
    for (size_t i = (size_t)blockIdx.x * blockDim.x + threadIdx.x; i < (size_t)M * DM; i += (size_t)gridDim.x * blockDim.x) out[i] *= (1.f + m);
}
#endif
__device__ __forceinline__ bool xcd_layout_ok(Frame& F, bool want) {
    LAS unsigned* badw = (LAS unsigned*)(F.lds + MISC_OFF) + 16;
    if (want && F.tid < 256) {
        unsigned* XT = (unsigned*)(F.ws + WS_CTL) + CW_XT; const int t = F.tid;
        const unsigned a = xb_ld(XT + t), r = xb_ld(XT + (t & 7)); bool good = (a == r) && a != 0u;
        if (t < 8) { for (int u = 0; u < 8; ++u) if (u != t && xb_ld(XT + u) == a) good = false; }
        if (__builtin_amdgcn_ballot_w64(!good) != 0ull && F.lane == 0) (void)__hip_atomic_fetch_or(badw, 1u, __ATOMIC_RELAXED, __HIP_MEMORY_SCOPE_WORKGROUP);
    }
    __syncthreads();
    return want && __builtin_amdgcn_readfirstlane((int)*badw) == 0;
}
__device__ __forceinline__ void xcd_barrier_ssdy(const XcdBarrier& b, Frame& F, bool local) {
    const int u = F.vcu * 4;
    asm volatile("s_waitcnt vmcnt(0)" ::: "memory");
    __syncthreads();
    if (F.wave <= 1) xcd_barrier_core(b, local);
    if (F.wave != 0) att::ssd_y_prefetch(F, u >> 7, (u >> 4) & 7, u & 15);
    asm volatile("" ::: "memory"); __builtin_amdgcn_s_barrier(); asm volatile("" ::: "memory");
    if (F.wave == 0) att::ssd_y_prefetch(F, u >> 7, (u >> 4) & 7, u & 15);
}
enum { PH_PROLOGUE = 0, PH_PROJ, PH_CONV, PH_ATTN, PH_SSDY, PH_MERGE, PH_X1, PH_ROUTE1, PH_ROUTE2, PH_UP, PH_PLE, PH_COUNT };

__global__ void __launch_bounds__(NWAVES * 64, 2) mk_fwd(Args args) {
    extern __shared__ __attribute__((aligned(16))) unsigned char lds[];
    Frame F;
    F.lds = (LAS unsigned char*)lds;
    F.tid = threadIdx.x; F.lane = F.tid & 63; F.wave = __builtin_amdgcn_readfirstlane(F.tid >> 6);
    F.G = gridDim.x; { const int bx = blockIdx.x; F.vcu = (F.G % 8 == 0) ? (bx % 8) * (F.G / 8) + bx / 8 : bx; }
    F.in = args.in; F.out = args.out; F.ws = args.ws; F.pscale = 1.f; F.live = 1.f;
    volatile LAS unsigned* MISC = (volatile LAS unsigned*)(F.lds + MISC_OFF);
    if (F.tid < 32) MISC[F.tid] = 0u;
    __syncthreads();
    XcdBarrier bar = xcd_barrier_post((unsigned*)(args.ws + WS_CTL) + CW_BAR + args.li * XCD_BAR_WORDS, MISC + 8);
    if (F.tid == 0) __hip_atomic_store((unsigned*)(args.ws + WS_CTL) + CW_XT + blockIdx.x, bar.x + 1u, __ATOMIC_RELAXED, __HIP_MEMORY_SCOPE_AGENT);
    const int lo = args.ph_lo, hi = args.ph_hi;
#define IN(k) (lo <= (k) && (k) < hi)
#ifdef PROBE_T
    unsigned long long ts[PH_COUNT + 1];
#define STAMP(k) ts[k] = __builtin_amdgcn_s_memrealtime()
#else
#define STAMP(k) do {} while (0)
#endif
#define SEAM(k) do { if (IN(k) && IN((k) + 1)) xcd_barrier(bar); STAMP((k) + 1); } while (0)
#ifndef DUPMASK
#define DUPMASK 0
#endif
#define DUP(k, call) do { if ((DUPMASK >> (k)) & 1) { xcd_barrier(bar); F.live = 0.f; call; F.live = 1.f; } } while (0)
    STAMP(0);
    if (IN(PH_PROLOGUE)) { phase_prologue(F); DUP(PH_PROLOGUE, phase_prologue(F)); } SEAM(PH_PROLOGUE);
    const bool xl = xcd_layout_ok(F, IN(PH_PROLOGUE) && IN(PH_PROJ) && F.G == 256);
    if (IN(PH_PROJ)) { phase_proj(F); DUP(PH_PROJ, phase_proj(F)); }
    if (IN(PH_PROJ) && IN(PH_CONV)) xcd_barrier(bar, xl); STAMP(PH_PROJ + 1);
    if (IN(PH_CONV)) { phase_conv(F); DUP(PH_CONV, phase_conv(F)); }
    if (IN(PH_CONV) && IN(PH_ATTN)) xcd_barrier(bar, xl); STAMP(PH_CONV + 1);
    if (IN(PH_ATTN)) { phase_attn(F); DUP(PH_ATTN, phase_attn(F)); } if (IN(PH_ATTN) && IN(PH_SSDY)) xcd_barrier_ssdy(bar, F, xl); STAMP(PH_ATTN + 1);
    if (IN(PH_ATTN) && F.tid == 0) (void)xb_add((unsigned*)(F.ws + WS_CTL) + CW_QKV, 1u);
    if (IN(PH_SSDY) && !IN(PH_ATTN)) { const int u = F.vcu * 4; att::ssd_y_prefetch(F, u >> 7, (u >> 4) & 7, u & 15); }
    if (IN(PH_SSDY)) { phase_ssdy(F); DUP(PH_SSDY, phase_ssdy(F)); }
    if (IN(PH_SSDY) && IN(PH_MERGE)) xcd_barrier(bar, xl); STAMP(PH_SSDY + 1);
    if (IN(PH_MERGE)) { phase_merge(F); DUP(PH_MERGE, phase_merge(F)); }
    if (IN(PH_MERGE) && IN(PH_X1)) xcd_barrier(bar, xl); STAMP(PH_MERGE + 1);
    if (IN(PH_X1)) { phase_x1(F); DUP(PH_X1, phase_x1(F)); }
    if (IN(PH_X1) && IN(PH_ROUTE1)) xcd_barrier(bar, xl && IN(PH_ATTN)); STAMP(PH_X1 + 1);
    if (IN(PH_ROUTE1)) { phase_route1(F, xl && IN(PH_ATTN)); } SEAM(PH_ROUTE1);
    if (IN(PH_ROUTE2)) { phase_route2(F); DUP(PH_ROUTE2, phase_route2(F)); } SEAM(PH_ROUTE2);
    if (IN(PH_UP)) { phase_up(F); } SEAM(PH_UP);
    if (IN(PH_PLE)) { phase_ple(F); DUP(PH_PLE, phase_ple(F)); }
#undef IN
#undef SEAM
}

extern "C" void kernel_launch(void* const* d_in, const int* in_sizes, int n_in, void* d_out, int out_size, void* d_ws, size_t ws_size, hipStream_t stream) {
    static int grid = 0;
    if (grid == 0) {
        if (n_in != 24 || out_size != M * DM || ws_size < WS_END) { fprintf(stderr, "kernel_launch: unexpected shapes n_in %d out %d ws %zu\n", n_in, out_size, ws_size); grid = -1; return; }
        int dev = 0, cus = 0, per_cu = 0;
        if (hipGetDevice(&dev) != hipSuccess || hipDeviceGetAttribute(&cus, hipDeviceAttributeMultiprocessorCount, dev) != hipSuccess) { grid = -1; return; }
        if (hipFuncSetAttribute((const void*)mk_fwd, hipFuncAttributeMaxDynamicSharedMemorySize, LDS_BYTES) != hipSuccess) { fprintf(stderr, "kernel_launch: hipFuncSetAttribute failed\n"); grid = -1; return; }
        if (hipOccupancyMaxActiveBlocksPerMultiprocessor(&per_cu, (const void*)mk_fwd, NWAVES * 64, LDS_BYTES) != hipSuccess || per_cu < 1) { fprintf(stderr, "kernel_launch: occupancy query says %d\n", per_cu); grid = -1; return; }
        (void)hipGetLastError();
        grid = cus;
        if (grid != 256) { fprintf(stderr, "kernel_launch: built for 256 CUs, device has %d\n", cus); grid = -1; return; }
    }
    if (grid < 0) return;
    hipMemsetAsync((char*)d_ws + WS_CTL, 0, CTL_ZERO_BYTES, stream);
    Args a{};
    for (int i = 0; i < 24; ++i) a.in[i] = (const float*)d_in[i];
    a.out = (float*)d_out; a.ws = (unsigned char*)d_ws;
    unsigned char* ws = (unsigned char*)d_ws;
    int li = 0;
    auto frame = [&](int lo, int hi) { a.ph_lo = lo; a.ph_hi = hi; a.li = li++; hipLaunchKernelGGL(mk_fwd, dim3(grid), dim3(NWAVES * 64), LDS_BYTES, stream, a); };
#ifdef DBG_ATT
    frame(PH_PROLOGUE, PH_SSDY);
    hipLaunchKernelGGL(attn_naive, dim3(NBATCH * AH * NBLK), dim3(256), 0, stream, (const bf16*)(ws + WS_Q), (const bf16*)(ws + WS_K), (const bf16*)(ws + WS_V), (const float*)(ws + WS_KMEAN), (bf16*)(ws + WS_ACAT));
    hipLaunchKernelGGL(ssd_naive, dim3(NBATCH * SH), dim3(64), 0, stream, (const bf16*)(ws + WS_XBCACT), (const float*)(ws + WS_DT), (const bf16*)(ws + WS_Z), (const float*)d_in[I_ALOG], (const float*)d_in[I_DSKIP],
                       (bf16*)(ws + WS_ACAT), (float*)(ws + WS_SUMSQ));
    hipLaunchKernelGGL(dbg_cmp, dim3(1024), dim3(256), 0, stream, (const bf16*)(ws + WS_ACAT), (const bf16*)(ws + WS_WCAT2), (float*)(ws + WS_CTL) + 64);
    frame(PH_SSDY, PH_COUNT);
    hipLaunchKernelGGL(dbg_apply, dim3(1024), dim3(256), 0, stream, (float*)d_out, (const float*)(ws + WS_CTL) + 64);
#elif FAST_ATTN && FAST_SSD
    frame(PH_PROLOGUE, PH_COUNT);
#else
    frame(PH_PROLOGUE, PH_SSDY);
#if !FAST_ATTN
    hipLaunchKernelGGL(attn_naive, dim3(NBATCH * AH * NBLK), dim3(256), 0, stream, (const bf16*)(ws + WS_Q), (const bf16*)(ws + WS_K), (const bf16*)(ws + WS_V), (const float*)(ws + WS_KMEAN), (bf16*)(ws + WS_ACAT));
#endif
#if !FAST_SSD
    hipLaunchKernelGGL(ssd_naive, dim3(NBATCH * SH), dim3(64), 0, stream, (const bf16*)(ws + WS_XBCACT), (const float*)(ws + WS_DT), (const bf16*)(ws + WS_Z), (const float*)d_in[I_ALOG], (const float*)d_in[I_DSKIP],
                       (bf16*)(ws + WS_ACAT), (float*)(ws + WS_SUMSQ));
#endif
    frame(PH_SSDY, PH_COUNT);
#endif
}
```
